# Optimizing an MI355X kernel written in HIP

```python
import math
import jax, jax.numpy as jnp
from jax import lax
import numpy as np

D_MODEL = 1024
BATCH = 8
SEQ = 2048
DEPTH = 2

MLA_HEADS = 6
MLA_Q_RANK = 384
MLA_KV_RANK = 256
MLA_NOPE = 64
MLA_ROPE = 32
MLA_QK = MLA_NOPE + MLA_ROPE
MLA_V = 64
DIFF_HEADS = 4
DIFF_QK = 64
DIFF_V = 2 * DIFF_QK
GQA_HEADS = 6
GQA_KV_HEADS = 2
GQA_GROUP = GQA_HEADS // GQA_KV_HEADS
GQA_DIM = 64
GRID_W = 64
Q_BLOCK = 128
ROPE_THETA = 10000.0
EPS = 1e-6
FFN_HIDDEN = -(-(8 * D_MODEL) // (3 * 256)) * 256

IN_SIZES = [
    MLA_Q_RANK, MLA_KV_RANK, MLA_ROPE,
    DIFF_HEADS * 2 * DIFF_QK, DIFF_HEADS * 2 * DIFF_QK, DIFF_HEADS * DIFF_V,
    GQA_HEADS * GQA_DIM, GQA_KV_HEADS * GQA_DIM, GQA_KV_HEADS * GQA_DIM,
]
IN_WIDTH = sum(IN_SIZES)
IN_OFFSETS = [int(v) for v in np.cumsum(IN_SIZES)[:-1]]
MIX_WIDTH = MLA_HEADS * MLA_V + DIFF_HEADS * DIFF_V + GQA_HEADS * GQA_DIM

kernel_name = "hybrid_mla_diff_axialgqa_encoder"


def _rms_norm(x, gain):
    xf = x.astype(jnp.float32)
    y = xf * lax.rsqrt(jnp.mean(xf * xf, axis=-1, keepdims=True) + EPS)
    return (y * gain.astype(jnp.float32)).astype(x.dtype)


def _rope_cos_sin(pos, dim):
    inv = 1.0 / (ROPE_THETA ** (jnp.arange(0, dim, 2, dtype=jnp.float32) / dim))
    ang = pos.astype(jnp.float32)[:, None] * inv[None, :]
    return jnp.cos(ang), jnp.sin(ang)


def _apply_rope(x, cos, sin):
    xf = x.astype(jnp.float32)
    half = x.shape[-1] // 2
    x1, x2 = xf[..., :half], xf[..., half:]
    return jnp.concatenate([x1 * cos - x2 * sin, x1 * sin + x2 * cos], axis=-1).astype(x.dtype)


def _sweep_query_blocks(block_fn, q):
    s_len = q.shape[-2]
    nb = s_len // Q_BLOCK
    qb = q.reshape(q.shape[:-2] + (nb, Q_BLOCK, q.shape[-1]))
    qb = jnp.moveaxis(qb, -3, 0)
    out = lax.map(block_fn, qb)
    out = jnp.moveaxis(out, 0, -3)
    return out.reshape(out.shape[:-3] + (s_len, out.shape[-1]))


def _dense_attention(q, k, v, scale, score_eq, out_eq):
    def block_fn(qb):
        s = jnp.einsum(score_eq, qb, k).astype(jnp.float32) * scale
        p = jax.nn.softmax(s, axis=-1)
        return jnp.einsum(out_eq, p.astype(v.dtype), v)
    return _sweep_query_blocks(block_fn, q)


def _normal(key, shape, scale):
    return jax.random.normal(key, shape, jnp.float32) * scale


def _gain(key, shape):
    return 1.0 + 0.02 * jax.random.normal(key, shape, jnp.float32)


def setup_inputs(seed: int = 0) -> dict:
    key = jax.random.key(seed)
    ks = jax.random.split(key, 24)
    L = DEPTH
    return {
        "x": jax.random.normal(ks[0], (BATCH, SEQ, D_MODEL), jnp.float32),
        "attn_norm": _gain(ks[1], (L, D_MODEL)),
        "w_in": _normal(ks[2], (L, D_MODEL, IN_WIDTH), D_MODEL ** -0.5),
        "mla_q_norm": _gain(ks[3], (L, MLA_Q_RANK)),
        "mla_w_uq": _normal(ks[4], (L, MLA_Q_RANK, MLA_HEADS * MLA_QK), MLA_Q_RANK ** -0.5),
        "mla_kv_norm": _gain(ks[5], (L, MLA_KV_RANK)),
        "mla_w_ukv": _normal(ks[6], (L, MLA_KV_RANK, MLA_HEADS * (MLA_NOPE + MLA_V)), MLA_KV_RANK ** -0.5),
        "mla_q_gain": _gain(ks[7], (L, MLA_QK)),
        "mla_k_gain": _gain(ks[8], (L, MLA_QK)),
        "diff_q_gain": _gain(ks[9], (L, DIFF_QK)),
        "diff_k_gain": _gain(ks[10], (L, DIFF_QK)),
        "diff_lq1": _normal(ks[11], (L, DIFF_QK), 0.1),
        "diff_lk1": _normal(ks[12], (L, DIFF_QK), 0.1),
        "diff_lq2": _normal(ks[13], (L, DIFF_QK), 0.1),
        "diff_lk2": _normal(ks[14], (L, DIFF_QK), 0.1),
        "diff_out_gain": _gain(ks[15], (L, DIFF_V)),
        "gqa_q_gain": _gain(ks[16], (L, GQA_DIM)),
        "gqa_k_gain": _gain(ks[17], (L, GQA_DIM)),
        "w_o": _normal(ks[18], (L, MIX_WIDTH, D_MODEL), MIX_WIDTH ** -0.5),
        "ffn_norm": _gain(ks[19], (L, D_MODEL)),
        "w_gate_up": _normal(ks[20], (L, D_MODEL, 2 * FFN_HIDDEN), D_MODEL ** -0.5),
        "w_down": _normal(ks[21], (L, FFN_HIDDEN, D_MODEL), FFN_HIDDEN ** -0.5),
    }


def reference(x, attn_norm, w_in, mla_q_norm, mla_w_uq, mla_kv_norm, mla_w_ukv,
              mla_q_gain, mla_k_gain, diff_q_gain, diff_k_gain, diff_lq1, diff_lk1,
              diff_lq2, diff_lk2, diff_out_gain, gqa_q_gain, gqa_k_gain, w_o,
              ffn_norm, w_gate_up, w_down):
    B, S, _ = x.shape
    rows = S // GRID_W
    pos = jnp.arange(S, dtype=jnp.int32)
    cos_mla, sin_mla = _rope_cos_sin(pos, MLA_ROPE)
    cos_dif, sin_dif = _rope_cos_sin(pos, DIFF_QK)
    row_idx, col_idx = jnp.meshgrid(jnp.arange(rows, dtype=jnp.int32),
                                    jnp.arange(GRID_W, dtype=jnp.int32), indexing="ij")
    half_ax = GQA_DIM // 2
    cos_row, sin_row = _rope_cos_sin(row_idx.reshape(-1), half_ax)
    cos_col, sin_col = _rope_cos_sin(col_idx.reshape(-1), half_ax)

    def axial_rope(t):
        return jnp.concatenate([_apply_rope(t[..., :half_ax], cos_row, sin_row),
                                _apply_rope(t[..., half_ax:], cos_col, sin_col)], axis=-1)

    for l in range(DEPTH):
        xn = _rms_norm(x, attn_norm[l])
        h = xn @ w_in[l]
        (h_cq, h_ckv, h_kr, h_dq, h_dk, h_dv, h_gq, h_gk, h_gv) = jnp.split(h, IN_OFFSETS, axis=-1)

        c_q = _rms_norm(h_cq, mla_q_norm[l])
        q_a = (c_q @ mla_w_uq[l]).reshape(B, S, MLA_HEADS, MLA_QK).transpose(0, 2, 1, 3)
        c_kv = _rms_norm(h_ckv, mla_kv_norm[l])
        kv_a = (c_kv @ mla_w_ukv[l]).reshape(B, S, MLA_HEADS, MLA_NOPE + MLA_V).transpose(0, 2, 1, 3)
        k_nope, v_a = kv_a[..., :MLA_NOPE], kv_a[..., MLA_NOPE:]
        k_rope = jnp.broadcast_to(h_kr[:, None, :, :], (B, MLA_HEADS, S, MLA_ROPE))
        k_a = jnp.concatenate([k_nope, k_rope], axis=-1)
        q_a = _rms_norm(q_a, mla_q_gain[l])
        k_a = _rms_norm(k_a, mla_k_gain[l])
        q_a = jnp.concatenate([q_a[..., :MLA_NOPE], _apply_rope(q_a[..., MLA_NOPE:], cos_mla, sin_mla)], axis=-1)
        k_a = jnp.concatenate([k_a[..., :MLA_NOPE], _apply_rope(k_a[..., MLA_NOPE:], cos_mla, sin_mla)], axis=-1)
        o_a = _dense_attention(q_a, k_a, v_a, MLA_QK ** -0.5,
                               "bhqd,bhsd->bhqs", "bhqs,bhsv->bhqv")
        o_a = o_a.transpose(0, 2, 1, 3).reshape(B, S, MLA_HEADS * MLA_V)

        q_b = h_dq.reshape(B, S, DIFF_HEADS, 2, DIFF_QK).transpose(0, 2, 3, 1, 4)
        k_b = h_dk.reshape(B, S, DIFF_HEADS, 2, DIFF_QK).transpose(0, 2, 3, 1, 4)
        v_b = h_dv.reshape(B, S, DIFF_HEADS, DIFF_V).transpose(0, 2, 1, 3)
        q_b = _apply_rope(_rms_norm(q_b, diff_q_gain[l]), cos_dif, sin_dif)
        k_b = _apply_rope(_rms_norm(k_b, diff_k_gain[l]), cos_dif, sin_dif)
        lambda_init = 0.8 - 0.6 * math.exp(-0.3 * l)
        lam = (jnp.exp(jnp.sum(diff_lq1[l].astype(jnp.float32) * diff_lk1[l].astype(jnp.float32)))
               - jnp.exp(jnp.sum(diff_lq2[l].astype(jnp.float32) * diff_lk2[l].astype(jnp.float32)))
               + lambda_init)
        scale_b = DIFF_QK ** -0.5

        def diff_block(qb, k_b=k_b, v_b=v_b, lam=lam):
            s = jnp.einsum("bhcqd,bhcsd->bhcqs", qb, k_b).astype(jnp.float32) * scale_b
            p = jax.nn.softmax(s, axis=-1)
            a = p[:, :, 0] - lam * p[:, :, 1]
            return jnp.einsum("bhqs,bhsv->bhqv", a.astype(v_b.dtype), v_b)

        o_b = _sweep_query_blocks(diff_block, q_b)
        o_b = (_rms_norm(o_b, diff_out_gain[l]) * (1.0 - lambda_init)).astype(x.dtype)
        o_b = o_b.transpose(0, 2, 1, 3).reshape(B, S, DIFF_HEADS * DIFF_V)

        q_c = h_gq.reshape(B, S, GQA_KV_HEADS, GQA_GROUP, GQA_DIM).transpose(0, 2, 3, 1, 4)
        k_c = h_gk.reshape(B, S, GQA_KV_HEADS, GQA_DIM).transpose(0, 2, 1, 3)
        v_c = h_gv.reshape(B, S, GQA_KV_HEADS, GQA_DIM).transpose(0, 2, 1, 3)
        q_c = axial_rope(_rms_norm(q_c, gqa_q_gain[l]))
        k_c = axial_rope(_rms_norm(k_c, gqa_k_gain[l]))
        o_c = _dense_attention(q_c, k_c, v_c, GQA_DIM ** -0.5,
                               "bkgqd,bksd->bkgqs", "bkgqs,bksv->bkgqv")
        o_c = o_c.transpose(0, 3, 1, 2, 4).reshape(B, S, GQA_HEADS * GQA_DIM)

        mix = jnp.concatenate([o_a, o_b, o_c], axis=-1)
        x = x + mix @ w_o[l]

        xn = _rms_norm(x, ffn_norm[l])
        gate, up = jnp.split(xn @ w_gate_up[l], 2, axis=-1)
        x = x + (jax.nn.silu(gate) * up) @ w_down[l]
    return x
```

```cpp
#include <hip/hip_runtime.h>
namespace nv {
constexpr int S = 2048, DM = 1024, INW = 2848, FFH = 2816, MIXW = 1280;
constexpr float THETA = 10000.0f, EPSV = 1e-6f;

__global__ __launch_bounds__(256) void rms_rows(const float* in, int ld_in, int W, const float* gain, float* out, int ld_out, int rows) {
    const int row = blockIdx.x * 4 + (threadIdx.x >> 6), lane = threadIdx.x & 63;
    if (row >= rows) return;
    const float* p = in + (size_t)row * ld_in;
    float s = 0.f;
    for (int c = lane; c < W; c += 64) { const float v = p[c]; s += v * v; }
    for (int o = 1; o < 64; o <<= 1) s += __shfl_xor(s, o);
    const float r = rsqrtf(s / (float)W + EPSV);
    for (int c = lane; c < W; c += 64) out[(size_t)row * ld_out + c] = p[c] * r * gain[c];
}

__global__ __launch_bounds__(256) void gemm(const float* A, int lda, const float* B, int ldb, float* C, int ldc, const float* R, int ldr, int N, int K) {
    __shared__ float As[16][64 + 4];
    __shared__ float Bs[16][64 + 4];
    const int bm = blockIdx.y * 64, bn = blockIdx.x * 64, tid = threadIdx.x, tx = tid & 15, ty = tid >> 4;
    float acc[4][4];
#pragma unroll
    for (int i = 0; i < 4; ++i)
#pragma unroll
        for (int j = 0; j < 4; ++j) acc[i][j] = 0.f;
    for (int k0 = 0; k0 < K; k0 += 16) {
        { const int r = tid >> 2, kq = (tid & 3) * 4; const float4 a = *(const float4*)&A[(size_t)(bm + r) * lda + k0 + kq];
          As[kq + 0][r] = a.x; As[kq + 1][r] = a.y; As[kq + 2][r] = a.z; As[kq + 3][r] = a.w; }
        { const int r = tid >> 4, c = (tid & 15) * 4; float4 b = make_float4(0.f, 0.f, 0.f, 0.f);
          if (bn + c < N) b = *(const float4*)&B[(size_t)(k0 + r) * ldb + bn + c];
          Bs[r][c + 0] = b.x; Bs[r][c + 1] = b.y; Bs[r][c + 2] = b.z; Bs[r][c + 3] = b.w; }
        __syncthreads();
#pragma unroll
        for (int kk = 0; kk < 16; ++kk) {
            float a[4], b[4];
#pragma unroll
            for (int i = 0; i < 4; ++i) a[i] = As[kk][ty * 4 + i];
#pragma unroll
            for (int j = 0; j < 4; ++j) b[j] = Bs[kk][tx * 4 + j];
#pragma unroll
            for (int i = 0; i < 4; ++i)
#pragma unroll
                for (int j = 0; j < 4; ++j) acc[i][j] += a[i] * b[j];
        }
        __syncthreads();
    }
#pragma unroll
    for (int i = 0; i < 4; ++i) {
        const int row = bm + ty * 4 + i;
#pragma unroll
        for (int j = 0; j < 4; ++j) { const int col = bn + tx * 4 + j; if (col < N) { float v = acc[i][j]; if (R) v += R[(size_t)row * ldr + col]; C[(size_t)row * ldc + col] = v; } }
    }
}

__device__ inline float inv_freq(int i, int dim) { return 1.0f / powf(THETA, (float)(2 * i) / (float)dim); }

__global__ void prep_mla(const float* h, const float* qa_raw, const float* kv_raw, const float* gq, const float* gk, float* q_a, float* k_a, float* v_a) {
    const int idx = blockIdx.x * blockDim.x + threadIdx.x; if (idx >= S * 6) return;
    const int s = idx / 6, hd = idx % 6;
    {
        const float* src = qa_raw + (size_t)s * 576 + hd * 96; float ss = 0.f;
        for (int d = 0; d < 96; ++d) ss += src[d] * src[d];
        const float r = rsqrtf(ss / 96.f + EPSV); float* dst = q_a + ((size_t)hd * S + s) * 96;
        for (int d = 0; d < 64; ++d) dst[d] = src[d] * r * gq[d];
        for (int i = 0; i < 16; ++i) { const float ang = (float)s * inv_freq(i, 32), c = cosf(ang), sn = sinf(ang);
            const float x1 = src[64 + i] * r * gq[64 + i], x2 = src[80 + i] * r * gq[80 + i];
            dst[64 + i] = x1 * c - x2 * sn; dst[80 + i] = x1 * sn + x2 * c; }
    }
    {
        const float* kn = kv_raw + (size_t)s * 768 + hd * 128; const float* kr = h + (size_t)s * INW + 640; float ss = 0.f;
        for (int d = 0; d < 64; ++d) ss += kn[d] * kn[d];
        for (int d = 0; d < 32; ++d) ss += kr[d] * kr[d];
        const float r = rsqrtf(ss / 96.f + EPSV); float* dst = k_a + ((size_t)hd * S + s) * 96;
        for (int d = 0; d < 64; ++d) dst[d] = kn[d] * r * gk[d];
        for (int i = 0; i < 16; ++i) { const float ang = (float)s * inv_freq(i, 32), c = cosf(ang), sn = sinf(ang);
            const float x1 = kr[i] * r * gk[64 + i], x2 = kr[16 + i] * r * gk[80 + i];
            dst[64 + i] = x1 * c - x2 * sn; dst[80 + i] = x1 * sn + x2 * c; }
        float* vd = v_a + ((size_t)hd * S + s) * 64;
        for (int d = 0; d < 64; ++d) vd[d] = kn[64 + d];
    }
}
__global__ void prep_diff(const float* h, const float* gq, const float* gk, float* q_b, float* k_b, float* v_b) {
    const int idx = blockIdx.x * blockDim.x + threadIdx.x; if (idx >= S * 8) return;
    const int s = idx / 8, hc = idx % 8;
    for (int which = 0; which < 2; ++which) {
        const float* src = h + (size_t)s * INW + (which ? 1184 : 672) + hc * 64; const float* g = which ? gk : gq; float ss = 0.f;
        for (int d = 0; d < 64; ++d) ss += src[d] * src[d];
        const float r = rsqrtf(ss / 64.f + EPSV); float* dst = (which ? k_b : q_b) + ((size_t)hc * S + s) * 64;
        for (int i = 0; i < 32; ++i) { const float ang = (float)s * inv_freq(i, 64), c = cosf(ang), sn = sinf(ang);
            const float x1 = src[i] * r * g[i], x2 = src[32 + i] * r * g[32 + i];
            dst[i] = x1 * c - x2 * sn; dst[32 + i] = x1 * sn + x2 * c; }
    }
    { const int hh = hc >> 1, half = hc & 1; const float* src = h + (size_t)s * INW + 1696 + hh * 128 + half * 64; float* dst = v_b + ((size_t)hh * S + s) * 128 + half * 64;
      for (int d = 0; d < 64; ++d) dst[d] = src[d]; }
}
__global__ void prep_gqa(const float* h, const float* gq, const float* gk, float* q_c, float* k_c, float* v_c) {
    const int idx = blockIdx.x * blockDim.x + threadIdx.x; if (idx >= S * 8) return;
    const int s = idx / 8, j = idx % 8;
    const bool isq = j < 6; const int hd = isq ? j : j - 6;
    const float* src = h + (size_t)s * INW + (isq ? 2208 : 2592) + hd * 64; const float* g = isq ? gq : gk; float ss = 0.f;
    for (int d = 0; d < 64; ++d) ss += src[d] * src[d];
    const float r = rsqrtf(ss / 64.f + EPSV); float* dst = (isq ? q_c : k_c) + ((size_t)hd * S + s) * 64;
    const int prow = s / 64, pcol = s % 64;
    for (int i = 0; i < 16; ++i) {
        { const float ang = (float)prow * inv_freq(i, 32), c = cosf(ang), sn = sinf(ang);
          const float x1 = src[i] * r * g[i], x2 = src[16 + i] * r * g[16 + i]; dst[i] = x1 * c - x2 * sn; dst[16 + i] = x1 * sn + x2 * c; }
        { const float ang = (float)pcol * inv_freq(i, 32), c = cosf(ang), sn = sinf(ang);
          const float x1 = src[32 + i] * r * g[32 + i], x2 = src[48 + i] * r * g[48 + i]; dst[32 + i] = x1 * c - x2 * sn; dst[48 + i] = x1 * sn + x2 * c; }
    }
    if (!isq) { const float* vs = h + (size_t)s * INW + 2720 + hd * 64; float* vd = v_c + ((size_t)hd * S + s) * 64; for (int d = 0; d < 64; ++d) vd[d] = vs[d]; }
}

template <int DQK, int DV>
__global__ __launch_bounds__(64) void attn(const float* q, const float* k, const float* v, float* out, int ldo, int ohs, int kdiv, int vdiv, float scale) {
    __shared__ float Ks[16][DQK];
    __shared__ float Vs[16][DV];
    const int qh = blockIdx.y, s = blockIdx.x * 64 + threadIdx.x, kh = qh / kdiv, vh = qh / vdiv;
    float qr[DQK], o[DV];
#pragma unroll
    for (int d = 0; d < DQK; ++d) qr[d] = q[((size_t)qh * S + s) * DQK + d] * scale;
#pragma unroll
    for (int d = 0; d < DV; ++d) o[d] = 0.f;
    float m = -1e30f, l = 0.f;
    for (int t0 = 0; t0 < S; t0 += 16) {
        __syncthreads();
        for (int e = threadIdx.x; e < 16 * DQK; e += 64) Ks[e / DQK][e % DQK] = k[((size_t)kh * S + t0) * DQK + e];
        for (int e = threadIdx.x; e < 16 * DV; e += 64) Vs[e / DV][e % DV] = v[((size_t)vh * S + t0) * DV + e];
        __syncthreads();
        for (int j = 0; j < 16; ++j) {
            float sc = 0.f;
#pragma unroll
            for (int d = 0; d < DQK; ++d) sc += qr[d] * Ks[j][d];
            if (sc > m) { const float f = __expf(m - sc); l *= f;
#pragma unroll
                for (int d = 0; d < DV; ++d) o[d] *= f;
                m = sc; }
            const float p = __expf(sc - m); l += p;
#pragma unroll
            for (int d = 0; d < DV; ++d) o[d] += p * Vs[j][d];
        }
    }
    const float il = 1.f / l;
#pragma unroll
    for (int d = 0; d < DV; ++d) out[(size_t)s * ldo + qh * ohs + d] = o[d] * il;
}

__global__ void diff_combine(const float* otmp, const float* lq1, const float* lk1, const float* lq2, const float* lk2, const float* og, float lambda_init, float* mix) {
    const int idx = blockIdx.x * blockDim.x + threadIdx.x; if (idx >= S * 4) return;
    const int s = idx / 4, hh = idx % 4;
    float d1 = 0.f, d2 = 0.f; for (int i = 0; i < 64; ++i) { d1 += lq1[i] * lk1[i]; d2 += lq2[i] * lk2[i]; }
    const float lam = expf(d1) - expf(d2) + lambda_init;
    const float* o0 = otmp + (size_t)s * 1024 + (hh * 2 + 0) * 128; const float* o1 = otmp + (size_t)s * 1024 + (hh * 2 + 1) * 128;
    float ss = 0.f; for (int d = 0; d < 128; ++d) { const float x = o0[d] - lam * o1[d]; ss += x * x; }
    const float r = rsqrtf(ss / 128.f + EPSV);
    for (int d = 0; d < 128; ++d) mix[(size_t)s * MIXW + 384 + hh * 128 + d] = (o0[d] - lam * o1[d]) * r * og[d] * (1.0f - lambda_init);
}
__global__ void swiglu(const float* gu, float* act) {
    const int idx = blockIdx.x * blockDim.x + threadIdx.x; if (idx >= S * FFH) return;
    const int s = idx / FFH, j = idx % FFH; const float g = gu[(size_t)s * 2 * FFH + j], u = gu[(size_t)s * 2 * FFH + FFH + j];
    act[idx] = g / (1.f + expf(-g)) * u;
}

struct Scratch { float *xn, *h, *cqn, *qaraw, *ckvn, *kvraw, *q_a, *k_a, *v_a, *q_b, *k_b, *v_b, *q_c, *k_c, *v_c, *otmp, *mix, *x1, *gu, *act; };
static Scratch carve(float* base) {
    Scratch sc; float* p = base;
    sc.xn = p; p += (size_t)S * DM; float* hreg = p; sc.h = p; p += (size_t)S * INW; sc.cqn = p; p += (size_t)S * 384; sc.qaraw = p; p += (size_t)S * 576;
    sc.ckvn = p; p += (size_t)S * 256; sc.kvraw = p; p += (size_t)S * 768; sc.q_a = p; p += (size_t)6 * S * 96; sc.k_a = p; p += (size_t)6 * S * 96; sc.v_a = p; p += (size_t)6 * S * 64;
    sc.q_b = p; p += (size_t)8 * S * 64; sc.k_b = p; p += (size_t)8 * S * 64; sc.v_b = p; p += (size_t)4 * S * 128; sc.q_c = p; p += (size_t)6 * S * 64; sc.k_c = p; p += (size_t)2 * S * 64; sc.v_c = p; p += (size_t)2 * S * 64;
    sc.otmp = p; p += (size_t)S * 1024;
    sc.gu = hreg; sc.act = hreg + (size_t)S * 2 * FFH;
    float* q = sc.act + (size_t)S * FFH; if (p > q) q = p;
    sc.mix = q; q += (size_t)S * MIXW; sc.x1 = q; q += (size_t)S * DM;
    return sc;
}
static size_t scratch_floats() { Scratch sc = carve((float*)0); return (size_t)(sc.x1 + (size_t)S * DM - (float*)0); }

static void layer(void* const* d_in, int l, const float* xin, float* xout, const Scratch& sc, hipStream_t st) {
    const float* attn_norm = (const float*)d_in[1] + (size_t)l * DM; const float* w_in = (const float*)d_in[2] + (size_t)l * DM * INW;
    const float* mla_q_norm = (const float*)d_in[3] + l * 384; const float* w_uq = (const float*)d_in[4] + (size_t)l * 384 * 576;
    const float* mla_kv_norm = (const float*)d_in[5] + l * 256; const float* w_ukv = (const float*)d_in[6] + (size_t)l * 256 * 768;
    const float* mla_q_gain = (const float*)d_in[7] + l * 96; const float* mla_k_gain = (const float*)d_in[8] + l * 96;
    const float* diff_q_gain = (const float*)d_in[9] + l * 64; const float* diff_k_gain = (const float*)d_in[10] + l * 64;
    const float* lq1 = (const float*)d_in[11] + l * 64; const float* lk1 = (const float*)d_in[12] + l * 64; const float* lq2 = (const float*)d_in[13] + l * 64; const float* lk2 = (const float*)d_in[14] + l * 64;
    const float* diff_out_gain = (const float*)d_in[15] + l * 128; const float* gqa_q_gain = (const float*)d_in[16] + l * 64; const float* gqa_k_gain = (const float*)d_in[17] + l * 64;
    const float* w_o = (const float*)d_in[18] + (size_t)l * MIXW * DM; const float* ffn_norm = (const float*)d_in[19] + (size_t)l * DM;
    const float* w_gu = (const float*)d_in[20] + (size_t)l * DM * 2 * FFH; const float* w_down = (const float*)d_in[21] + (size_t)l * FFH * DM;
    const float lambda_init = 0.8f - 0.6f * expf(-0.3f * (float)l);
    rms_rows<<<S / 4, 256, 0, st>>>(xin, DM, DM, attn_norm, sc.xn, DM, S);
    gemm<<<dim3((INW + 63) / 64, S / 64), 256, 0, st>>>(sc.xn, DM, w_in, INW, sc.h, INW, nullptr, 0, INW, DM);
    rms_rows<<<S / 4, 256, 0, st>>>(sc.h, INW, 384, mla_q_norm, sc.cqn, 384, S);
    gemm<<<dim3(576 / 64, S / 64), 256, 0, st>>>(sc.cqn, 384, w_uq, 576, sc.qaraw, 576, nullptr, 0, 576, 384);
    rms_rows<<<S / 4, 256, 0, st>>>(sc.h + 384, INW, 256, mla_kv_norm, sc.ckvn, 256, S);
    gemm<<<dim3(768 / 64, S / 64), 256, 0, st>>>(sc.ckvn, 256, w_ukv, 768, sc.kvraw, 768, nullptr, 0, 768, 256);
    prep_mla<<<(S * 6 + 255) / 256, 256, 0, st>>>(sc.h, sc.qaraw, sc.kvraw, mla_q_gain, mla_k_gain, sc.q_a, sc.k_a, sc.v_a);
    prep_diff<<<(S * 8 + 255) / 256, 256, 0, st>>>(sc.h, diff_q_gain, diff_k_gain, sc.q_b, sc.k_b, sc.v_b);
    prep_gqa<<<(S * 8 + 255) / 256, 256, 0, st>>>(sc.h, gqa_q_gain, gqa_k_gain, sc.q_c, sc.k_c, sc.v_c);
    attn<96, 64><<<dim3(S / 64, 6), 64, 0, st>>>(sc.q_a, sc.k_a, sc.v_a, sc.mix, MIXW, 64, 1, 1, 1.0f / sqrtf(96.f));
    attn<64, 128><<<dim3(S / 64, 8), 64, 0, st>>>(sc.q_b, sc.k_b, sc.v_b, sc.otmp, 1024, 128, 1, 2, 0.125f);
    diff_combine<<<(S * 4 + 255) / 256, 256, 0, st>>>(sc.otmp, lq1, lk1, lq2, lk2, diff_out_gain, lambda_init, sc.mix);
    attn<64, 64><<<dim3(S / 64, 6), 64, 0, st>>>(sc.q_c, sc.k_c, sc.v_c, sc.mix + 896, MIXW, 64, 3, 3, 0.125f);
    gemm<<<dim3(DM / 64, S / 64), 256, 0, st>>>(sc.mix, MIXW, w_o, DM, sc.x1, DM, xin, DM, DM, MIXW);
    rms_rows<<<S / 4, 256, 0, st>>>(sc.x1, DM, DM, ffn_norm, sc.xn, DM, S);
    gemm<<<dim3(2 * FFH / 64, S / 64), 256, 0, st>>>(sc.xn, DM, w_gu, 2 * FFH, sc.gu, 2 * FFH, nullptr, 0, 2 * FFH, DM);
    swiglu<<<(S * FFH + 255) / 256, 256, 0, st>>>(sc.gu, sc.act);
    gemm<<<dim3(DM / 64, S / 64), 256, 0, st>>>(sc.act, FFH, w_down, DM, xout, DM, sc.x1, DM, DM, FFH);
}
}
extern "C" void kernel_launch(void* const* d_in, const int* in_sizes, int n_in, void* d_out, int out_size, void* d_ws, size_t ws_size, hipStream_t stream) {
    const nv::Scratch sc = nv::carve((float*)d_ws);
    float* xmid = (float*)d_ws + nv::scratch_floats();
    for (int b = 0; b < 8; ++b) {
        const float* xin = (const float*)d_in[0] + (size_t)b * nv::S * nv::DM; float* xout = (float*)d_out + (size_t)b * nv::S * nv::DM;
        nv::layer(d_in, 0, xin, xmid, sc, stream);
        nv::layer(d_in, 1, xmid, xout, sc, stream);
    }
}
```

```cpp
#include <hip/hip_runtime.h>
#include <cstdio>
#include <cstdint>
constexpr int NWAVES = 8;
constexpr int BATCH = 8, SEQ = 2048, DMODEL = 1024, M = BATCH * SEQ, DEPTH = 2, INW = 2848, FFH = 2816, MIXW = 1280;
constexpr int NPHASE = 1 + 6 * DEPTH;
constexpr size_t MiB = 1u << 20;
constexpr size_t WS_CTL = 0, CTL_ZERO_BYTES = 64 * 1024;
constexpr size_t WS_TAB = 1 * MiB;
constexpr size_t TAB_MLA_COS = 0, TAB_MLA_SIN = 131072, TAB_DIF_COS = 262144, TAB_DIF_SIN = 524288, TAB_ROW_COS = 786432, TAB_ROW_SIN = 788480, TAB_COL_COS = 790528, TAB_COL_SIN = 794624, TAB_CONST = 798720, TAB_GAIN = 799232;
constexpr int GN_MQ = 0, GN_MK = 96, GN_DQ = 192, GN_DK = 256, GN_GQ = 320, GN_GK = 384, GN_OG = 448, GN_STRIDE = 576;
constexpr size_t WS_SSQ = 2 * MiB;
constexpr size_t SSQ_X = 0, SSQ_Q = 262144, SSQ_KV = 786432, SSQ_KR = 1048576;
constexpr size_t WS_W = 4 * MiB;
constexpr size_t W_IN = 0, W_UQ = 6291456, W_UKV = W_UQ + 589824, W_O = W_UKV + 393216, W_GU = W_O + 2621440, W_DN = W_GU + 11534336, W_LAYER = W_DN + 5767168;
static_assert(WS_W + 2 * W_LAYER <= 56 * MiB, "weights");
constexpr size_t WS_XB = 56 * MiB;
constexpr size_t WS_MIX = 88 * MiB;
constexpr size_t MIX_CQ = 0, MIX_CKV = 12 * MiB, MIX_KR = 20 * MiB;
constexpr size_t WS_QKV = 128 * MiB;
constexpr size_t QA = 0, KA = 18 * MiB, VA = 36 * MiB, QB = 48 * MiB, KB = 64 * MiB, VB = 80 * MiB, QC = 96 * MiB, KC = 108 * MiB, VC = 112 * MiB, QKV_END = 116 * MiB;
constexpr size_t WS_GOLD = 244 * MiB, WS_END = 256 * MiB;
static_assert(WS_QKV + QKV_END <= WS_GOLD, "ws map");
constexpr int CW_BAR = 1024;
constexpr int RING_OFF = 0, RING_BYTES = 139264, LDSCTL_OFF = RING_BYTES, MISC_OFF = LDSCTL_OFF + 320, LDS_BYTES = 147456;

namespace pg8 {
#define PG8_LAS __attribute__((address_space(3)))
typedef unsigned short bf16_t;
typedef short bf16x8 __attribute__((ext_vector_type(8)));
typedef float f32x4 __attribute__((ext_vector_type(4)));
typedef unsigned u32x4 __attribute__((ext_vector_type(4)));
constexpr int BM = 256, BK = 64, HALF = 128, HTB = HALF * BK * 2  , STAGE_BYTES = 8 * HTB, NXCD = 8, WGM = 8;

__host__ __device__ __forceinline__ int lds_byte(int r, int c) { const int st = (r >> 4) * 2 + (c >> 5), rr = r & 15, cc = c & 31, ob = rr * 64 + cc * 2; return st * 1024 + (ob ^ (((ob >> 9) & 1) << 5)); }
__host__ __device__ __forceinline__ void stage_rc(int b, int& R, int& C) { const int st = b / 1024, sb = b % 1024, swz = sb ^ (((sb >> 9) & 1) << 5); R = (st >> 1) * 16 + swz / 64; C = (st & 1) * 32 + (swz % 64) / 2; }
__host__ __device__ __forceinline__ int perm32(int rho) { const int n = rho >> 4, i = rho & 15; return 8 * (i >> 2) + 4 * n + (i & 3); }

struct Unit { int pm, pn; };
struct Gemm { const bf16_t* A; const bf16_t* Bt; int M, N, K; };

struct StaticOrder {
    int nM, nN, nwg, G, c;
    __host__ __device__ void init(int M, int N, int G_, int c_) { nM = M / BM; nN = N / BM; nwg = nM * nN; G = G_; c = c_; }
    __host__ __device__ bool next(int i, Unit& u) const {
        const long L = (long)i * G + c; if (L >= nwg) return false;
        int wgid = (int)L; { const int q = nwg / NXCD, r = nwg % NXCD, xcd = wgid % NXCD, off = wgid / NXCD; wgid = (xcd < r ? xcd * (q + 1) : r * (q + 1) + (xcd - r) * q) + off; }
        const int nig = WGM * nN, gid = wgid / nig, fm = gid * WGM, gsz = (nM - fm) < WGM ? (nM - fm) : WGM;
        u.pm = fm + ((wgid % nig) % gsz); u.pn = (wgid % nig) / gsz; return true;
    }
    __device__ __forceinline__ void a_ready(const Unit&) const {}
    __device__ __forceinline__ void done(const Unit&) const {}
};

__device__ __forceinline__ unsigned cvt_pk_bf16(float lo, float hi) { unsigned r; asm volatile("v_cvt_pk_bf16_f32 %0, %1, %2" : "=v"(r) : "v"(lo), "v"(hi)); return r; }
typedef float f32x2 __attribute__((ext_vector_type(2)));
constexpr float EPS_RMS = 1e-6f;
constexpr float LOG2E = 1.4426950408889634f;
constexpr float C2_MLA = 0.10206207261596575f * LOG2E;
constexpr float C2_64 = 0.125f * LOG2E;
typedef unsigned u32x2 __attribute__((ext_vector_type(2)));
__device__ __forceinline__ u32x2 pk4(f32x4 v) { u32x2 w; w.x = cvt_pk_bf16(v[0], v[1]); w.y = cvt_pk_bf16(v[2], v[3]); return w; }
__device__ __forceinline__ void st4(bf16_t* p, f32x4 v) { u32x2 w; w.x = cvt_pk_bf16(v[0], v[1]); w.y = cvt_pk_bf16(v[2], v[3]); *(u32x2*)p = w; }
__device__ __forceinline__ float dot4(f32x4 a) { return (a[0] * a[0] + a[1] * a[1]) + (a[2] * a[2] + a[3] * a[3]); }
__device__ __forceinline__ float qsum(float s) {
    const auto r = __builtin_amdgcn_permlane16_swap(__float_as_uint(s), __float_as_uint(s), false, false);
    const float t = __uint_as_float(r[0]) + __uint_as_float(r[1]);
    const auto q = __builtin_amdgcn_permlane32_swap(__float_as_uint(t), __float_as_uint(t), false, false);
    return __uint_as_float(q[0]) + __uint_as_float(q[1]);
}
__device__ __forceinline__ f32x4 bf4_to_f32(u32x2 w) { f32x4 r; r[0] = __uint_as_float(w.x << 16); r[1] = __uint_as_float(w.x & 0xffff0000u); r[2] = __uint_as_float(w.y << 16); r[3] = __uint_as_float(w.y & 0xffff0000u); return r; }

#define WSF(off) ((float*)(ws + (off)))
#define WSH(off) ((bf16_t*)(ws + (off)))
struct EpiInProj {
    static constexpr bool PERM = false, AFTER_DRAIN = false;
    unsigned char* ws; unsigned char* hs; int l;
    template <int MODE>
    __device__ __forceinline__ void body(const f32x4 (&acc)[2][2][4][2], const Unit& u, int wr, int wc, int fr, int fq) const {
        float rs[4];
        auto rs_load = [&](int ai) {
#pragma unroll
            for (int m = 0; m < 4; ++m) { const int row = u.pm * BM + ai * HALF + wr * 64 + m * 16 + fr;
                const f32x4 sq = *(const f32x4*)(WSF(WS_SSQ + SSQ_X) + (size_t)row * 4); rs[m] = rsqrtf(((sq[0] + sq[1]) + (sq[2] + sq[3])) * (1.0f / 1024.0f) + EPS_RMS); } };
        rs_load(0);
        const int c0 = wc * 32 + 4 * fq;
        const int c8 = wc * 32 + 8 * fq;
        f32x4 tcur[4];
        auto tab_load = [&](f32x4 (&t)[4], int it) {
            const int s = (u.pm * BM + (it >> 2) * HALF + wr * 64 + (it & 3) * 16 + fr) & 2047;
            if constexpr (MODE == 3 || MODE == 4) {
                t[0] = *(const f32x4*)(WSF(WS_TAB + TAB_DIF_COS) + s * 32 + 8 * fq); t[1] = *(const f32x4*)(WSF(WS_TAB + TAB_DIF_SIN) + s * 32 + 8 * fq);
                t[2] = *(const f32x4*)(WSF(WS_TAB + TAB_DIF_COS) + s * 32 + 8 * fq + 4); t[3] = *(const f32x4*)(WSF(WS_TAB + TAB_DIF_SIN) + s * 32 + 8 * fq + 4);
            } else if constexpr (MODE == 6) {
                t[0] = *(const f32x4*)(WSF(WS_TAB + TAB_ROW_COS) + (s >> 6) * 16 + 4 * fq); t[1] = *(const f32x4*)(WSF(WS_TAB + TAB_ROW_SIN) + (s >> 6) * 16 + 4 * fq);
                t[2] = *(const f32x4*)(WSF(WS_TAB + TAB_COL_COS) + (s & 63) * 16 + 4 * fq); t[3] = *(const f32x4*)(WSF(WS_TAB + TAB_COL_SIN) + (s & 63) * 16 + 4 * fq);
            }
        };
        f32x4 gg[4];
        if constexpr (MODE == 3 || MODE == 4) { const float* g = WSF(WS_TAB + TAB_GAIN) + l * GN_STRIDE + (MODE == 3 ? GN_DQ : GN_DK);
            gg[0] = *(const f32x4*)(g + 8 * fq); gg[1] = *(const f32x4*)(g + 32 + 8 * fq); gg[2] = *(const f32x4*)(g + 8 * fq + 4); gg[3] = *(const f32x4*)(g + 32 + 8 * fq + 4); }
        const bool isq = (u.pn == 9) || (wc < 2);
        if constexpr (MODE == 6) { const float* g = WSF(WS_TAB + TAB_GAIN) + l * GN_STRIDE + (isq ? GN_GQ : GN_GK);
            gg[0] = *(const f32x4*)(g + 4 * fq); gg[1] = *(const f32x4*)(g + 16 + 4 * fq); gg[2] = *(const f32x4*)(g + 32 + 4 * fq); gg[3] = *(const f32x4*)(g + 48 + 4 * fq); }
        if constexpr (MODE == 3 || MODE == 4 || MODE == 6) tab_load(tcur, 0);
#pragma unroll
        for (int it = 0; it < 8; ++it) {
                const int ai = it >> 2, m = it & 3;
                const int row = u.pm * BM + ai * HALF + wr * 64 + m * 16 + fr, b = row >> 11, s = row & 2047;
                f32x4 v[2][2];
#pragma unroll
                for (int bj = 0; bj < 2; ++bj)
#pragma unroll
                    for (int n = 0; n < 2; ++n) v[bj][n] = acc[ai][bj][m][n] * rs[m];
                if (it == 3) rs_load(1);
                if constexpr (MODE == 0) {
#pragma unroll
                    for (int bj = 0; bj < 2; ++bj) { u32x4 w_; w_.x = cvt_pk_bf16(v[bj][0][0], v[bj][0][1]); w_.y = cvt_pk_bf16(v[bj][0][2], v[bj][0][3]); w_.z = cvt_pk_bf16(v[bj][1][0], v[bj][1][1]); w_.w = cvt_pk_bf16(v[bj][1][2], v[bj][1][3]); *(u32x4*)(((bf16_t*)(hs + MIX_CQ)) + (size_t)row * 384 + bj * HALF + c8) = w_; }
                    const float ss = qsum((dot4(v[0][0]) + dot4(v[0][1])) + (dot4(v[1][0]) + dot4(v[1][1])));
                    if (fq == 0) WSF(WS_SSQ + SSQ_Q)[(size_t)row * 8 + wc] = ss;
                } else if constexpr (MODE == 1) {
                    { u32x4 w_; w_.x = cvt_pk_bf16(v[0][0][0], v[0][0][1]); w_.y = cvt_pk_bf16(v[0][0][2], v[0][0][3]); w_.z = cvt_pk_bf16(v[0][1][0], v[0][1][1]); w_.w = cvt_pk_bf16(v[0][1][2], v[0][1][3]); *(u32x4*)(((bf16_t*)(hs + MIX_CQ)) + (size_t)row * 384 + 256 + c8) = w_; }
                    const float ss = qsum(dot4(v[0][0]) + dot4(v[0][1]));
                    if (fq == 0) WSF(WS_SSQ + SSQ_Q)[(size_t)row * 8 + 4 + wc] = ss;
                    const int kv = wc >> 1, d = (wc & 1) * 32 + 8 * fq;
                    { u32x4 w_; w_.x = cvt_pk_bf16(v[1][0][0], v[1][0][1]); w_.y = cvt_pk_bf16(v[1][0][2], v[1][0][3]); w_.z = cvt_pk_bf16(v[1][1][0], v[1][1][1]); w_.w = cvt_pk_bf16(v[1][1][2], v[1][1][3]); *(u32x4*)(WSH(WS_QKV + VC) + ((size_t)(b * 2 + kv) * 2048 + s) * 64 + d) = w_; }
                } else if constexpr (MODE == 2) {
#pragma unroll
                    for (int bj = 0; bj < 2; ++bj) { u32x4 w_; w_.x = cvt_pk_bf16(v[bj][0][0], v[bj][0][1]); w_.y = cvt_pk_bf16(v[bj][0][2], v[bj][0][3]); w_.z = cvt_pk_bf16(v[bj][1][0], v[bj][1][1]); w_.w = cvt_pk_bf16(v[bj][1][2], v[bj][1][3]); *(u32x4*)(((bf16_t*)(hs + MIX_CKV)) + (size_t)row * 256 + bj * HALF + c8) = w_; }
                    const float ss = qsum((dot4(v[0][0]) + dot4(v[0][1])) + (dot4(v[1][0]) + dot4(v[1][1])));
                    if (fq == 0) WSF(WS_SSQ + SSQ_KV)[(size_t)row * 4 + wc] = ss;
                } else if constexpr (MODE == 3 || MODE == 4) {
                    const int hc = 4 * (u.pn - (MODE == 3 ? 3 : 5)) + wc;
                    const float ss = qsum((dot4(v[0][0]) + dot4(v[0][1])) + (dot4(v[1][0]) + dot4(v[1][1])));
                    const float r = rsqrtf(ss * (1.0f / 64.0f) + EPS_RMS) * (MODE == 3 ? C2_64 : 1.0f);
                    bf16_t* dst = WSH(WS_QKV + (MODE == 3 ? QB : KB)) + ((size_t)(b * 4 + (hc >> 1)) * 2048 + s) * 128 + (hc & 1) * 64;
                    u32x2 ow[4];
#pragma unroll
                    for (int n = 0; n < 2; ++n) {
                        const f32x4 cs = tcur[2 * n], sn = tcur[2 * n + 1];
                        const f32x4 x1 = v[0][n] * gg[2 * n] * r, x2 = v[1][n] * gg[2 * n + 1] * r;
                        ow[2 * n] = pk4(x1 * cs - x2 * sn); ow[2 * n + 1] = pk4(x1 * sn + x2 * cs);
                    }
                    if (it + 1 < 8) tab_load(tcur, it + 1);
                    { u32x4 w0, w1; w0.x = ow[0].x; w0.y = ow[0].y; w0.z = ow[2].x; w0.w = ow[2].y; w1.x = ow[1].x; w1.y = ow[1].y; w1.z = ow[3].x; w1.w = ow[3].y;
                      *(u32x4*)(dst + 8 * fq) = w0; *(u32x4*)(dst + 32 + 8 * fq) = w1; }
                } else if constexpr (MODE == 5) {
#pragma unroll
                    for (int bj = 0; bj < 2; ++bj) { const int col = (u.pn - 7) * 256 + bj * HALF + c8;
                        { u32x4 w_; w_.x = cvt_pk_bf16(v[bj][0][0], v[bj][0][1]); w_.y = cvt_pk_bf16(v[bj][0][2], v[bj][0][3]); w_.z = cvt_pk_bf16(v[bj][1][0], v[bj][1][1]); w_.w = cvt_pk_bf16(v[bj][1][2], v[bj][1][3]); *(u32x4*)(WSH(WS_QKV + VB) + ((size_t)(b * 4 + (col >> 7)) * 2048 + s) * 128 + (col & 127)) = w_; } }
                } else if constexpr (MODE == 6) {
                    const int hd = (u.pn == 9) ? wc : (wc < 2 ? 4 + wc : wc - 2);
                    const float ss = qsum((dot4(v[0][0]) + dot4(v[0][1])) + (dot4(v[1][0]) + dot4(v[1][1])));
                    const float r = rsqrtf(ss * (1.0f / 64.0f) + EPS_RMS) * (isq ? C2_64 : 1.0f);
                    bf16_t* dst = isq ? WSH(WS_QKV + QC) + ((size_t)(b * 6 + hd) * 2048 + s) * 64 : WSH(WS_QKV + KC) + ((size_t)(b * 2 + hd) * 2048 + s) * 64;
                    const int f = 4 * fq;
                    u32x2 ow[4];
#pragma unroll
                    for (int bj = 0; bj < 2; ++bj) {
                        const f32x4 cs = tcur[2 * bj], sn = tcur[2 * bj + 1];
                        const f32x4 x1 = v[bj][0] * gg[2 * bj] * r, x2 = v[bj][1] * gg[2 * bj + 1] * r;
                        ow[2 * bj] = pk4(x1 * cs - x2 * sn); ow[2 * bj + 1] = pk4(x1 * sn + x2 * cs);
                    }
                    if (it + 1 < 8) tab_load(tcur, it + 1);
#pragma unroll
                    for (int bj = 0; bj < 2; ++bj) { *(u32x2*)(dst + 32 * bj + f) = ow[2 * bj]; *(u32x2*)(dst + 32 * bj + 16 + f) = ow[2 * bj + 1]; }
                } else {
                    if (wc == 0) {
                        { u32x4 w_; w_.x = cvt_pk_bf16(v[0][0][0], v[0][0][1]); w_.y = cvt_pk_bf16(v[0][0][2], v[0][0][3]); w_.z = cvt_pk_bf16(v[0][1][0], v[0][1][1]); w_.w = cvt_pk_bf16(v[0][1][2], v[0][1][3]); *(u32x4*)(((bf16_t*)(hs + MIX_KR)) + (size_t)row * 32 + 8 * fq) = w_; }
                        const float ss = qsum(dot4(v[0][0]) + dot4(v[0][1]));
                        if (fq == 0) WSF(WS_SSQ + SSQ_KR)[row] = ss;
                    }
                }
        }
    }
    __device__ __forceinline__ void operator()(const f32x4 (&acc)[2][2][4][2], const Unit& u, int wr, int wc, int fr, int fq) const {
        asm volatile("" : "+v"(fr), "+v"(fq));
        switch (u.pn) {
            case 0: body<0>(acc, u, wr, wc, fr, fq); break;
            case 1: body<1>(acc, u, wr, wc, fr, fq); break;
            case 2: body<2>(acc, u, wr, wc, fr, fq); break;
            case 3: case 4: body<3>(acc, u, wr, wc, fr, fq); break;
            case 5: case 6: body<4>(acc, u, wr, wc, fr, fq); break;
            case 7: case 8: body<5>(acc, u, wr, wc, fr, fq); break;
            case 9: case 10: body<6>(acc, u, wr, wc, fr, fq); break;
            default: body<7>(acc, u, wr, wc, fr, fq); break;
        }
    }
};

#define EPI_BAR() do { asm volatile("s_waitcnt lgkmcnt(0)" ::: "memory"); __builtin_amdgcn_s_barrier(); asm volatile("" ::: "memory"); } while (0)

struct EpiMlaQ {
    static constexpr bool PERM = false, AFTER_DRAIN = true;
    unsigned char* ws; int l;
    __device__ __forceinline__ void fused(f32x4 (&acc)[2][2][4][2], const Unit& u, int wr, int wc, int fr, int fq, PG8_LAS unsigned char* lds, int wid, int lane) const {
        asm volatile("" : "+v"(fr), "+v"(fq), "+v"(lane));
        PG8_LAS float* P = (PG8_LAS float*)lds;
        float rs[8];
        { f32x4 s0[8], s1[8];
#pragma unroll
          for (int it = 0; it < 8; ++it) { const int row = u.pm * BM + (it >> 2) * HALF + wr * 64 + (it & 3) * 16 + fr; s0[it] = *(const f32x4*)(WSF(WS_SSQ + SSQ_Q) + (size_t)row * 8); s1[it] = *(const f32x4*)(WSF(WS_SSQ + SSQ_Q) + (size_t)row * 8 + 4); }
#pragma unroll
          for (int it = 0; it < 8; ++it) rs[it] = rsqrtf((((s0[it][0] + s0[it][1]) + (s0[it][2] + s0[it][3])) + ((s1[it][0] + s1[it][1]) + (s1[it][2] + s1[it][3]))) * (1.0f / 384.0f) + EPS_RMS); }
        const float* gq = WSF(WS_TAB + TAB_GAIN) + l * GN_STRIDE + GN_MQ;
        f32x4 g0, g1, cs[4], sn[4];
        if (wc < 2) { g0 = *(const f32x4*)(gq + wc * 32 + 8 * fq); g1 = *(const f32x4*)(gq + wc * 32 + 8 * fq + 4); }
        else { g0 = *(const f32x4*)(gq + 64 + 4 * fq); g1 = *(const f32x4*)(gq + 80 + 4 * fq); }
#pragma unroll
        for (int it = 0; it < 8; ++it) {
            const int ai = it >> 2, m = it & 3, rl = ai * HALF + wr * 64 + m * 16 + fr;
#pragma unroll
            for (int bj = 0; bj < 2; ++bj) {
                acc[ai][bj][m][0] = acc[ai][bj][m][0] * rs[it]; acc[ai][bj][m][1] = acc[ai][bj][m][1] * rs[it];
                const float ss = qsum(dot4(acc[ai][bj][m][0]) + dot4(acc[ai][bj][m][1]));
                if (fq == 0) P[(rl * 2 + bj) * 4 + wc] = ss;
            }
        }
        EPI_BAR();
        bf16_t* qa = WSH(WS_QKV + QA);
        if (wc < 3) {
#pragma unroll
            for (int it = 0; it < 8; ++it) {
                const int ai = it >> 2, m = it & 3, rl = ai * HALF + wr * 64 + m * 16 + fr, row = u.pm * BM + rl, b = row >> 11, s = row & 2047;
                if (m == 0 && wc == 2) {
#pragma unroll
                    for (int q = 0; q < 4; ++q) { const int sq_ = (u.pm * BM + ai * HALF + wr * 64 + q * 16 + fr) & 2047;
                        cs[q] = *(const f32x4*)(WSF(WS_TAB + TAB_MLA_COS) + sq_ * 16 + 4 * fq); sn[q] = *(const f32x4*)(WSF(WS_TAB + TAB_MLA_SIN) + sq_ * 16 + 4 * fq); }
                }
#pragma unroll
                for (int bj = 0; bj < 2; ++bj) {
                    const f32x4 pp = *(const PG8_LAS f32x4*)(P + (rl * 2 + bj) * 4);
                    const float r = rsqrtf((pp[0] + pp[1] + pp[2]) * (1.0f / 96.0f) + EPS_RMS) * C2_MLA;
                    bf16_t* dst = qa + ((size_t)(b * 6 + 2 * u.pn + bj) * 2048 + s) * 96;
                    if (wc < 2) { const f32x4 y0 = acc[ai][bj][m][0] * g0 * r, y1 = acc[ai][bj][m][1] * g1 * r; u32x4 w_; w_.x = cvt_pk_bf16(y0[0], y0[1]); w_.y = cvt_pk_bf16(y0[2], y0[3]); w_.z = cvt_pk_bf16(y1[0], y1[1]); w_.w = cvt_pk_bf16(y1[2], y1[3]);
                        *(u32x4*)(dst + wc * 32 + 8 * fq) = w_; }
                    else { const f32x4 x1 = acc[ai][bj][m][0] * g0 * r, x2 = acc[ai][bj][m][1] * g1 * r;
                        st4(dst + 64 + 4 * fq, x1 * cs[m] - x2 * sn[m]); st4(dst + 80 + 4 * fq, x1 * sn[m] + x2 * cs[m]); }
                }
            }
        }
    }
};
struct EpiMlaKV {
    static constexpr bool PERM = false, AFTER_DRAIN = true;
    unsigned char* ws; unsigned char* hs; int l;
    __device__ __forceinline__ void fused(f32x4 (&acc)[2][2][4][2], const Unit& u, int wr, int wc, int fr, int fq, PG8_LAS unsigned char* lds, int wid, int lane) const {
        asm volatile("" : "+v"(fr), "+v"(fq), "+v"(lane));
        PG8_LAS float* P = (PG8_LAS float*)lds;
        float rs[8], skr[4];
        { f32x4 s0[8];
#pragma unroll
          for (int it = 0; it < 8; ++it) { const int row = u.pm * BM + (it >> 2) * HALF + wr * 64 + (it & 3) * 16 + fr; s0[it] = *(const f32x4*)(WSF(WS_SSQ + SSQ_KV) + (size_t)row * 4); }
#pragma unroll
          for (int it = 0; it < 8; ++it) rs[it] = rsqrtf(((s0[it][0] + s0[it][1]) + (s0[it][2] + s0[it][3])) * (1.0f / 256.0f) + EPS_RMS); }
        const float* gk = WSF(WS_TAB + TAB_GAIN) + l * GN_STRIDE + GN_MK;
        f32x4 g0, g1, gr0, gr1;
        g0 = *(const f32x4*)(gk + (wc & 1) * 32 + 8 * fq); g1 = *(const f32x4*)(gk + (wc & 1) * 32 + 8 * fq + 4);   gr0 = *(const f32x4*)(gk + 64 + 4 * fq); gr1 = *(const f32x4*)(gk + 80 + 4 * fq);
        f32x4 cs[4], sn[4]; u32x2 kr1[4], kr2[4];
#pragma unroll
        for (int it = 0; it < 8; ++it) {
            const int ai = it >> 2, m = it & 3, rl = ai * HALF + wr * 64 + m * 16 + fr;
#pragma unroll
            for (int bj = 0; bj < 2; ++bj) {
                acc[ai][bj][m][0] = acc[ai][bj][m][0] * rs[it]; acc[ai][bj][m][1] = acc[ai][bj][m][1] * rs[it];
                if (wc < 2) { const float ss = qsum(dot4(acc[ai][bj][m][0]) + dot4(acc[ai][bj][m][1])); if (fq == 0) P[(rl * 2 + bj) * 2 + wc] = ss; }
            }
        }
        EPI_BAR();
        bf16_t* ka = WSH(WS_QKV + KA); bf16_t* va = WSH(WS_QKV + VA);
#pragma unroll
        for (int it = 0; it < 8; ++it) {
            const int ai = it >> 2, m = it & 3, rl = ai * HALF + wr * 64 + m * 16 + fr, row = u.pm * BM + rl, b = row >> 11, s = row & 2047;
            if (m == 0 && wc < 2) {
#pragma unroll
                for (int q = 0; q < 4; ++q) { const int rq = u.pm * BM + ai * HALF + wr * 64 + q * 16 + fr, sq_ = rq & 2047;
                    cs[q] = *(const f32x4*)(WSF(WS_TAB + TAB_MLA_COS) + sq_ * 16 + 4 * fq); sn[q] = *(const f32x4*)(WSF(WS_TAB + TAB_MLA_SIN) + sq_ * 16 + 4 * fq);
                    kr1[q] = *(const u32x2*)(((bf16_t*)(hs + MIX_KR)) + (size_t)rq * 32 + 4 * fq); kr2[q] = *(const u32x2*)(((bf16_t*)(hs + MIX_KR)) + (size_t)rq * 32 + 16 + 4 * fq); skr[q] = WSF(WS_SSQ + SSQ_KR)[rq]; }
            }
#pragma unroll
            for (int bj = 0; bj < 2; ++bj) {
                const size_t hrow = (size_t)(b * 6 + 2 * u.pn + bj) * 2048 + s;
                if (wc < 2) {
                    const float r = rsqrtf((P[(rl * 2 + bj) * 2] + P[(rl * 2 + bj) * 2 + 1] + skr[m]) * (1.0f / 96.0f) + EPS_RMS);
                    bf16_t* dst = ka + hrow * 96;
                    { const f32x4 y0 = acc[ai][bj][m][0] * g0 * r, y1 = acc[ai][bj][m][1] * g1 * r; u32x4 w_; w_.x = cvt_pk_bf16(y0[0], y0[1]); w_.y = cvt_pk_bf16(y0[2], y0[3]); w_.z = cvt_pk_bf16(y1[0], y1[1]); w_.w = cvt_pk_bf16(y1[2], y1[3]);
                      *(u32x4*)(dst + wc * 32 + 8 * fq) = w_; }
                    if (wc == bj) {
                        const f32x4 x1 = bf4_to_f32(kr1[m]) * gr0 * r, x2 = bf4_to_f32(kr2[m]) * gr1 * r;
                        st4(dst + 64 + 4 * fq, x1 * cs[m] - x2 * sn[m]); st4(dst + 80 + 4 * fq, x1 * sn[m] + x2 * cs[m]);
                    }
                } else {
                    bf16_t* dst = va + hrow * 64;
                    { const f32x4 y0 = acc[ai][bj][m][0], y1 = acc[ai][bj][m][1]; u32x4 w_; w_.x = cvt_pk_bf16(y0[0], y0[1]); w_.y = cvt_pk_bf16(y0[2], y0[3]); w_.z = cvt_pk_bf16(y1[0], y1[1]); w_.w = cvt_pk_bf16(y1[2], y1[3]);
                      *(u32x4*)(dst + (wc - 2) * 32 + 8 * fq) = w_; }
                }
            }
        }
    }
};
struct EpiRes {
    static constexpr bool PERM = true, AFTER_DRAIN = true;
    float* out; unsigned char* ws; int final_;
    __device__ __forceinline__ void fused(f32x4 (&acc)[2][2][4][2], const Unit& u, int wr, int wc, int fr, int fq, PG8_LAS unsigned char* lds, int wid, int lane) const {
        asm volatile("" : "+v"(fr), "+v"(fq), "+v"(lane));
        PG8_LAS float* P = (PG8_LAS float*)lds;
        const int col0 = u.pn * BM + wc * 32 + 8 * fq;
#pragma unroll
        for (int ai = 0; ai < 2; ++ai) {
            u32x4 bs[4][2];
#pragma unroll
            for (int m = 0; m < 4; ++m) { const size_t off = (size_t)(u.pm * BM + ai * HALF + wr * 64 + m * 16 + fr) * 1024 + col0;
#pragma unroll
                for (int bj = 0; bj < 2; ++bj) bs[m][bj] = *(const u32x4*)(WSH(WS_XB) + off + bj * HALF); }
#pragma unroll
            for (int m = 0; m < 4; ++m) {
                const int rl = ai * HALF + wr * 64 + m * 16 + fr; const size_t off = (size_t)(u.pm * BM + rl) * 1024 + col0;
                float ss = 0.f;
#pragma unroll
                for (int bj = 0; bj < 2; ++bj) {
                    u32x2 lo; lo.x = bs[m][bj].x; lo.y = bs[m][bj].y; u32x2 hi2; hi2.x = bs[m][bj].z; hi2.y = bs[m][bj].w;
                    const f32x4 x0 = bf4_to_f32(lo) + acc[ai][bj][m][0], x1 = bf4_to_f32(hi2) + acc[ai][bj][m][1];
                    if (final_) { *(f32x4*)(out + off + bj * HALF) = x0; *(f32x4*)(out + off + bj * HALF + 4) = x1; }
                    else { u32x4 w; w.x = cvt_pk_bf16(x0[0], x0[1]); w.y = cvt_pk_bf16(x0[2], x0[3]); w.z = cvt_pk_bf16(x1[0], x1[1]); w.w = cvt_pk_bf16(x1[2], x1[3]); *(u32x4*)(WSH(WS_XB) + off + bj * HALF) = w; }
                    ss += dot4(x0) + dot4(x1); }
                ss = qsum(ss);
                if (fq == 0) P[rl * 4 + wc] = ss;
            }
            asm volatile("" ::: "memory");
        }
        EPI_BAR();
        const int t = wid * 64 + lane;
        if (t < 256 && !final_) { const f32x4 pp = *(const PG8_LAS f32x4*)(P + t * 4); WSF(WS_SSQ + SSQ_X)[(size_t)(u.pm * BM + t) * 4 + u.pn] = (pp[0] + pp[1]) + (pp[2] + pp[3]); }
    }
};
struct EpiSwiglu {
    static constexpr bool PERM = true, AFTER_DRAIN = false;
    unsigned char* ws;
    __device__ __forceinline__ void operator()(const f32x4 (&acc)[2][2][4][2], const Unit& u, int wr, int wc, int fr, int fq) const {
        asm volatile("" : "+v"(fr), "+v"(fq));
        const int col0 = u.pn * 128 + wc * 32 + 8 * fq;
        float rsv[8];
#pragma unroll
        for (int it = 0; it < 8; ++it) { const int row = u.pm * BM + (it >> 2) * HALF + wr * 64 + (it & 3) * 16 + fr;
            const f32x4 sq = *(const f32x4*)(WSF(WS_SSQ + SSQ_X) + (size_t)row * 4); rsv[it] = rsqrtf(((sq[0] + sq[1]) + (sq[2] + sq[3])) * (1.0f / 1024.0f) + EPS_RMS); }
#pragma unroll
        for (int ai = 0; ai < 2; ++ai)
#pragma unroll
            for (int m = 0; m < 4; ++m) {
                const int row = u.pm * BM + ai * HALF + wr * 64 + m * 16 + fr;
                const float rs = rsv[ai * 4 + m];
                u32x4 w; unsigned wv[4];
#pragma unroll
                for (int n = 0; n < 2; ++n) { const f32x4 g = acc[ai][0][m][n] * rs, up = acc[ai][1][m][n] * rs; f32x4 a;
#pragma unroll
                    for (int i = 0; i < 4; ++i) a[i] = g[i] * __builtin_amdgcn_rcpf(1.0f + __builtin_amdgcn_exp2f(-LOG2E * g[i])) * up[i];
                    wv[2 * n] = cvt_pk_bf16(a[0], a[1]); wv[2 * n + 1] = cvt_pk_bf16(a[2], a[3]); }
                w.x = wv[0]; w.y = wv[1]; w.z = wv[2]; w.w = wv[3];
                *(u32x4*)(WSH(WS_QKV) + (size_t)row * 2816 + col0) = w;
            }
    }
};
template <class Epi, class Sched, bool ALIGN_EPI = false, bool SP2 = false>
__device__ __forceinline__ void gemm_phase(PG8_LAS unsigned char* lds, const Gemm g, const Sched& S, const Epi& E) {
    int tid_ = threadIdx.x; asm volatile("" : "+v"(tid_));
    const int tid = tid_, wid = __builtin_amdgcn_readfirstlane(tid >> 6), lane = tid & 63, wr = wid >> 2, wc = wid & 3, fr = lane & 15, fq = lane >> 4;
    const int K = g.K, nt = K / BK;
    unsigned voffA[2], voffB[2];
#pragma unroll
    for (int i = 0; i < 2; ++i) { int R, C; stage_rc(tid * 16 + i * 8192, R, C); const int Rb = Epi::PERM ? ((R & ~31) + perm32(R & 31)) : R;
        voffA[i] = (unsigned)(R * K + C) * 2u; voffB[i] = (unsigned)(Rb * K + C) * 2u; }
    const size_t kstep = (size_t)(BK * 2);
    const size_t hstep = (size_t)HALF * K * 2;
    const size_t tstep = 2 * hstep;
    const unsigned ldsw = (unsigned)wid * 1024u;
    const int aoff = lds_byte(wr * 64 + fr, fq * 8), boff = lds_byte(wc * 32 + fr, fq * 8);
#define PG8_SA(b, h) (((b) * 2 + (h)) * HTB)
#define PG8_SB(b, h) ((4 + (b) * 2 + (h)) * HTB)
#define PG8_STAGE(bufoff, gbase, voff) do { _Pragma("unroll") for (int _i = 0; _i < 2; ++_i) \
        __builtin_amdgcn_global_load_lds((const unsigned*)((const char*)(gbase) + (voff)[_i]), (PG8_LAS unsigned*)(lds + (bufoff) + ldsw + _i * 8192), 16, 0, 0); } while (0)
#define PG8_LDA(dst, b, h) do { _Pragma("unroll") for (int m = 0; m < 4; ++m) _Pragma("unroll") for (int k = 0; k < 2; ++k) dst[m][k] = *(const PG8_LAS bf16x8*)(lds + PG8_SA(b, h) + aoff + m * 2048 + k * 1024); } while (0)
#define PG8_LDB(dst, b, h) do { _Pragma("unroll") for (int n = 0; n < 2; ++n) _Pragma("unroll") for (int k = 0; k < 2; ++k) dst[n][k] = *(const PG8_LAS bf16x8*)(lds + PG8_SB(b, h) + boff + n * 2048 + k * 1024); } while (0)
#define PG8_MMA(ai, bj, At, Bt) do { __builtin_amdgcn_s_setprio(1); _Pragma("unroll") for (int m = 0; m < 4; ++m) _Pragma("unroll") for (int n = 0; n < 2; ++n) _Pragma("unroll") for (int k = 0; k < 2; ++k) \
        acc[ai][bj][m][n] = __builtin_amdgcn_mfma_f32_16x16x32_bf16(Bt[n][k], At[m][k], acc[ai][bj][m][n], 0, 0, 0); __builtin_amdgcn_s_setprio(0); } while (0)
#define PG8_WAIT_V(n) asm volatile("s_waitcnt vmcnt(" #n ")" ::: "memory")
#define PG8_WAIT_L(n) asm volatile("s_waitcnt lgkmcnt(" #n ")" ::: "memory")
#define PG8_BAR __builtin_amdgcn_s_barrier()
#define PG8_SCHED __builtin_amdgcn_sched_barrier(0)
    Unit cur, nxt; int ui = 0;
    if (!S.next(0, cur)) return;
    f32x4 acc[2][2][4][2];
#pragma unroll
    for (int a = 0; a < 2; ++a)
#pragma unroll
        for (int b = 0; b < 2; ++b)
#pragma unroll
            for (int m = 0; m < 4; ++m)
#pragma unroll
                for (int n = 0; n < 2; ++n) acc[a][b][m][n] = (f32x4){0.f, 0.f, 0.f, 0.f};
    bf16x8 At[4][2], B0[2][2], B1[2][2];
    const char* cA = (const char*)g.A + (size_t)cur.pm * tstep; const char* cB = (const char*)g.Bt + (size_t)cur.pn * tstep;
    S.a_ready(cur);
    if constexpr (SP2) {
        PG8_STAGE(PG8_SB(0, 0), cB, voffB); PG8_STAGE(PG8_SB(0, 1), cB + hstep, voffB); PG8_STAGE(PG8_SA(0, 0), cA, voffA); PG8_STAGE(PG8_SA(0, 1), cA + hstep, voffA);
        if (wr == 1) PG8_BAR;
        PG8_WAIT_V(2); PG8_BAR;
        PG8_STAGE(PG8_SB(1, 0), cB + kstep, voffB); PG8_STAGE(PG8_SA(1, 0), cA + kstep, voffA); PG8_STAGE(PG8_SB(1, 1), cB + hstep + kstep, voffB);
        PG8_WAIT_V(6); PG8_BAR;
    } else {
        PG8_STAGE(PG8_SB(0, 0), cB, voffB); PG8_STAGE(PG8_SA(0, 0), cA, voffA); PG8_STAGE(PG8_SB(0, 1), cB + hstep, voffB); PG8_STAGE(PG8_SA(0, 1), cA + hstep, voffA);
        if (wr == 1) PG8_BAR;
        PG8_WAIT_V(4); PG8_BAR;
        PG8_STAGE(PG8_SB(1, 0), cB + kstep, voffB); PG8_STAGE(PG8_SA(1, 0), cA + kstep, voffA); PG8_STAGE(PG8_SB(1, 1), cB + hstep + kstep, voffB);
        PG8_WAIT_V(6); PG8_BAR;
    }
    for (;;) {
        const bool has_next = S.next(ui + 1, nxt);
        const char* nA = has_next ? (const char*)g.A + (size_t)nxt.pm * tstep : cA; const char* nB = has_next ? (const char*)g.Bt + (size_t)nxt.pn * tstep : cB;
        for (int t = 0; t < nt; t += 2) {
            const bool last = (t == nt - 2);
            const char* a1 = cA + (size_t)(t + 1) * kstep;
            const char* a2 = last ? nA : cA + (size_t)(t + 2) * kstep; const char* b2 = last ? nB : cB + (size_t)(t + 2) * kstep;
            const char* a3 = a2 + kstep; const char* b3 = b2 + kstep;
            if (last && has_next) S.a_ready(nxt);
            if constexpr (SP2) {
            PG8_LDB(B0, 0, 0); PG8_LDB(B1, 0, 1); PG8_SCHED; PG8_LDA(At, 0, 0); PG8_STAGE(PG8_SA(1, 1), a1 + hstep, voffA);
            PG8_WAIT_V(8); PG8_WAIT_L(0); PG8_BAR; PG8_MMA(0, 0, At, B0); PG8_MMA(0, 1, At, B1); PG8_BAR; PG8_SCHED;
            PG8_LDA(At, 0, 1); PG8_STAGE(PG8_SB(0, 0), b2, voffB); PG8_STAGE(PG8_SB(0, 1), b2 + hstep, voffB); PG8_STAGE(PG8_SA(0, 0), a2, voffA);
            PG8_WAIT_V(8); PG8_WAIT_L(0); PG8_BAR; PG8_MMA(1, 0, At, B0); PG8_MMA(1, 1, At, B1); PG8_BAR; PG8_SCHED;
            PG8_LDB(B0, 1, 0); PG8_LDB(B1, 1, 1); PG8_SCHED; PG8_LDA(At, 1, 0); PG8_STAGE(PG8_SA(0, 1), a2 + hstep, voffA);
            PG8_WAIT_V(8); PG8_WAIT_L(0); PG8_BAR; PG8_MMA(0, 0, At, B0); PG8_MMA(0, 1, At, B1); PG8_BAR; PG8_SCHED;
            PG8_LDA(At, 1, 1); PG8_STAGE(PG8_SB(1, 0), b3, voffB); PG8_STAGE(PG8_SB(1, 1), b3 + hstep, voffB); PG8_STAGE(PG8_SA(1, 0), a3, voffA);
            PG8_WAIT_V(8); PG8_WAIT_L(0); PG8_BAR; PG8_MMA(1, 0, At, B0); PG8_MMA(1, 1, At, B1); PG8_BAR; PG8_SCHED;
            } else {
            PG8_LDB(B0, 0, 0); PG8_SCHED; PG8_LDA(At, 0, 0); PG8_STAGE(PG8_SA(1, 1), a1 + hstep, voffA);
            PG8_WAIT_L(8); PG8_BAR; PG8_WAIT_L(0); PG8_MMA(0, 0, At, B0); PG8_BAR; PG8_SCHED;
            PG8_LDB(B1, 0, 1); PG8_STAGE(PG8_SB(0, 0), b2, voffB);
            PG8_BAR; PG8_WAIT_L(0); PG8_MMA(0, 1, At, B1); PG8_BAR;
            PG8_LDA(At, 0, 1); PG8_STAGE(PG8_SA(0, 0), a2, voffA);
            PG8_BAR; PG8_WAIT_L(0); PG8_MMA(1, 0, At, B0); PG8_BAR; PG8_SCHED;
            PG8_STAGE(PG8_SB(0, 1), b2 + hstep, voffB);
            PG8_WAIT_V(6); PG8_BAR; PG8_MMA(1, 1, At, B1); PG8_BAR;
            PG8_LDB(B0, 1, 0); PG8_SCHED; PG8_LDA(At, 1, 0); PG8_STAGE(PG8_SA(0, 1), a2 + hstep, voffA);
            PG8_WAIT_L(8); PG8_BAR; PG8_WAIT_L(0); PG8_MMA(0, 0, At, B0); PG8_BAR; PG8_SCHED;
            PG8_LDB(B1, 1, 1); PG8_STAGE(PG8_SB(1, 0), b3, voffB);
            PG8_BAR; PG8_WAIT_L(0); PG8_MMA(0, 1, At, B1); PG8_BAR;
            PG8_LDA(At, 1, 1); PG8_STAGE(PG8_SA(1, 0), a3, voffA);
            PG8_BAR; PG8_WAIT_L(0); PG8_MMA(1, 0, At, B0); PG8_BAR; PG8_SCHED;
            PG8_STAGE(PG8_SB(1, 1), b3 + hstep, voffB);
            PG8_WAIT_V(6); PG8_BAR; PG8_MMA(1, 1, At, B1); PG8_BAR;
            }
        }
        if constexpr (ALIGN_EPI) { if (wr == 0) PG8_BAR; }
        if constexpr (!Epi::AFTER_DRAIN) { E(acc, cur, wr, wc, fr, fq); S.done(cur); }
        if (!has_next) break;
#pragma unroll
        for (int a = 0; a < 2; ++a)
#pragma unroll
            for (int b = 0; b < 2; ++b)
#pragma unroll
                for (int m = 0; m < 4; ++m)
#pragma unroll
                    for (int n = 0; n < 2; ++n) acc[a][b][m][n] = (f32x4){0.f, 0.f, 0.f, 0.f};
        cur = nxt; cA = nA; cB = nB; ++ui;
        if constexpr (ALIGN_EPI) { if (wr == 1) PG8_BAR; }
    }
    PG8_WAIT_V(0);
    if constexpr (!ALIGN_EPI) { if (wr == 0) PG8_BAR; }
    PG8_BAR;
    if constexpr (Epi::AFTER_DRAIN) { E.fused(acc, cur, wr, wc, fr, fq, lds, wid, lane); S.done(cur); }
#undef PG8_SA
#undef PG8_SB
#undef PG8_STAGE
#undef PG8_LDA
#undef PG8_LDB
#undef PG8_MMA
#undef PG8_WAIT_V
#undef PG8_WAIT_L
#undef PG8_BAR
#undef PG8_SCHED
}
}
namespace att {
#ifndef ATT_DIAG
#define ATT_DIAG 0
#endif
#if ATT_DIAG
__device__ __forceinline__ unsigned long long diag_now() { unsigned long long t; asm volatile("s_memtime %0\n\ts_waitcnt lgkmcnt(0)" : "=s"(t) :: "memory"); return t; }
#define ATT_T(x) const unsigned long long x = diag_now()
#define ATT_ACC(i, a, b) dacc[i] += (b) - (a)
#else
#define ATT_T(x)
#define ATT_ACC(i, a, b)
#endif
typedef unsigned short bf16_t;
using bf16x8 = __attribute__((ext_vector_type(8))) short;
using s16x4 = __attribute__((ext_vector_type(4))) short;
using f32x16 = __attribute__((ext_vector_type(16))) float;
using u32x4 = __attribute__((ext_vector_type(4))) unsigned;
#ifndef ATT_RSV
#define ATT_RSV 1
#endif
#define ATT_SBAR() __builtin_amdgcn_sched_barrier(0)
__device__ __forceinline__ int crow(int r, int hi) { return (r & 3) + 8 * (r >> 2) + 4 * hi; }
__device__ __forceinline__ unsigned cvtpk(float lo, float hi) { unsigned r; asm volatile("v_cvt_pk_bf16_f32 %0, %1, %2" : "=v"(r) : "v"(lo), "v"(hi)); return r; }
__device__ __forceinline__ void glds16(const void* gsrc, unsigned lds_dst) { unsigned keep;
    asm volatile("s_mov_b32 %0, m0\n\ts_mov_b32 m0, %2\n\ts_nop 0\n\tglobal_load_lds_dwordx4 %1, off\n\ts_mov_b32 m0, %0" : "=&s"(keep) : "v"(gsrc), "s"(lds_dst) : "memory"); }
template <int NB> __device__ __forceinline__ int v_st(int k, int c) { const int kk = k; return ((kk >> 3) * NB + (c >> 5)) * 512 + ((kk & 7) * 32 + (c & 31)) * 2; }
__device__ __forceinline__ int v_rd_base(int lane) { return ((lane & 3) << 3) | (((lane >> 2) & 3) << 6) | (((lane >> 4) & 1) << 5) | (((lane >> 5) & 1) << 8); }
template <int OFF> __device__ __forceinline__ s16x4 tr_read(int vb) { s16x4 r; asm volatile("ds_read_b64_tr_b16 %0, %1 offset:%2" : "=&v"(r) : "v"(vb), "i"(OFF) : "memory"); return r; }
template <int I> __device__ __forceinline__ void exp1(f32x16& p0, f32x16& p1) { if constexpr (I < 16) p0[I] = __builtin_amdgcn_exp2f(p0[I]); else p1[I - 16] = __builtin_amdgcn_exp2f(p1[I - 16]); }
template <int NB, int C> __device__ __forceinline__ void exp_chunk(f32x16& p0, f32x16& p1) {
    constexpr int N = 32 / (4 * NB);
    exp1<C * N>(p0, p1); exp1<C * N + 1>(p0, p1);
    if constexpr (N == 4) { exp1<C * N + 2>(p0, p1); exp1<C * N + 3>(p0, p1); }
}
template <int I> __device__ __forceinline__ void exp3(f32x16& p0, f32x16& p1) { exp1<I>(p0, p1); exp1<I + 1>(p0, p1); exp1<I + 2>(p0, p1); }
template <int I> __device__ __forceinline__ void exp4(f32x16& p0, f32x16& p1) { exp1<I>(p0, p1); exp1<I + 1>(p0, p1); exp1<I + 2>(p0, p1); exp1<I + 3>(p0, p1); }
struct VF { s16x4 l0, h0, l1, h1, l2, h2, l3, h3; };
template <int NB, int D0> __device__ __forceinline__ void v_read(VF& f, int vb) {
    f.l0 = tr_read<(0 * NB + D0) * 512>(vb); f.h0 = tr_read<(1 * NB + D0) * 512>(vb); f.l1 = tr_read<(2 * NB + D0) * 512>(vb); f.h1 = tr_read<(3 * NB + D0) * 512>(vb);
    f.l2 = tr_read<(4 * NB + D0) * 512>(vb); f.h2 = tr_read<(5 * NB + D0) * 512>(vb); f.l3 = tr_read<(6 * NB + D0) * 512>(vb); f.h3 = tr_read<(7 * NB + D0) * 512>(vb);
}
#define ATT_PIN2(a, b) asm volatile("" : "+v"(a), "+v"(b))
template <int NB, int D0, bool EXP, int PROBE = 0> __device__ __forceinline__ void pv_mm(f32x16& od, f32x16& lacc, const VF& f, bf16x8 pa0, bf16x8 pa1, bf16x8 pa2, bf16x8 pa3, f32x16& p0, f32x16& p1) {
    const bf16x8 ones = {16256, 16256, 16256, 16256, 16256, 16256, 16256, 16256};
#define ATT_PK(L, H) (bf16x8){L[0], L[1], L[2], L[3], H[0], H[1], H[2], H[3]}
    if constexpr (PROBE != 3) od = __builtin_amdgcn_mfma_f32_32x32x16_bf16(pa0, ATT_PK(f.l0, f.h0), od, 0, 0, 0); if constexpr (D0 == 0 && !ATT_RSV) lacc = __builtin_amdgcn_mfma_f32_32x32x16_bf16(pa0, ones, lacc, 0, 0, 0); if constexpr (EXP) { if constexpr (PROBE != 2) exp_chunk<NB, D0 * 4 + 0>(p0, p1); ATT_PIN2(p0, p1); ATT_SBAR(); }
    if constexpr (PROBE != 3) od = __builtin_amdgcn_mfma_f32_32x32x16_bf16(pa1, ATT_PK(f.l1, f.h1), od, 0, 0, 0); if constexpr (D0 == 0 && !ATT_RSV) lacc = __builtin_amdgcn_mfma_f32_32x32x16_bf16(pa1, ones, lacc, 0, 0, 0); if constexpr (EXP) { if constexpr (PROBE != 2) exp_chunk<NB, D0 * 4 + 1>(p0, p1); ATT_PIN2(p0, p1); ATT_SBAR(); }
    if constexpr (PROBE != 3) od = __builtin_amdgcn_mfma_f32_32x32x16_bf16(pa2, ATT_PK(f.l2, f.h2), od, 0, 0, 0); if constexpr (D0 == 0 && !ATT_RSV) lacc = __builtin_amdgcn_mfma_f32_32x32x16_bf16(pa2, ones, lacc, 0, 0, 0); if constexpr (EXP) { if constexpr (PROBE != 2) exp_chunk<NB, D0 * 4 + 2>(p0, p1); ATT_PIN2(p0, p1); ATT_SBAR(); }
    if constexpr (PROBE != 3) od = __builtin_amdgcn_mfma_f32_32x32x16_bf16(pa3, ATT_PK(f.l3, f.h3), od, 0, 0, 0); if constexpr (D0 == 0 && !ATT_RSV) lacc = __builtin_amdgcn_mfma_f32_32x32x16_bf16(pa3, ones, lacc, 0, 0, 0); if constexpr (EXP) { if constexpr (PROBE != 2) exp_chunk<NB, D0 * 4 + 3>(p0, p1); ATT_PIN2(p0, p1); ATT_SBAR(); }
#undef ATT_PK
}
#define ATT_LGKM(n) do { asm volatile("s_waitcnt lgkmcnt(" #n ")" ::: "memory"); ATT_SBAR(); } while (0)
#ifndef ATT_NEWK
#define ATT_NEWK 1
#endif
#ifndef ATT_XSPLIT
#define ATT_XSPLIT 1
#endif
#ifndef ATT_DLATE
#define ATT_DLATE 1
#endif
#ifndef ATT_GQA_ONES
#define ATT_GQA_ONES 1
#endif
#ifndef ATT_ALT4
#define ATT_ALT4 1
#endif
#ifndef ATT_ALT
#define ATT_ALT 1
#endif
template <bool EXP> __device__ __forceinline__ void pv_alt(f32x16* o, int vb, bf16x8 pa0, bf16x8 pa1, bf16x8 pa2, bf16x8 pa3, f32x16& p0, f32x16& p1) {
    ATT_SBAR();
    const s16x4 a0l = tr_read<0 * 512>(vb), a0h = tr_read<2 * 512>(vb), b0l = tr_read<1 * 512>(vb), b0h = tr_read<3 * 512>(vb);
    const s16x4 a1l = tr_read<4 * 512>(vb), a1h = tr_read<6 * 512>(vb), b1l = tr_read<5 * 512>(vb), b1h = tr_read<7 * 512>(vb);
    const s16x4 a2l = tr_read<8 * 512>(vb), a2h = tr_read<10 * 512>(vb), b2l = tr_read<9 * 512>(vb), b2h = tr_read<11 * 512>(vb);
    const s16x4 a3l = tr_read<12 * 512>(vb), a3h = tr_read<14 * 512>(vb), b3l = tr_read<13 * 512>(vb), b3h = tr_read<15 * 512>(vb);
#define ATT_PK(L, H) (bf16x8){L[0], L[1], L[2], L[3], H[0], H[1], H[2], H[3]}
#define ATT_ALT2(PA, AL, AH, BL, BH, C) do { \
    o[0] = __builtin_amdgcn_mfma_f32_32x32x16_bf16(PA, ATT_PK(AL, AH), o[0], 0, 0, 0); if constexpr (EXP) { exp_chunk<2, C>(p0, p1); ATT_PIN2(p0, p1); ATT_SBAR(); } \
    o[1] = __builtin_amdgcn_mfma_f32_32x32x16_bf16(PA, ATT_PK(BL, BH), o[1], 0, 0, 0); if constexpr (EXP) { exp_chunk<2, C + 1>(p0, p1); ATT_PIN2(p0, p1); ATT_SBAR(); } } while (0)
    ATT_LGKM(12); ATT_ALT2(pa0, a0l, a0h, b0l, b0h, 0);
    ATT_LGKM(8);  ATT_ALT2(pa1, a1l, a1h, b1l, b1h, 2);
    ATT_LGKM(4);  ATT_ALT2(pa2, a2l, a2h, b2l, b2h, 4);
    ATT_LGKM(0);  ATT_ALT2(pa3, a3l, a3h, b3l, b3h, 6);
#undef ATT_ALT2
#undef ATT_PK
}
template <int OFF> __device__ __forceinline__ bf16x8 kr_read(int ka) { bf16x8 r; asm volatile("ds_read_b128 %0, %1 offset:%2" : "=&v"(r) : "v"(ka), "i"(OFF) : "memory"); return r; }
template <int KP, int G> __device__ __forceinline__ void k_read_grp(bf16x8* kf, int ka) {
    kf[4 * G] = kr_read<64 * G>(ka); kf[4 * G + 1] = kr_read<32 * KP + 64 * G>(ka); kf[4 * G + 2] = kr_read<64 * G + 32>(ka); kf[4 * G + 3] = kr_read<32 * KP + 64 * G + 32>(ka);
}
template <int NQ> __device__ __forceinline__ void k_pin(bf16x8* kf) {
    asm volatile("" : "+v"(kf[0]), "+v"(kf[1]), "+v"(kf[2]), "+v"(kf[3]), "+v"(kf[4]), "+v"(kf[5]), "+v"(kf[6]), "+v"(kf[7]));
    if constexpr (NQ == 6) asm volatile("" : "+v"(kf[8]), "+v"(kf[9]), "+v"(kf[10]), "+v"(kf[11]));
}
template <bool EXP, int KP, int NKG, bool XS = false, bool ONES = false> __device__ __forceinline__ void pv_alt_k(f32x16* o, int vb, bf16x8 pa0, bf16x8 pa1, bf16x8 pa2, bf16x8 pa3, f32x16& p0, f32x16& p1, bf16x8* kf, int ka, f32x16& lacc) {
    const bf16x8 ones = {16256, 16256, 16256, 16256, 16256, 16256, 16256, 16256};
    ATT_SBAR();
    const s16x4 a0l = tr_read<0 * 512>(vb), a0h = tr_read<2 * 512>(vb), b0l = tr_read<1 * 512>(vb), b0h = tr_read<3 * 512>(vb);
    const s16x4 a1l = tr_read<4 * 512>(vb), a1h = tr_read<6 * 512>(vb), b1l = tr_read<5 * 512>(vb), b1h = tr_read<7 * 512>(vb);
    const s16x4 a2l = tr_read<8 * 512>(vb), a2h = tr_read<10 * 512>(vb), b2l = tr_read<9 * 512>(vb), b2h = tr_read<11 * 512>(vb);
    const s16x4 a3l = tr_read<12 * 512>(vb), a3h = tr_read<14 * 512>(vb), b3l = tr_read<13 * 512>(vb), b3h = tr_read<15 * 512>(vb);
#define ATT_PK(L, H) (bf16x8){L[0], L[1], L[2], L[3], H[0], H[1], H[2], H[3]}
#define ATT_ALT2(PA, AL, AH, BL, BH, C) do { \
    if constexpr (ONES) lacc = __builtin_amdgcn_mfma_f32_32x32x16_bf16(PA, ones, lacc, 0, 0, 0); \
    o[0] = __builtin_amdgcn_mfma_f32_32x32x16_bf16(PA, ATT_PK(AL, AH), o[0], 0, 0, 0); if constexpr (EXP) { if constexpr (XS) exp3<3 * (C)>(p0, p1); else exp_chunk<2, C>(p0, p1); ATT_PIN2(p0, p1); ATT_SBAR(); } \
    o[1] = __builtin_amdgcn_mfma_f32_32x32x16_bf16(PA, ATT_PK(BL, BH), o[1], 0, 0, 0); if constexpr (EXP) { if constexpr (XS) exp3<3 * (C) + 3>(p0, p1); else exp_chunk<2, C + 1>(p0, p1); ATT_PIN2(p0, p1); ATT_SBAR(); } } while (0)
    ATT_LGKM(12); ATT_ALT2(pa0, a0l, a0h, b0l, b0h, 0); if constexpr (NKG > 0) { ATT_SBAR(); k_read_grp<KP, 0>(kf, ka); ATT_SBAR(); }
    if constexpr (NKG == 0) ATT_LGKM(8); else ATT_LGKM(12);
    ATT_ALT2(pa1, a1l, a1h, b1l, b1h, 2); if constexpr (NKG > 1) { ATT_SBAR(); k_read_grp<KP, 1>(kf, ka); ATT_SBAR(); }
    if constexpr (NKG == 0) ATT_LGKM(4); else ATT_LGKM(12);
    ATT_ALT2(pa2, a2l, a2h, b2l, b2h, 4); if constexpr (NKG > 2) { ATT_SBAR(); k_read_grp<KP, 2>(kf, ka); ATT_SBAR(); }
    if constexpr (NKG == 0) ATT_LGKM(0); else if constexpr (NKG == 2) ATT_LGKM(8); else ATT_LGKM(12);
    ATT_ALT2(pa3, a3l, a3h, b3l, b3h, 6);
#undef ATT_ALT2
#undef ATT_PK
}
template <bool EXP> __device__ __forceinline__ void pv_alt4(f32x16* o, int vb, bf16x8 pa0, bf16x8 pa1, bf16x8 pa2, bf16x8 pa3, f32x16& p0, f32x16& p1) {
    ATT_SBAR();
#define ATT_RD(I, D, L, H) const s16x4 L = tr_read<((2 * I) * 4 + D) * 512>(vb), H = tr_read<((2 * I + 1) * 4 + D) * 512>(vb)
    ATT_RD(0, 0, a0l, a0h); ATT_RD(0, 1, b0l, b0h); ATT_RD(1, 0, a1l, a1h); ATT_RD(1, 1, b1l, b1h); ATT_RD(2, 0, a2l, a2h); ATT_RD(2, 1, b2l, b2h); ATT_RD(3, 0, a3l, a3h); ATT_RD(3, 1, b3l, b3h);
#define ATT_PK(L, H) (bf16x8){L[0], L[1], L[2], L[3], H[0], H[1], H[2], H[3]}
#define ATT_ALT2(OA, OB, PA, AL, AH, BL, BH, C) do { \
    OA = __builtin_amdgcn_mfma_f32_32x32x16_bf16(PA, ATT_PK(AL, AH), OA, 0, 0, 0); if constexpr (EXP) { exp_chunk<4, C>(p0, p1); ATT_PIN2(p0, p1); ATT_SBAR(); } \
    OB = __builtin_amdgcn_mfma_f32_32x32x16_bf16(PA, ATT_PK(BL, BH), OB, 0, 0, 0); if constexpr (EXP) { exp_chunk<4, C + 1>(p0, p1); ATT_PIN2(p0, p1); ATT_SBAR(); } } while (0)
    ATT_LGKM(12); ATT_ALT2(o[0], o[1], pa0, a0l, a0h, b0l, b0h, 0); ATT_SBAR(); ATT_RD(0, 2, c0l, c0h); ATT_RD(0, 3, d0l, d0h);
    ATT_LGKM(12); ATT_ALT2(o[0], o[1], pa1, a1l, a1h, b1l, b1h, 2); ATT_SBAR(); ATT_RD(1, 2, c1l, c1h); ATT_RD(1, 3, d1l, d1h);
    ATT_LGKM(12); ATT_ALT2(o[0], o[1], pa2, a2l, a2h, b2l, b2h, 4); ATT_SBAR(); ATT_RD(2, 2, c2l, c2h); ATT_RD(2, 3, d2l, d2h);
    ATT_LGKM(12); ATT_ALT2(o[0], o[1], pa3, a3l, a3h, b3l, b3h, 6); ATT_SBAR(); ATT_RD(3, 2, c3l, c3h); ATT_RD(3, 3, d3l, d3h);
    ATT_LGKM(12); ATT_ALT2(o[2], o[3], pa0, c0l, c0h, d0l, d0h, 8);
    ATT_LGKM(8);  ATT_ALT2(o[2], o[3], pa1, c1l, c1h, d1l, d1h, 10);
    ATT_LGKM(4);  ATT_ALT2(o[2], o[3], pa2, c2l, c2h, d2l, d2h, 12);
    ATT_LGKM(0);  ATT_ALT2(o[2], o[3], pa3, c3l, c3h, d3l, d3h, 14);
#undef ATT_ALT2
#undef ATT_PK
#undef ATT_RD
}
template <bool EXP, class F> __device__ __forceinline__ void pv_alt4_d(f32x16* o, int vb, bf16x8 pa0, bf16x8 pa1, bf16x8 pa2, bf16x8 pa3, f32x16& p0, f32x16& p1, const F& dma) {
    ATT_SBAR();
#define ATT_RD(I, D, L, H) const s16x4 L = tr_read<((2 * I) * 4 + D) * 512>(vb), H = tr_read<((2 * I + 1) * 4 + D) * 512>(vb)
    ATT_RD(0, 0, a0l, a0h); ATT_RD(0, 1, b0l, b0h); ATT_RD(1, 0, a1l, a1h); ATT_RD(1, 1, b1l, b1h); ATT_RD(2, 0, a2l, a2h); ATT_RD(2, 1, b2l, b2h); ATT_RD(3, 0, a3l, a3h); ATT_RD(3, 1, b3l, b3h);
#define ATT_PK(L, H) (bf16x8){L[0], L[1], L[2], L[3], H[0], H[1], H[2], H[3]}
#define ATT_ALT2(OA, OB, PA, AL, AH, BL, BH, C) do { \
    OA = __builtin_amdgcn_mfma_f32_32x32x16_bf16(PA, ATT_PK(AL, AH), OA, 0, 0, 0); if constexpr (EXP) { exp_chunk<4, C>(p0, p1); ATT_PIN2(p0, p1); ATT_SBAR(); } \
    OB = __builtin_amdgcn_mfma_f32_32x32x16_bf16(PA, ATT_PK(BL, BH), OB, 0, 0, 0); if constexpr (EXP) { exp_chunk<4, C + 1>(p0, p1); ATT_PIN2(p0, p1); ATT_SBAR(); } } while (0)
    ATT_LGKM(12); ATT_ALT2(o[0], o[1], pa0, a0l, a0h, b0l, b0h, 0); ATT_SBAR(); ATT_RD(0, 2, c0l, c0h); ATT_RD(0, 3, d0l, d0h);
    ATT_LGKM(12); ATT_ALT2(o[0], o[1], pa1, a1l, a1h, b1l, b1h, 2); ATT_SBAR(); ATT_RD(1, 2, c1l, c1h); ATT_RD(1, 3, d1l, d1h);
    ATT_LGKM(12); ATT_ALT2(o[0], o[1], pa2, a2l, a2h, b2l, b2h, 4); ATT_SBAR(); ATT_RD(2, 2, c2l, c2h); ATT_RD(2, 3, d2l, d2h);
    ATT_LGKM(12); ATT_ALT2(o[0], o[1], pa3, a3l, a3h, b3l, b3h, 6); ATT_SBAR(); ATT_RD(3, 2, c3l, c3h); ATT_RD(3, 3, d3l, d3h);
    ATT_LGKM(12); ATT_ALT2(o[2], o[3], pa0, c0l, c0h, d0l, d0h, 8);  dma(0); dma(1); ATT_SBAR();
    ATT_LGKM(8);  ATT_ALT2(o[2], o[3], pa1, c1l, c1h, d1l, d1h, 10); dma(2); dma(3); ATT_SBAR();
    ATT_LGKM(4);  ATT_ALT2(o[2], o[3], pa2, c2l, c2h, d2l, d2h, 12); dma(4); ATT_SBAR();
    ATT_LGKM(0);  ATT_ALT2(o[2], o[3], pa3, c3l, c3h, d3l, d3h, 14);
#undef ATT_ALT2
#undef ATT_PK
#undef ATT_RD
}
template <int NB, bool EXP, int PROBE = 0, bool PRE = false> __device__ __forceinline__ void pv_all(f32x16* o, f32x16& lacc, int vb, bf16x8 pa0, bf16x8 pa1, bf16x8 pa2, bf16x8 pa3, f32x16& p0, f32x16& p1, VF& fa, VF& fb) {
    if constexpr (!PRE) { ATT_SBAR(); v_read<NB, 0>(fa, vb); v_read<NB, 1>(fb, vb); ATT_LGKM(8); }
    else { ATT_LGKM(0); }
    pv_mm<NB, 0, EXP, PROBE>(o[0], lacc, fa, pa0, pa1, pa2, pa3, p0, p1);
    if constexpr (NB == 2) { if constexpr (!PRE) ATT_LGKM(0); pv_mm<NB, 1, EXP, PROBE>(o[1], lacc, fb, pa0, pa1, pa2, pa3, p0, p1); }
    else {
        ATT_SBAR(); v_read<NB, 2>(fa, vb); ATT_LGKM(8); pv_mm<NB, 1, EXP, PROBE>(o[1], lacc, fb, pa0, pa1, pa2, pa3, p0, p1);
        ATT_SBAR(); v_read<NB, 3>(fb, vb); ATT_LGKM(8); pv_mm<NB, 2, EXP, PROBE>(o[2], lacc, fa, pa0, pa1, pa2, pa3, p0, p1);
        ATT_LGKM(0); pv_mm<NB, 3, EXP, PROBE>(o[3], lacc, fb, pa0, pa1, pa2, pa3, p0, p1);
    }
}
template <int NQ, int KP> __device__ __forceinline__ void k_read(bf16x8* kf, const char* Ks, int koffB, int r32, int hi) {
#pragma unroll
    for (int d0 = 0; d0 < NQ; ++d0) { const int cb = koffB + (d0 * 16 + hi * 8) * 2;
        kf[2 * d0] = *reinterpret_cast<const bf16x8*>(Ks + r32 * KP + cb); kf[2 * d0 + 1] = *reinterpret_cast<const bf16x8*>(Ks + (32 + r32) * KP + cb); }
}
template <int NQ, int KP, int PROBE = 0> __device__ __forceinline__ void qkt(f32x16& p0, f32x16& p1, const char* Ks, int koffB, const bf16x8* qr, int r32, int hi) {
    bf16x8 kf[2 * NQ]; k_read<NQ, KP>(kf, Ks, koffB, r32, hi);
    if constexpr (PROBE == 4) { _Pragma("unroll") for (int i = 0; i < 2 * NQ; ++i) asm volatile("" :: "v"(kf[i])); p0 = f32x16{}; p1 = f32x16{}; return; }
#pragma unroll
    for (int d0 = 0; d0 < NQ; ++d0) {
        if (d0 == 0) { p0 = __builtin_amdgcn_mfma_f32_32x32x16_bf16(kf[0], qr[0], f32x16{}, 0, 0, 0); p1 = __builtin_amdgcn_mfma_f32_32x32x16_bf16(kf[1], qr[0], f32x16{}, 0, 0, 0); }
        else { p0 = __builtin_amdgcn_mfma_f32_32x32x16_bf16(kf[2 * d0], qr[d0], p0, 0, 0, 0); p1 = __builtin_amdgcn_mfma_f32_32x32x16_bf16(kf[2 * d0 + 1], qr[d0], p1, 0, 0, 0); } }
}
__device__ __forceinline__ void add_bias(f32x16& p0, f32x16& p1, float nb) {
#pragma unroll
    for (int r = 0; r < 16; ++r) { p0[r] += nb; p1[r] += nb; }
}
__device__ __forceinline__ void exp_all(f32x16& p0, f32x16& p1) {
#pragma unroll
    for (int r = 0; r < 16; ++r) { p0[r] = __builtin_amdgcn_exp2f(p0[r]); p1[r] = __builtin_amdgcn_exp2f(p1[r]); }
}
struct RS { float a, b, c, d; };
template <int I> __device__ __forceinline__ void rs_add1(RS& l, const f32x16& p0, const f32x16& p1) {
    const float x = (I < 16) ? p0[I & 15] : p1[I & 15];
    if constexpr ((I & 3) == 0) asm volatile("v_add_f32 %0, %0, %1" : "+v"(l.a) : "v"(x));
    else if constexpr ((I & 3) == 1) asm volatile("v_add_f32 %0, %0, %1" : "+v"(l.b) : "v"(x));
    else if constexpr ((I & 3) == 2) asm volatile("v_add_f32 %0, %0, %1" : "+v"(l.c) : "v"(x));
    else asm volatile("v_add_f32 %0, %0, %1" : "+v"(l.d) : "v"(x));
}
template <int I0, int I1> __device__ __forceinline__ void rs_adds(RS& l, const f32x16& p0, const f32x16& p1) {
    if constexpr (ATT_RSV && I0 < I1) { rs_add1<I0>(l, p0, p1); rs_adds<I0 + 1, I1>(l, p0, p1); }
}
template <int NQ, int G> __device__ __forceinline__ void rs_group(RS& l, const f32x16& p0, const f32x16& p1) {
    if constexpr (NQ == 4) rs_adds<8 * G, 8 * G + 8>(l, p0, p1);
    else { constexpr int S = (G < 2) ? 6 * G : 12 + 5 * (G - 2), N = (G < 2) ? 6 : 5; rs_adds<S, S + N>(l, p0, p1); }
}
template <bool SUMV = true> __device__ __forceinline__ void sum_pack(const f32x16& p0, const f32x16& p1, bf16x8& pa0, bf16x8& pa1, bf16x8& pa2, bf16x8& pa3, RS& l) {
    if constexpr (SUMV) rs_adds<0, 32>(l, p0, p1);
#define ATT_PK4(P, BASE, OUT) do { u32x4 w = {cvtpk(P[BASE + 0], P[BASE + 1]), cvtpk(P[BASE + 2], P[BASE + 3]), cvtpk(P[BASE + 4], P[BASE + 5]), cvtpk(P[BASE + 6], P[BASE + 7])}; \
    OUT = *reinterpret_cast<bf16x8*>(&w); } while (0)
    ATT_PK4(p0, 0, pa0); ATT_PK4(p0, 8, pa1); ATT_PK4(p1, 0, pa2); ATT_PK4(p1, 8, pa3);
#undef ATT_PK4
}

#define ATT_PK4(P, BASE, OUT) do { u32x4 w = {cvtpk(P[BASE + 0], P[BASE + 1]), cvtpk(P[BASE + 2], P[BASE + 3]), cvtpk(P[BASE + 4], P[BASE + 5]), cvtpk(P[BASE + 6], P[BASE + 7])}; \
    OUT = *reinterpret_cast<bf16x8*>(&w); } while (0)
template <int NQ, int KP, int PROBE = 0> __device__ __forceinline__ void qkt_sp(f32x16& n0, f32x16& n1, const char* Ks, int koffB, const bf16x8* qr, int r32, int hi,
                                                                const f32x16& e0, const f32x16& e1, bf16x8& pa0, bf16x8& pa1, bf16x8& pa2, bf16x8& pa3, RS& l) {
    bf16x8 kf[2 * NQ]; k_read<NQ, KP>(kf, Ks, koffB, r32, hi);
#pragma unroll
    for (int d0 = 0; d0 < NQ; ++d0) {
        if constexpr (PROBE == 4) { asm volatile("" :: "v"(kf[2 * d0]), "v"(kf[2 * d0 + 1])); if (d0 == 0) { n0 = f32x16{}; n1 = f32x16{}; } }
        else if (d0 == 0) { n0 = __builtin_amdgcn_mfma_f32_32x32x16_bf16(kf[0], qr[0], f32x16{}, 0, 0, 0); n1 = __builtin_amdgcn_mfma_f32_32x32x16_bf16(kf[1], qr[0], f32x16{}, 0, 0, 0); }
        else { n0 = __builtin_amdgcn_mfma_f32_32x32x16_bf16(kf[2 * d0], qr[d0], n0, 0, 0, 0); n1 = __builtin_amdgcn_mfma_f32_32x32x16_bf16(kf[2 * d0 + 1], qr[d0], n1, 0, 0, 0); }
        if (d0 == 0) { ATT_PK4(e0, 0, pa0); rs_group<NQ, 0>(l, e0, e1); }
        if (d0 == 1) { ATT_PK4(e0, 8, pa1); rs_group<NQ, 1>(l, e0, e1); }
        if (d0 == 2) { ATT_PK4(e1, 0, pa2); rs_group<NQ, 2>(l, e0, e1); }
        if (d0 == 3) { ATT_PK4(e1, 8, pa3); rs_group<NQ, 3>(l, e0, e1); }
        if constexpr (NQ == 6) { if (d0 == 4) rs_group<NQ, 4>(l, e0, e1); if (d0 == 5) rs_group<NQ, 5>(l, e0, e1); }
    }
}
template <int NQ, int KP, int PROBE = 0, bool XS = false, bool SUMV = true> __device__ __forceinline__ void qkt_sp_pre(f32x16& n0, f32x16& n1, const bf16x8* kf, const bf16x8* qr,
                                                                f32x16& e0, f32x16& e1, bf16x8& pa0, bf16x8& pa1, bf16x8& pa2, bf16x8& pa3, RS& l) {
#pragma unroll
    for (int d0 = 0; d0 < NQ; ++d0) {
        if constexpr (PROBE == 4) { asm volatile("" :: "v"(kf[2 * d0]), "v"(kf[2 * d0 + 1])); if (d0 == 0) { n0 = f32x16{}; n1 = f32x16{}; } }
        else if (d0 == 0) { n0 = __builtin_amdgcn_mfma_f32_32x32x16_bf16(kf[0], qr[0], f32x16{}, 0, 0, 0); n1 = __builtin_amdgcn_mfma_f32_32x32x16_bf16(kf[1], qr[0], f32x16{}, 0, 0, 0); }
        else { n0 = __builtin_amdgcn_mfma_f32_32x32x16_bf16(kf[2 * d0], qr[d0], n0, 0, 0, 0); n1 = __builtin_amdgcn_mfma_f32_32x32x16_bf16(kf[2 * d0 + 1], qr[d0], n1, 0, 0, 0); }
        if (d0 == 0) { if constexpr (XS) { exp4<24>(e0, e1); ATT_PIN2(e0, e1); } ATT_PK4(e0, 0, pa0); if constexpr (SUMV) rs_group<NQ, 0>(l, e0, e1); }
        if (d0 == 1) { if constexpr (XS) { exp4<28>(e0, e1); ATT_PIN2(e0, e1); } ATT_PK4(e0, 8, pa1); if constexpr (SUMV) rs_group<NQ, 1>(l, e0, e1); }
        if (d0 == 2) { ATT_PK4(e1, 0, pa2); if constexpr (SUMV) rs_group<NQ, 2>(l, e0, e1); }
        if (d0 == 3) { ATT_PK4(e1, 8, pa3); if constexpr (SUMV) rs_group<NQ, 3>(l, e0, e1); }
        if constexpr (NQ == 6 && SUMV) { if (d0 == 4) rs_group<NQ, 4>(l, e0, e1); if (d0 == 5) rs_group<NQ, 5>(l, e0, e1); }
    }
}
#undef ATT_PK4

template <int KIND> struct Cfg;
template <> struct Cfg<0> { static constexpr int KROW = 96,  NQ = 6, DV = 64;  };
template <> struct Cfg<1> { static constexpr int KROW = 128, NQ = 4, DV = 128; };
template <> struct Cfg<2> { static constexpr int KROW = 64,  NQ = 4, DV = 64;  };
constexpr int NTILES = 2048 / 64;
constexpr int LDS_WS = 135168, LDS_BYTES = LDS_WS;
struct DiffAux { float lam; float oscale; const float* og; };

template <int KIND, int PROBE = 0>
__device__ __forceinline__ void attn_unit(const bf16_t* __restrict__ Qg, const bf16_t* __restrict__ Kg, const bf16_t* __restrict__ Vg, bf16_t* mixp, float negBc, const DiffAux& aux, char* lds, void* diag_out = nullptr) {
    using C = Cfg<KIND>;
    constexpr int KROW = C::KROW, NQ = C::NQ, DV = C::DV, NB = DV / 32, KP = KROW * 2 + 16, KBUF = 64 * KP, VBUF = 64 * DV * 2;
    int tid_ = threadIdx.x; asm volatile("" : "+v"(tid_));
    const int tid = tid_, lane = tid & 63, r32 = lane & 31, hi = lane >> 5; const int wid = __builtin_amdgcn_readfirstlane(tid >> 6);
    const int comp = (KIND == 1) ? (wid >> 2) : 0, rb = (KIND == 1) ? (wid & 3) : wid;
    constexpr int SLOT = KBUF + VBUF, R = (KIND == 1) ? 4 : 5, D = R - 2;
    constexpr int NKP = KBUF / 1024, NVP = VBUF / 1024, NP = NKP + NVP, NPW = (NP + 7) / 8;
    static_assert(R * SLOT <= LDS_WS && KBUF % 1024 == 0 && VBUF % 1024 == 0, "LDS map");
    constexpr bool ONES = (KIND == 2) && ATT_GQA_ONES && ATT_NEWK && ATT_ALT && ATT_RSV && PROBE == 0;
    f32x16 o[NB]; f32x16 lacc = f32x16{}; bf16x8 qr[NQ];
#pragma unroll
    for (int d = 0; d < NB; ++d) o[d] = f32x16{};
    { const bf16_t* Qw = Qg + (size_t)(rb * 32 + r32) * KROW + comp * 64 + hi * 8;
#pragma unroll
      for (int d0 = 0; d0 < NQ; ++d0) qr[d0] = *reinterpret_cast<const bf16x8*>(Qw + d0 * 16); }
    const float nb = __builtin_amdgcn_readfirstlane(negBc);
    const int koffB = comp * 128;
    const unsigned lds0 = (unsigned)(uintptr_t)lds;
    const int vb0 = (int)lds0 + KBUF + v_rd_base(lane);
    const bf16_t* gsrc[NPW]; int gstep[NPW]; int npw = 0;
#pragma unroll
    for (int i = 0; i < NPW; ++i) {
        const int pi = wid + 8 * i;
        if (pi < NKP) { const int d = 1024 * pi + 16 * lane, row = d / KP, cb = d % KP;
            gsrc[i] = Kg + row * KROW + (cb < 2 * KROW ? (cb >> 1) : 0); gstep[i] = 64 * KROW; }
        else { const int q = 1024 * (pi - NKP) + 16 * lane, st = q >> 9, kk = (st / NB) * 8 + ((q & 511) >> 6), k = kk, c = (st % NB) * 32 + ((q & 63) >> 1);
            gsrc[i] = Vg + k * DV + c; gstep[i] = 64 * DV; }
        if (pi < NP) npw = i + 1;
    }
#define ATT_DMA(t, slot) do { if constexpr (PROBE == 0) { _Pragma("unroll") for (int i_ = 0; i_ < NPW; ++i_) { if (i_ < npw) \
        glds16(gsrc[i_] + (size_t)(t) * gstep[i_], (unsigned)__builtin_amdgcn_readfirstlane((int)lds0 + (slot) * SLOT + 1024 * (wid + 8 * i_))); } } } while (0)
#define ATT_WAITBAR(keep) do { if (npw == NPW) asm volatile("s_waitcnt vmcnt(%0) lgkmcnt(0)\n\ts_barrier" :: "n"((keep) * NPW) : "memory"); \
                               else asm volatile("s_waitcnt vmcnt(%0) lgkmcnt(0)\n\ts_barrier" :: "n"((keep) * (NPW - 1)) : "memory"); } while (0)
#define ATT_KSLOT(s_) (lds + (s_) * SLOT)
#define ATT_VSLOT(s_) (vb0 + (s_) * SLOT)
#define ATT_INC(x) do { x = (x == R - 1) ? 0 : x + 1; } while (0)
    bf16x8 pa0, pa1, pa2, pa3; RS ls{0.f, 0.f, 0.f, 0.f};
#if ATT_DIAG
    unsigned long long dacc[4] = {0, 0, 0, 0};
#endif
    constexpr int NT = NTILES;
#pragma unroll
    for (int t = 0; t < D; ++t) ATT_DMA(t, t);
    ATT_WAITBAR(D - 1);
    int sc = 0, sp = 0, sw = D;
    {
        f32x16 pA0, pA1, pB0, pB1; VF fa, fb;
        constexpr bool KPRE = (KIND != 1);
        constexpr bool DLATE = (KIND == 1) && ATT_DLATE && ATT_ALT4 && ATT_RSV && PROBE == 0 && NPW <= 5;
        constexpr bool NEWK = KPRE && ATT_NEWK && ATT_ALT && ATT_RSV && PROBE == 0;
        constexpr bool XS = NEWK && ATT_XSPLIT && (NQ == 6);
        const int ka0 = (int)lds0 + r32 * KP + koffB + hi * 16;
        constexpr int KEEP = KPRE ? D - 2 : D - 1;
        bf16x8 kf[KPRE ? 2 * NQ : 1];
        if constexpr (KPRE) {
            ATT_WAITBAR(D - 2);
            ATT_DMA(D, sw); ATT_INC(sw);
            qkt<NQ, KP>(pA0, pA1, ATT_KSLOT(0), koffB, qr, r32, hi); if (nb != 0.f) add_bias(pA0, pA1, nb);
            if constexpr (NEWK) { ATT_SBAR(); k_read_grp<KP, 0>(kf, ka0 + SLOT); k_read_grp<KP, 1>(kf, ka0 + SLOT); if constexpr (NQ == 6) k_read_grp<KP, 2>(kf, ka0 + SLOT); ATT_SBAR(); }
            else k_read<NQ, KP>(kf, ATT_KSLOT(1), koffB, r32, hi);
            if constexpr (XS) { exp4<0>(pA0, pA1); exp4<4>(pA0, pA1); exp4<8>(pA0, pA1); exp4<12>(pA0, pA1); exp4<16>(pA0, pA1); exp4<20>(pA0, pA1); }
            else exp_all(pA0, pA1);
        } else {
            ATT_DMA(D, sw); ATT_INC(sw);
            qkt<NQ, KP>(pA0, pA1, ATT_KSLOT(0), koffB, qr, r32, hi); if (nb != 0.f) add_bias(pA0, pA1, nb); exp_all(pA0, pA1);
        }
        ATT_WAITBAR(KEEP);
        if constexpr (NEWK) k_pin<NQ>(kf);
        sc = 1;
        int sk = 2;
#define ATT_STEP(E0, E1, N0, N1, j, keep) do { \
            ATT_T(t0_); if constexpr (!DLATE) { if ((j) + D < NT) ATT_DMA((j) + D, sw); } ATT_T(t1_); \
            if constexpr (KPRE) { ATT_SBAR(); qkt_sp_pre<NQ, KP, PROBE, XS, !ONES>(N0, N1, kf, qr, E0, E1, pa0, pa1, pa2, pa3, ls); ATT_SBAR(); \
                                  if constexpr (!NEWK) { if ((j) + 1 < NT) k_read<NQ, KP>(kf, ATT_KSLOT(sk), koffB, r32, hi); } } \
            else qkt_sp<NQ, KP, PROBE>(N0, N1, ATT_KSLOT(sc), koffB, qr, r32, hi, E0, E1, pa0, pa1, pa2, pa3, ls); \
            if (nb != 0.f) add_bias(N0, N1, nb); ATT_T(t2_); \
            if constexpr (NEWK) { if ((j) + 1 < NT) pv_alt_k<true, KP, NQ / 2, XS, ONES>(o, ATT_VSLOT(sp), pa0, pa1, pa2, pa3, N0, N1, kf, ka0 + sk * SLOT, lacc); \
                                  else pv_alt_k<true, KP, 0, XS, ONES>(o, ATT_VSLOT(sp), pa0, pa1, pa2, pa3, N0, N1, kf, ka0, lacc); } \
            else if constexpr (NB == 2 && ATT_ALT && ATT_RSV && PROBE == 0) pv_alt<true>(o, ATT_VSLOT(sp), pa0, pa1, pa2, pa3, N0, N1); \
            else if constexpr (DLATE) pv_alt4_d<true>(o, ATT_VSLOT(sp), pa0, pa1, pa2, pa3, N0, N1, [&](int i_) { if (i_ < npw && (j) + D < NT) \
                     glds16(gsrc[i_] + (size_t)((j) + D) * gstep[i_], (unsigned)__builtin_amdgcn_readfirstlane((int)lds0 + sw * SLOT + 1024 * (wid + 8 * i_))); }); \
            else if constexpr (NB == 4 && ATT_ALT4 && ATT_RSV && PROBE == 0) pv_alt4<true>(o, ATT_VSLOT(sp), pa0, pa1, pa2, pa3, N0, N1); \
            else pv_all<NB, true, PROBE, false>(o, lacc, ATT_VSLOT(sp), pa0, pa1, pa2, pa3, N0, N1, fa, fb); ATT_T(t3_); \
            ATT_INC(sw); ATT_WAITBAR(keep); if constexpr (NEWK) k_pin<NQ>(kf); if constexpr (KPRE) ATT_INC(sk); ATT_INC(sc); ATT_INC(sp); ATT_T(t4_); ATT_ACC(0, t0_, t1_); ATT_ACC(1, t1_, t2_); ATT_ACC(2, t2_, t3_); ATT_ACC(3, t3_, t4_); } while (0)
        static_assert(NT == 32 && (D == 3 || D == 2), "step schedule below is written for 32 tiles, 2 or 3 tiles ahead");
#pragma unroll 1
        for (int j = 1; j < NT - 3; j += 2) { ATT_STEP(pA0, pA1, pB0, pB1, j, KEEP); ATT_STEP(pB0, pB1, pA0, pA1, j + 1, KEEP); }
        ATT_STEP(pA0, pA1, pB0, pB1, NT - 3, (NT - 3 < NT - D) ? KEEP : 0); ATT_STEP(pB0, pB1, pA0, pA1, NT - 2, 0); ATT_STEP(pA0, pA1, pB0, pB1, NT - 1, 0);
#undef ATT_STEP
        if constexpr (XS) { exp4<24>(pB0, pB1); exp4<28>(pB0, pB1); }
        sum_pack<!ONES>(pB0, pB1, pa0, pa1, pa2, pa3, ls);
        if constexpr (ONES) { const bf16x8 ones = {16256, 16256, 16256, 16256, 16256, 16256, 16256, 16256};
            lacc = __builtin_amdgcn_mfma_f32_32x32x16_bf16(pa0, ones, lacc, 0, 0, 0); lacc = __builtin_amdgcn_mfma_f32_32x32x16_bf16(pa1, ones, lacc, 0, 0, 0);
            lacc = __builtin_amdgcn_mfma_f32_32x32x16_bf16(pa2, ones, lacc, 0, 0, 0); lacc = __builtin_amdgcn_mfma_f32_32x32x16_bf16(pa3, ones, lacc, 0, 0, 0); }
        if constexpr (NB == 2 && ATT_ALT && ATT_RSV && PROBE == 0) pv_alt<false>(o, ATT_VSLOT(sp), pa0, pa1, pa2, pa3, pB0, pB1);
        else if constexpr (NB == 4 && ATT_ALT4 && ATT_RSV && PROBE == 0) pv_alt4<false>(o, ATT_VSLOT(sp), pa0, pa1, pa2, pa3, pB0, pB1);
        else pv_all<NB, false>(o, lacc, ATT_VSLOT(sp), pa0, pa1, pa2, pa3, pB0, pB1, fa, fb);
    }
#undef ATT_DMA
#undef ATT_WAITBAR
#undef ATT_KSLOT
#undef ATT_VSLOT
#undef ATT_INC
#if ATT_DIAG
    if (KIND == ATT_DIAG_KIND && lane == 0) { unsigned long long* dg = (unsigned long long*)diag_out; for (int i = 0; i < 4; ++i) atomicAdd(dg + i, dacc[i]); }
#endif
    float rli[16];
    if constexpr (ATT_RSV && !ONES) {
        float lt = (ls.a + ls.b) + (ls.c + ls.d); { const auto q_ = __builtin_amdgcn_permlane32_swap(__float_as_uint(lt), __float_as_uint(lt), false, false); lt = __uint_as_float(q_[0]) + __uint_as_float(q_[1]); }
        const float li = __builtin_amdgcn_rcpf(lt);
#pragma unroll
        for (int r = 0; r < 16; ++r) rli[r] = __shfl(li, crow(r, hi));
    } else {
#pragma unroll
        for (int r = 0; r < 16; ++r) rli[r] = __builtin_amdgcn_rcpf(lacc[r]);
    }
    if constexpr (KIND != 1) {
        __syncthreads();
        bf16_t* stg = (bf16_t*)lds + wid * 2048;
#pragma unroll
        for (int r = 0; r < 16; ++r) { const int orow = crow(r, hi);
#pragma unroll
            for (int d0 = 0; d0 < 2; ++d0) stg[orow * 64 + d0 * 32 + r32] = (bf16_t)(cvtpk(o[d0][r] * rli[r], 0.f) & 0xffffu); }
        asm volatile("s_waitcnt lgkmcnt(0)" ::: "memory");
#pragma unroll
        for (int i = 0; i < 4; ++i) { const int row = i * 8 + (lane >> 3), ch = lane & 7; const u32x4 v = *(const u32x4*)(stg + row * 64 + ch * 8);
            *(u32x4*)(mixp + (size_t)(wid * 32 + row) * 1280 + ch * 8) = v; }
        asm volatile("s_waitcnt lgkmcnt(0)" ::: "memory"); __syncthreads();
    } else {
#pragma unroll
        for (int d0 = 0; d0 < 4; ++d0)
#pragma unroll
            for (int r = 0; r < 16; ++r) o[d0][r] *= rli[r];
        __syncthreads();
        float* X = (float*)lds + rb * 4096;
        if (comp == 1) {
#pragma unroll
            for (int d0 = 0; d0 < 4; ++d0)
#pragma unroll
                for (int r = 0; r < 16; ++r) X[crow(r, hi) * 128 + d0 * 32 + r32] = aux.lam * o[d0][r];
        }
        asm volatile("s_waitcnt lgkmcnt(0)" ::: "memory"); __syncthreads();
        if (comp == 0) {
            float og[4];
#pragma unroll
            for (int d0 = 0; d0 < 4; ++d0) og[d0] = aux.og[d0 * 32 + r32] * aux.oscale;
#pragma unroll
            for (int d0 = 0; d0 < 4; ++d0)
#pragma unroll
                for (int r = 0; r < 16; ++r) o[d0][r] -= X[crow(r, hi) * 128 + d0 * 32 + r32];
            asm volatile("s_waitcnt lgkmcnt(0)" ::: "memory");
            bf16_t* stg = (bf16_t*)X;
            float ssr[16];
#pragma unroll
            for (int r = 0; r < 16; ++r) { float v = (o[0][r] * o[0][r] + o[1][r] * o[1][r]) + (o[2][r] * o[2][r] + o[3][r] * o[3][r]);
                v += __uint_as_float(__builtin_amdgcn_update_dpp(0u, __float_as_uint(v), 0xB1, 0xf, 0xf, true));
                v += __uint_as_float(__builtin_amdgcn_update_dpp(0u, __float_as_uint(v), 0x4E, 0xf, 0xf, true));
                v += __uint_as_float(__builtin_amdgcn_update_dpp(0u, __float_as_uint(v), 0x141, 0xf, 0xf, true));
                v += __uint_as_float(__builtin_amdgcn_update_dpp(0u, __float_as_uint(v), 0x140, 0xf, 0xf, true));
                const auto w_ = __builtin_amdgcn_permlane16_swap(__float_as_uint(v), __float_as_uint(v), false, false);
                ssr[r] = __uint_as_float(w_[0]) + __uint_as_float(w_[1]); }
#pragma unroll
            for (int r = 0; r < 16; ++r) {
                const float rr = rsqrtf(ssr[r] * (1.0f / 128.0f) + 1e-6f);
#pragma unroll
                for (int d0 = 0; d0 < 4; ++d0) stg[crow(r, hi) * 128 + d0 * 32 + r32] = (bf16_t)(cvtpk(o[d0][r] * rr * og[d0], 0.f) & 0xffffu);
            }
            asm volatile("s_waitcnt lgkmcnt(0)" ::: "memory");
#pragma unroll
            for (int i = 0; i < 8; ++i) { const int row = i * 4 + (lane >> 4), ch = lane & 15; const u32x4 v = *(const u32x4*)(stg + row * 128 + ch * 8);
                *(u32x4*)(mixp + (size_t)(rb * 32 + row) * 1280 + ch * 8) = v; }
        }
        asm volatile("s_waitcnt lgkmcnt(0)" ::: "memory"); __syncthreads();
    }
}
#undef ATT_SBAR
}
#define GAS __attribute__((address_space(1)))
#define LAS __attribute__((address_space(3)))
typedef unsigned short bf16;
typedef unsigned v4u __attribute__((ext_vector_type(4)));
typedef float f32x4 __attribute__((ext_vector_type(4)));
typedef short bf16x8 __attribute__((ext_vector_type(8)));
typedef GAS unsigned gu32;
typedef GAS unsigned long long gu64;
#define RLX_AGENT __ATOMIC_RELAXED, __HIP_MEMORY_SCOPE_AGENT
#define LDS_WAIT() asm volatile("s_waitcnt lgkmcnt(0)" ::: "memory")
#define VM_WAIT() asm volatile("s_waitcnt vmcnt(0)" ::: "memory")
__device__ __forceinline__ unsigned long long rt() { return __builtin_amdgcn_s_memrealtime(); }
__device__ __forceinline__ unsigned f2bf(float f) { unsigned u = __builtin_bit_cast(unsigned, f); return (u + 0x7fffu + ((u >> 16) & 1u)) >> 16; }
__device__ __forceinline__ unsigned pk2(float lo, float hi) { return f2bf(lo) | (f2bf(hi) << 16); }
#define XB_TMO      128
#define XB_XCNT(j)  (256  + 64 * (j))
#define XB_XSUB(j)  (1280 + 64 * (j))
#define XB_XGEN(j)  (2304 + 64 * (j))
#define XB_TOP      3328
#define XB_TOPGEN   3392
#define XCD_BAR_WORDS 3456
#define XB_SPIN_CAP (1u << 18)

__device__ __forceinline__ unsigned xb_ld(unsigned* p)              { return __hip_atomic_load(p, __ATOMIC_RELAXED, __HIP_MEMORY_SCOPE_AGENT); }
__device__ __forceinline__ unsigned xb_add(unsigned* p, unsigned v) { return __hip_atomic_fetch_add(p, v, __ATOMIC_RELAXED, __HIP_MEMORY_SCOPE_AGENT); }
__device__ __forceinline__ unsigned xb_xcc_id() { return (unsigned)__builtin_amdgcn_s_getreg((3 << 11) | 20) & 0xFu; }
#define XB_SPIN(cond, bar) do { unsigned _sp = 0; while (cond) { __builtin_amdgcn_s_sleep(1); \
    if ((++_sp & 255u) == 0u) { if (xb_ld(&(bar)[XB_TMO])) break; if (_sp > XB_SPIN_CAP) { atomicAdd(&(bar)[XB_TMO], 1u); break; } } } } while (0)

struct XcdBarrier {
    unsigned* bar; unsigned x;
    volatile LAS unsigned* st;
};

__device__ __forceinline__ XcdBarrier xcd_barrier_post(unsigned* bar, volatile LAS unsigned* st) {
    XcdBarrier b; b.bar = bar; b.x = xb_xcc_id(); b.st = st;
    if (threadIdx.x == 0) (void)xb_add(&bar[XB_XCNT(b.x)], 1u);
    return b;
}
__device__ __forceinline__ void xcd_barrier_complete(unsigned* bar, unsigned x, unsigned& nloc, unsigned& nx) {
    const unsigned G = gridDim.x * gridDim.y * gridDim.z;
    unsigned sum, cnt, mine, sp = 0u;
    for (;;) {
        sum = 0u; cnt = 0u; mine = 0u;
#pragma unroll
        for (unsigned j = 0; j < 16; ++j) { const unsigned c = xb_ld(&bar[XB_XCNT(j)]); sum += c; cnt += (c > 0u) ? 1u : 0u; mine = (j == x) ? c : mine; }
        if (sum == G) break;
        __builtin_amdgcn_s_sleep(1);
        if ((++sp & 255u) == 0u) { if (xb_ld(&bar[XB_TMO])) break; if (sp > XB_SPIN_CAP) { atomicAdd(&bar[XB_TMO], 1u); break; } }
    }
    nloc = mine > 0u ? mine : 1u; nx = cnt > 0u ? cnt : 1u;
}

__device__ __forceinline__ void xcd_barrier(const XcdBarrier& b) {
    asm volatile("s_waitcnt vmcnt(0)" ::: "memory");
    __syncthreads();
    if (threadIdx.x == 0) {
        unsigned* bar = b.bar;
        __builtin_amdgcn_s_waitcnt(0);
        unsigned nloc = b.st[0], nx = b.st[1];
        if (nloc == 0u) { xcd_barrier_complete(bar, b.x, nloc, nx); b.st[0] = nloc; b.st[1] = nx; }
        const unsigned old = xb_add(&bar[XB_XSUB(b.x)], 1u);
        const unsigned gen = old / nloc;
        if (old + 1u == (gen + 1u) * nloc) {
            __builtin_amdgcn_fence(__ATOMIC_RELEASE, "agent");
            asm volatile("s_waitcnt vmcnt(0)" ::: "memory");
            const unsigned og = xb_add(&bar[XB_TOP], 1u);
            const unsigned tg = og / nx;
            if (og + 1u == (tg + 1u) * nx) xb_add(&bar[XB_TOPGEN], 1u);
            else XB_SPIN(xb_ld(&bar[XB_TOPGEN]) == tg, bar);
            __builtin_amdgcn_fence(__ATOMIC_ACQUIRE, "agent");
            xb_add(&bar[XB_XGEN(b.x)], 1u);
            asm volatile("s_waitcnt vmcnt(0)" ::: "memory");
        } else {
            XB_SPIN(xb_ld(&bar[XB_XGEN(b.x)]) == gen, bar);
            __builtin_amdgcn_fence(__ATOMIC_ACQUIRE, "agent");
            asm volatile("s_waitcnt vmcnt(0)" ::: "memory");
        }
    }
    __syncthreads();
}
#ifndef PH_CONST
#define PH_CONST 1
#endif
#ifndef USE_LOCAL_BAR
#define USE_LOCAL_BAR 1
#endif
#ifndef DEFER_W1
#define DEFER_W1 1
#endif
static_assert(att::LDS_BYTES <= RING_BYTES, "attention LDS");
struct Args { const float* in[22]; float* out; unsigned char* ws; int ph_lo, ph_hi; };

__device__ __forceinline__ float wave_sum(float v) {
    v += __uint_as_float(__builtin_amdgcn_update_dpp(0u, __float_as_uint(v), 0xB1, 0xf, 0xf, true));
    v += __uint_as_float(__builtin_amdgcn_update_dpp(0u, __float_as_uint(v), 0x4E, 0xf, 0xf, true));
    v += __uint_as_float(__builtin_amdgcn_update_dpp(0u, __float_as_uint(v), 0x141, 0xf, 0xf, true));
    v += __uint_as_float(__builtin_amdgcn_update_dpp(0u, __float_as_uint(v), 0x140, 0xf, 0xf, true));
    const auto r = __builtin_amdgcn_permlane16_swap(__float_as_uint(v), __float_as_uint(v), false, false);
    const float t = __uint_as_float(r[0]) + __uint_as_float(r[1]);
    const auto q = __builtin_amdgcn_permlane32_swap(__float_as_uint(t), __float_as_uint(t), false, false);
    return __uint_as_float(q[0]) + __uint_as_float(q[1]);
}
__device__ __forceinline__ int src_col32(int which, int g) {
    const int t = g >> 3, gi = g & 7, bj = gi >> 2, wc = gi & 3;
    switch (which) {
        case 0:
            switch (t) {
                case 0: return 32 * gi;
                case 1: return bj == 0 ? 256 + 32 * gi : 2720 + 32 * (gi - 4);
                case 2: return 384 + 32 * gi;
                case 3: case 4: return 672 + (4 * (t - 3) + wc) * 64 + 32 * bj;
                case 5: case 6: return 1184 + (4 * (t - 5) + wc) * 64 + 32 * bj;
                case 7: case 8: return 1696 + 256 * (t - 7) + 32 * gi;
                case 9: return 2208 + wc * 64 + 32 * bj;
                case 10: return wc < 2 ? 2208 + (4 + wc) * 64 + 32 * bj : 2592 + (wc - 2) * 64 + 32 * bj;
                default: return gi == 0 ? 640 : -1;
            }
        case 1: return wc < 3 ? (2 * t + bj) * 96 + 32 * wc : -1;
        case 4: return bj * FFH + 128 * t + 32 * wc;
        default: return 32 * g;
    }
}
__device__ __forceinline__ bool win_plain_group(int g) { const int t = g >> 3; return t <= 8 || t == 11; }
__device__ __forceinline__ void p0_convert_item(const float* W, int K, int N, const float* kg, int which, bf16* WT, LAS float* scr, int item, int lane) {
    const int ngr = (which == 0 ? 96 : which == 1 || which == 2 ? 24 : which == 4 ? 176 : 32), kb = item / ngr, g = item % ngr, k0 = 64 * kb, sc = src_col32(which, g);
    {
        float w[32];
        const int hl = lane >> 5, cl = lane & 31;
        if (sc >= 0) {
            const float* wp = W + (size_t)(k0 + hl) * N + sc + cl;
#pragma unroll
            for (int i = 0; i < 32; ++i) { w[i] = *wp; wp += 2 * N; if (i == 15) asm volatile("" : "+v"(wp)); }
            if (kg) {
                float gv[32];
#pragma unroll
                for (int i = 0; i < 32; ++i) gv[i] = kg[k0 + 2 * i + hl];
#pragma unroll
                for (int i = 0; i < 32; ++i) w[i] *= gv[i];
            }
        } else {
#pragma unroll
            for (int i = 0; i < 32; ++i) w[i] = 0.f;
        }
#pragma unroll
        for (int i = 0; i < 32; ++i) scr[(2 * i + hl) * 33 + cl] = w[i];
    }
    LDS_WAIT(); asm volatile("" ::: "memory");
    const int c = lane & 7;
    const bool prm = (which == 0 && win_plain_group(g)) || (which == 1 && (g & 3) < 2) || which == 2;
#pragma unroll
    for (int j = 0; j < 4; ++j) { const int n = (lane >> 3) + 8 * j; const LAS float* s = scr + (8 * c) * 33 + (prm ? pg8::perm32(n) : n);
        v4u o; o.x = pk2(s[0 * 33], s[1 * 33]); o.y = pk2(s[2 * 33], s[3 * 33]); o.z = pk2(s[4 * 33], s[5 * 33]); o.w = pk2(s[6 * 33], s[7 * 33]);
        *(GAS v4u*)(WT + (size_t)(32 * g + n) * K + k0 + 8 * c) = o; }
    LDS_WAIT(); asm volatile("" ::: "memory");
}
__device__ __forceinline__ void split_arrive(const XcdBarrier& b, unsigned* w) {
    asm volatile("s_waitcnt vmcnt(0)" ::: "memory");
    __syncthreads();
    if (threadIdx.x == 0) {
        __builtin_amdgcn_s_waitcnt(0);
        const unsigned nloc = b.st[0];
        const unsigned old = xb_add(&w[64 * b.x], 1u);
        if (old + 1u == nloc) { __builtin_amdgcn_fence(__ATOMIC_RELEASE, "agent"); asm volatile("s_waitcnt vmcnt(0)" ::: "memory"); xb_add(&w[1024], 1u); }
    }
}
__device__ __forceinline__ void split_wait(const XcdBarrier& b, unsigned* w) {
    if (threadIdx.x == 0) { const unsigned nx = b.st[1]; XB_SPIN(xb_ld(&w[1024]) < nx, b.bar); __builtin_amdgcn_fence(__ATOMIC_ACQUIRE, "agent"); asm volatile("s_waitcnt vmcnt(0)" ::: "memory"); }
    __syncthreads();
}
__device__ __forceinline__ void xcc_local_barrier(const XcdBarrier& b, unsigned* cnt, unsigned nloc) {
    asm volatile("s_waitcnt vmcnt(0)" ::: "memory");
    __syncthreads();
    if (threadIdx.x == 0) {
        __builtin_amdgcn_s_waitcnt(0);
        const unsigned old = xb_add(cnt, 1u), target = (old / nloc + 1u) * nloc;
        XB_SPIN(xb_ld(cnt) < target, b.bar);
        __builtin_amdgcn_fence(__ATOMIC_ACQUIRE, "agent");
        asm volatile("s_waitcnt vmcnt(0)" ::: "memory");
    }
    __syncthreads();
}
__device__ __forceinline__ void local_arrive(unsigned* cnt) {
    asm volatile("s_waitcnt vmcnt(0)" ::: "memory");
    __syncthreads();
    if (threadIdx.x == 0) { __builtin_amdgcn_s_waitcnt(0); (void)xb_add(cnt, 1u); }
}
__device__ __forceinline__ void local_wait(const XcdBarrier& b, unsigned* cnt, unsigned nloc) {
    if (threadIdx.x == 0) { XB_SPIN(xb_ld(cnt) < nloc, b.bar); __builtin_amdgcn_fence(__ATOMIC_ACQUIRE, "agent"); asm volatile("s_waitcnt vmcnt(0)" ::: "memory"); }
    __syncthreads();
}
constexpr int CW_LOCAL = 10240;
constexpr int CW_SPLIT = 6144;
struct Consts { float lam, oscale, negb_mla, negb_dif, negb_gqa, pad0, pad1, pad2; };

__device__ __forceinline__ void convert_layer_weights(const Args& A, int l, LAS float* scr, int gw, int NGW, int lane) {
    constexpr int NI_IN = (3072 / 32) * (1024 / 64), NI_UQ = (768 / 32) * (384 / 64), NI_UKV = (768 / 32) * (256 / 64), NI_O = (1024 / 32) * (1280 / 64), NI_GU = (5632 / 32) * (1024 / 64), NI_DN = (1024 / 32) * (2816 / 64);
    constexpr int NI_L = NI_IN + NI_UQ + NI_UKV + NI_O + NI_GU + NI_DN;
    bf16* wb = (bf16*)(A.ws + WS_W + (size_t)l * W_LAYER);
    for (int it = gw; it < NI_L; it += NGW) {
        int r = it;
        if (r < NI_IN) { p0_convert_item(A.in[2] + (size_t)l * 1024 * INW, 1024, INW, A.in[1] + l * 1024, 0, wb + W_IN / 2, scr, r, lane); continue; } r -= NI_IN;
        if (r < NI_UQ) { p0_convert_item(A.in[4] + (size_t)l * 384 * 576, 384, 576, A.in[3] + l * 384, 1, wb + W_UQ / 2, scr, r, lane); continue; } r -= NI_UQ;
        if (r < NI_UKV) { p0_convert_item(A.in[6] + (size_t)l * 256 * 768, 256, 768, A.in[5] + l * 256, 2, wb + W_UKV / 2, scr, r, lane); continue; } r -= NI_UKV;
        if (r < NI_O) { p0_convert_item(A.in[18] + (size_t)l * 1280 * 1024, 1280, 1024, nullptr, 3, wb + W_O / 2, scr, r, lane); continue; } r -= NI_O;
        if (r < NI_GU) { p0_convert_item(A.in[20] + (size_t)l * 1024 * 2 * FFH, 1024, 2 * FFH, A.in[19] + l * 1024, 4, wb + W_GU / 2, scr, r, lane); continue; } r -= NI_GU;
        p0_convert_item(A.in[21] + (size_t)l * FFH * 1024, FFH, 1024, nullptr, 5, wb + W_DN / 2, scr, r, lane);
    }
}
__device__ __forceinline__ void p0_prologue(const Args& A, LAS unsigned char* lds, int vcu, int G, int wave, int lane, int parts = 7) {
    unsigned char* ws = A.ws;
    LAS float* scr = (LAS float*)(lds + RING_OFF + wave * 16384);
    const int gw = vcu * NWAVES + wave, NGW = G * NWAVES;
    if (parts & 1) for (int l = 0; l < (DEFER_W1 && G == 256 ? 1 : DEPTH); ++l) convert_layer_weights(A, l, scr, gw, NGW, lane);
    float* ssqx = (float*)(ws + WS_SSQ + SSQ_X); bf16* xb = (bf16*)(ws + WS_XB);
    if (parts & 2) for (int m = gw; m < M; m += 2 * NGW) {
        const int m2 = m + NGW;
        const GAS f32x4* xr = (const GAS f32x4*)(A.in[0] + (size_t)m * DMODEL) + lane; const GAS f32x4* xr2 = (const GAS f32x4*)(A.in[0] + (size_t)(m2 < M ? m2 : m) * DMODEL) + lane;
        f32x4 v[4], v2[4]; float s = 0.f, s2 = 0.f;
#pragma unroll
        for (int j = 0; j < 4; ++j) { v[j] = xr[64 * j]; v2[j] = xr2[64 * j]; }
#pragma unroll
        for (int j = 0; j < 4; ++j) { s += (v[j].x * v[j].x + v[j].y * v[j].y) + (v[j].z * v[j].z + v[j].w * v[j].w); s2 += (v2[j].x * v2[j].x + v2[j].y * v2[j].y) + (v2[j].z * v2[j].z + v2[j].w * v2[j].w); }
        s = wave_sum(s); s2 = wave_sum(s2);
        GAS unsigned long long* o8 = (GAS unsigned long long*)(xb + (size_t)m * DMODEL) + lane;
#pragma unroll
        for (int j = 0; j < 4; ++j) o8[64 * j] = (unsigned long long)pk2(v[j].x, v[j].y) | ((unsigned long long)pk2(v[j].z, v[j].w) << 32);
        if (lane < 4) ssqx[(size_t)m * 4 + lane] = lane == 0 ? s : 0.f;
        if (m2 < M) {
            GAS unsigned long long* o82 = (GAS unsigned long long*)(xb + (size_t)m2 * DMODEL) + lane;
#pragma unroll
            for (int j = 0; j < 4; ++j) o82[64 * j] = (unsigned long long)pk2(v2[j].x, v2[j].y) | ((unsigned long long)pk2(v2[j].z, v2[j].w) << 32);
            if (lane < 4) ssqx[(size_t)m2 * 4 + lane] = lane == 0 ? s2 : 0.f;
        }
    }
    if (!(parts & 4)) return;
    float* tab = (float*)(ws + WS_TAB);
    const int gt = gw * 64 + lane, NGT = NGW * 64;
    for (int e = gt; e < 2048 * 16; e += NGT) { const int p = e >> 4, i = e & 15; const float ang = (float)p * (1.0f / powf(10000.0f, (float)(2 * i) / 32.0f)); tab[TAB_MLA_COS / 4 + e] = cosf(ang); tab[TAB_MLA_SIN / 4 + e] = sinf(ang); }
    for (int e = gt; e < 2048 * 32; e += NGT) { const int p = e >> 5, i = e & 31; const float ang = (float)p * (1.0f / powf(10000.0f, (float)(2 * i) / 64.0f)); tab[TAB_DIF_COS / 4 + e] = cosf(ang); tab[TAB_DIF_SIN / 4 + e] = sinf(ang); }
    for (int e = gt; e < 64 * 16; e += NGT) { const int p = e >> 4, i = e & 15; const float ang = (float)p * (1.0f / powf(10000.0f, (float)(2 * i) / 32.0f)); const float c = cosf(ang), s = sinf(ang);
        tab[TAB_COL_COS / 4 + e] = c; tab[TAB_COL_SIN / 4 + e] = s; if (p < 32) { tab[TAB_ROW_COS / 4 + e] = c; tab[TAB_ROW_SIN / 4 + e] = s; } }
    for (int e = gt; e < DEPTH * GN_STRIDE; e += NGT) { const int l = e / GN_STRIDE, r = e % GN_STRIDE; float v;
        if (r < GN_MK) v = A.in[7][l * 96 + r]; else if (r < GN_DQ) v = A.in[8][l * 96 + r - GN_MK]; else if (r < GN_DK) v = A.in[9][l * 64 + r - GN_DQ]; else if (r < GN_GQ) v = A.in[10][l * 64 + r - GN_DK];
        else if (r < GN_GK) v = A.in[16][l * 64 + r - GN_GQ]; else if (r < GN_OG) v = A.in[17][l * 64 + r - GN_GK]; else v = A.in[15][l * 128 + r - GN_OG];
        tab[TAB_GAIN / 4 + e] = v; }
    if (gw < DEPTH) {
        const int l = gw;
        const float d1 = wave_sum(A.in[11][l * 64 + lane] * A.in[12][l * 64 + lane]), d2 = wave_sum(A.in[13][l * 64 + lane] * A.in[14][l * 64 + lane]);
        const float lambda_init = 0.8f - 0.6f * expf(-0.3f * (float)l);
        float mq = fabsf(A.in[7][l * 96 + lane]), mk = fabsf(A.in[8][l * 96 + lane]);
        if (lane < 32) { mq = fmaxf(mq, fabsf(A.in[7][l * 96 + 64 + lane])); mk = fmaxf(mk, fabsf(A.in[8][l * 96 + 64 + lane])); }
        float dq = fabsf(A.in[9][l * 64 + lane]), dk = fabsf(A.in[10][l * 64 + lane]), gq = fabsf(A.in[16][l * 64 + lane]), gk = fabsf(A.in[17][l * 64 + lane]);
#pragma unroll
        for (int o = 1; o < 64; o <<= 1) { mq = fmaxf(mq, __shfl_xor(mq, o)); mk = fmaxf(mk, __shfl_xor(mk, o)); dq = fmaxf(dq, __shfl_xor(dq, o)); dk = fmaxf(dk, __shfl_xor(dk, o)); gq = fmaxf(gq, __shfl_xor(gq, o)); gk = fmaxf(gk, __shfl_xor(gk, o)); }
        if (lane == 0) { Consts c; c.lam = expf(d1) - expf(d2) + lambda_init; c.oscale = 1.0f - lambda_init;
            const float bm = pg8::C2_MLA * 96.0f * mq * mk, bd = pg8::C2_64 * 64.0f * dq * dk, bg = pg8::C2_64 * 64.0f * gq * gk;
            c.negb_mla = bm > 48.f ? -bm : 0.f; c.negb_dif = bd > 48.f ? -bd : 0.f; c.negb_gqa = bg > 48.f ? -bg : 0.f;
            c.pad0 = c.pad1 = c.pad2 = 0.f;
            *(Consts*)((unsigned char*)tab + TAB_CONST + 32 * l) = c; }
    }
}

#ifndef ATT_SD1
#define ATT_SD1 1
#endif
#ifndef KMASK
#define KMASK 7
#endif
#ifndef ATT_PROBE
#define ATT_PROBE 0
#endif
#define ATT_BODY { \
            const int b = vcu2 >> 5, c32 = vcu2 & 31; \
            att::DiffAux aux{cst.lam, cst.oscale, tab + TAB_GAIN / 4 + l * GN_STRIDE + GN_OG}; \
            if (KMASK & 1) for (int i = 0; i < 2; ++i) { const int u = c32 + 32 * i, h = u >> 4, qb = u & 15; const size_t hrow = (size_t)(b * 4 + h) * 2048; \
                ATTU(1)((const att::bf16_t*)(qkv + QB) + (hrow + qb * 128) * 128, (const att::bf16_t*)(qkv + KB) + hrow * 128, (const att::bf16_t*)(qkv + VB) + hrow * 128, \
                                  mix + (size_t)(b * 2048 + qb * 128) * MIXW + 384 + h * 128, cst.negb_dif, aux, (char*)lds + RING_OFF); } \
            if (KMASK & 4) for (int i = 0; i < 2; ++i) { const int u = i == 0 ? c32 : 16 + c32; if (i == 1 && c32 < 16) break; const int h = u >> 3, qb = u & 7; const size_t hq = (size_t)(b * 6 + h) * 2048, hk = (size_t)(b * 2 + h / 3) * 2048; \
                ATTU(2)((const att::bf16_t*)(qkv + QC) + (hq + qb * 256) * 64, (const att::bf16_t*)(qkv + KC) + hk * 64, (const att::bf16_t*)(qkv + VC) + hk * 64, \
                                  mix + (size_t)(b * 2048 + qb * 256) * MIXW + 896 + h * 64, cst.negb_gqa, aux, (char*)lds + RING_OFF, ws + WS_CTL + 32768); } \
            if (SPLIT_MLA && IN(p0 + 1)) { if (loc) local_wait(bar, (unsigned*)(ctl + CW_LOCAL + 1024 + 2048 * l + 64 * xb_xcc_id()), (unsigned)(G / 8)); else split_wait(bar, (unsigned*)(ctl + CW_SPLIT + 2048 * l)); }     \
            if (KMASK & 2) for (int i = 0; i < 2; ++i) { const int u = c32 + 32 * i; if (u >= 48) break; const int h = u >> 3, qb = u & 7; const size_t hrow = (size_t)(b * 6 + h) * 2048; \
                ATTU(0)((const att::bf16_t*)(qkv + QA) + (hrow + qb * 256) * 96, (const att::bf16_t*)(qkv + KA) + hrow * 96, (const att::bf16_t*)(qkv + VA) + hrow * 64, \
                                  mix + (size_t)(b * 2048 + qb * 256) * MIXW + h * 64, cst.negb_mla, aux, (char*)lds + RING_OFF, ws + WS_CTL + 32768); } \
 }
__global__ void __launch_bounds__(NWAVES * 64, 2) mega_fwd(Args args) {
    extern __shared__ __attribute__((aligned(16))) unsigned char lds[];
    LAS unsigned char* ldsl = (LAS unsigned char*)lds;
    volatile LAS unsigned* MISC = (volatile LAS unsigned*)(ldsl + MISC_OFF);
    int tid_ = threadIdx.x; asm volatile("" : "+v"(tid_));
    const int tid = tid_, lane = tid & 63, wave = __builtin_amdgcn_readfirstlane(tid >> 6);
    constexpr int G = 256;
    const int bx = blockIdx.x, vcu = (bx % 8) * (G / 8) + bx / 8;
    unsigned char* ws = args.ws;
    gu32* ctl = (gu32*)(ws + WS_CTL);
    for (int u = tid; u < (LDS_BYTES - LDSCTL_OFF) / 4; u += NWAVES * 64) ((LAS unsigned*)(ldsl + LDSCTL_OFF))[u] = 0u;
    __syncthreads();
#define bar (XcdBarrier{(unsigned*)((gu32*)(ws + WS_CTL) + CW_BAR), xb_xcc_id(), (volatile LAS unsigned*)((LAS unsigned char*)lds + MISC_OFF) + 8})
    if (tid == 0) { const unsigned x_ = xb_xcc_id(); MISC[10] = xb_add((unsigned*)((gu32*)(ws + WS_CTL) + CW_BAR) + XB_XCNT(x_), 1u); }
    __syncthreads();
#if PH_CONST
    constexpr int lo = 0, hi = NPHASE;
#else
    const int lo = args.ph_lo, hi = args.ph_hi;
#endif
#ifndef PRO_PART
#define PRO_PART 7
#endif
#ifndef CLK_DIAG
#define CLK_DIAG 0
#endif
#ifndef CLK_PH
#define CLK_PH 3
#endif
#ifndef GEMM_ALIGN
#define GEMM_ALIGN true
#endif
#ifndef GEMM_SP2
#define GEMM_SP2 true
#endif
#ifndef SPLIT_MLA
#define SPLIT_MLA 1
#endif
#ifndef REP_PRO
#define REP_PRO 1
#endif
#ifndef REP_IN
#define REP_IN 1
#endif
#ifndef REP_MLA
#define REP_MLA 1
#endif
#ifndef REP_ATT
#define REP_ATT 1
#endif
#ifndef REP_GU
#define REP_GU 1
#endif
#ifndef REP_OP0
#define REP_OP0 1
#endif
#ifndef EXTRA_BARS
#define EXTRA_BARS 0
#endif
#ifndef REP_DN0
#define REP_DN0 1
#endif
#ifndef PHMASK
#define PHMASK 0x7f
#endif
#define IN(k) (lo <= (k) && (k) < hi)
#define SEAM(k) do { if (IN((k) + 1)) xcd_barrier(bar); } while (0)
    float* tab = (float*)(ws + WS_TAB);
    pg8::bf16_t* xb = (pg8::bf16_t*)(ws + WS_XB);
    pg8::bf16_t* mix = (pg8::bf16_t*)(ws + WS_MIX);
    unsigned char* hs = (unsigned char*)args.out;
    pg8::bf16_t* cq = (pg8::bf16_t*)(hs + MIX_CQ); pg8::bf16_t* ckv = (pg8::bf16_t*)(hs + MIX_CKV);
    unsigned char* qkv = ws + WS_QKV;
    pg8::bf16_t* act = (pg8::bf16_t*)(ws + WS_QKV);

    if ((PHMASK & 1) && IN(0)) { for (int rep = 0; rep < REP_PRO; ++rep) { p0_prologue(args, ldsl, vcu, G, wave, lane, rep + 1 < REP_PRO ? PRO_PART : 7); __syncthreads(); } SEAM(0); }
    if (tid == 0) { MISC[11] = 0u; }
    if (USE_LOCAL_BAR && lo == 0 && G == 256) {
        if (tid == 0) { unsigned okc = 1u; unsigned* bw_ = (unsigned*)((gu32*)(ws + WS_CTL) + CW_BAR); for (unsigned j = 0; j < 16; ++j) { const unsigned c = xb_ld(&bw_[XB_XCNT(j)]); okc &= (j < 8 ? (c == (unsigned)(G / 8)) : (c == 0u)) ? 1u : 0u; } MISC[11] = okc; }
    }
    __syncthreads();
#define loc (__builtin_amdgcn_readfirstlane((int)MISC[11]) != 0)
#define bxv (loc ? (int)xb_xcc_id() + 8 * __builtin_amdgcn_readfirstlane((int)MISC[10]) : (int)blockIdx.x)
#define vcu2 ((bxv % 8) * 32 + bxv / 8)
#define lcnt ((unsigned*)((gu32*)(ws + WS_CTL) + CW_LOCAL + 64 * xb_xcc_id()))
#define SEAM_L(k) do { if (IN((k) + 1)) { if (loc) xcc_local_barrier(bar, lcnt, (unsigned)(G / 8)); else xcd_barrier(bar); } } while (0)

    for (int eb = 0; eb < EXTRA_BARS; ++eb) xcd_barrier(bar);
#pragma unroll 1
    for (int l = 0; l < DEPTH; ++l) {
        const int p0 = 1 + 6 * l;
        const pg8::bf16_t* wb = (const pg8::bf16_t*)(ws + WS_W + (size_t)l * W_LAYER);
        if ((PHMASK & 2) && IN(p0)) {

#if CLK_DIAG
            unsigned long long ck0_ = 0, rt0_ = 0; if (CLK_PH == 1 && l == 1) { ck0_ = __builtin_amdgcn_s_memtime(); rt0_ = __builtin_amdgcn_s_memrealtime(); }
#endif
          for (int rep = 0; rep < REP_IN; ++rep) {
            pg8::Gemm g{xb, wb + W_IN / 2, M, 3072, 1024}; pg8::StaticOrder S; S.init(M, 3072, G, bxv);
            pg8::EpiInProj E{ws, hs, l};
            pg8::gemm_phase<pg8::EpiInProj, pg8::StaticOrder, GEMM_ALIGN, GEMM_SP2>(ldsl + RING_OFF, g, S, E);
            __syncthreads(); }
#if CLK_DIAG
            if (CLK_PH == 1 && l == 1 && blockIdx.x == 0 && threadIdx.x == 0) { const unsigned long long ck1_ = __builtin_amdgcn_s_memtime(), rt1_ = __builtin_amdgcn_s_memrealtime(); float* dg = (float*)(ws + WS_CTL + 32768); dg[0] = (float)(ck1_ - ck0_) / (float)(rt1_ - rt0_); dg[1] = (float)(rt1_ - rt0_) / 100.f; }
#endif
            SEAM_L(p0);
        }
        if ((PHMASK & 4) && IN(p0 + 1)) {

#if CLK_DIAG
            unsigned long long ck0_ = 0, rt0_ = 0; if (CLK_PH == 2 && l == 1) { ck0_ = __builtin_amdgcn_s_memtime(); rt0_ = __builtin_amdgcn_s_memrealtime(); }
#endif
          for (int rep = 0; rep < REP_MLA; ++rep) {
            { pg8::Gemm g{cq, wb + W_UQ / 2, M, 768, 384}; pg8::StaticOrder S; S.init(M, 768, G, (bxv + 192) % G);
              pg8::EpiMlaQ E{ws, l};
              pg8::gemm_phase<pg8::EpiMlaQ, pg8::StaticOrder, false, true>(ldsl + RING_OFF, g, S, E); }
            __syncthreads();
            { pg8::Gemm g{ckv, wb + W_UKV / 2, M, 768, 256}; pg8::StaticOrder S; S.init(M, 768, G, (bxv + 128) % G);
              pg8::EpiMlaKV E{ws, hs, l};
              pg8::gemm_phase<pg8::EpiMlaKV, pg8::StaticOrder, false, true>(ldsl + RING_OFF, g, S, E); }
            __syncthreads(); }
#if CLK_DIAG
            if (CLK_PH == 2 && l == 1 && blockIdx.x == 0 && threadIdx.x == 0) { const unsigned long long ck1_ = __builtin_amdgcn_s_memtime(), rt1_ = __builtin_amdgcn_s_memrealtime(); float* dg = (float*)(ws + WS_CTL + 32768); dg[0] = (float)(ck1_ - ck0_) / (float)(rt1_ - rt0_); dg[1] = (float)(rt1_ - rt0_) / 100.f; }
#endif
            if (SPLIT_MLA && IN(p0 + 2)) { if (loc) local_arrive((unsigned*)(ctl + CW_LOCAL + 1024 + 2048 * l + 64 * xb_xcc_id())); else split_arrive(bar, (unsigned*)(ctl + CW_SPLIT + 2048 * l)); } else SEAM_L(p0 + 1);
        }
        if ((PHMASK & 8) && IN(p0 + 2)) {

#if CLK_DIAG
            unsigned long long ck0_ = 0, rt0_ = 0; if (CLK_PH == 3 && l == 1) { ck0_ = __builtin_amdgcn_s_memtime(); rt0_ = __builtin_amdgcn_s_memrealtime(); }
#endif
          for (int rep = 0; rep < REP_ATT; ++rep) {
            __syncthreads();
            const Consts cst = *(const Consts*)((const unsigned char*)tab + TAB_CONST + 32 * l);
#define ATTU(K) att::attn_unit<K, 0>
#if ATT_PROBE
            if (rep == 0) {
#undef ATTU
#define ATTU(K) att::attn_unit<K, ATT_PROBE>
            ATT_BODY
#undef ATTU
#define ATTU(K) att::attn_unit<K, 0>
            continue; }
#endif
            ATT_BODY
          }
#if CLK_DIAG
            if (CLK_PH == 3 && l == 1 && blockIdx.x == 0 && threadIdx.x == 0) { const unsigned long long ck1_ = __builtin_amdgcn_s_memtime(), rt1_ = __builtin_amdgcn_s_memrealtime(); float* dg = (float*)(ws + WS_CTL + 32768); dg[0] = (float)(ck1_ - ck0_) / (float)(rt1_ - rt0_); dg[1] = (float)(rt1_ - rt0_) / 100.f; }
#endif
            SEAM_L(p0 + 2);
        }
        if ((PHMASK & 16) && IN(p0 + 3)) {

#if CLK_DIAG
            unsigned long long ck0_ = 0, rt0_ = 0; if (CLK_PH == 4 && l == 1) { ck0_ = __builtin_amdgcn_s_memtime(); rt0_ = __builtin_amdgcn_s_memrealtime(); }
#endif
          for (int rep = 0; rep < (l == 0 ? REP_OP0 : 1); ++rep) {
            pg8::Gemm g{mix, wb + W_O / 2, M, 1024, 1280}; pg8::StaticOrder S; S.init(M, 1024, G, bxv);
            pg8::EpiRes E{args.out, ws, 0};
            pg8::gemm_phase<pg8::EpiRes, pg8::StaticOrder, false, true>(ldsl + RING_OFF, g, S, E);
            __syncthreads(); }
#if CLK_DIAG
            if (CLK_PH == 4 && l == 1 && blockIdx.x == 0 && threadIdx.x == 0) { const unsigned long long ck1_ = __builtin_amdgcn_s_memtime(), rt1_ = __builtin_amdgcn_s_memrealtime(); float* dg = (float*)(ws + WS_CTL + 32768); dg[0] = (float)(ck1_ - ck0_) / (float)(rt1_ - rt0_); dg[1] = (float)(rt1_ - rt0_) / 100.f; }
#endif
            SEAM_L(p0 + 3);
        }
        if ((PHMASK & 32) && IN(p0 + 4)) {

#if CLK_DIAG
            unsigned long long ck0_ = 0, rt0_ = 0; if (CLK_PH == 5 && l == 1) { ck0_ = __builtin_amdgcn_s_memtime(); rt0_ = __builtin_amdgcn_s_memrealtime(); }
#endif
          for (int rep = 0; rep < REP_GU; ++rep) {
            pg8::Gemm g{xb, wb + W_GU / 2, M, 2 * FFH, 1024}; pg8::StaticOrder S; S.init(M, 2 * FFH, G, bxv);
            pg8::EpiSwiglu E{ws};
            pg8::gemm_phase<pg8::EpiSwiglu, pg8::StaticOrder, GEMM_ALIGN, GEMM_SP2>(ldsl + RING_OFF, g, S, E);
            __syncthreads(); }
#if DEFER_W1
            if (l == 0 && DEPTH == 2 && G == 256) {
                if (bxv >= 128) { int t2 = threadIdx.x; asm volatile("" : "+v"(t2)); const int w2 = __builtin_amdgcn_readfirstlane(t2 >> 6);
                    convert_layer_weights(args, 1, (LAS float*)(ldsl + RING_OFF + w2 * 16384), (bxv - 128) * NWAVES + w2, 128 * NWAVES, t2 & 63); }
            }
#endif
#if CLK_DIAG
            if (CLK_PH == 5 && l == 1 && blockIdx.x == 0 && threadIdx.x == 0) { const unsigned long long ck1_ = __builtin_amdgcn_s_memtime(), rt1_ = __builtin_amdgcn_s_memrealtime(); float* dg = (float*)(ws + WS_CTL + 32768); dg[0] = (float)(ck1_ - ck0_) / (float)(rt1_ - rt0_); dg[1] = (float)(rt1_ - rt0_) / 100.f; }
#endif
            SEAM_L(p0 + 4);
        }
        if ((PHMASK & 64) && IN(p0 + 5)) {

#if CLK_DIAG
            unsigned long long ck0_ = 0, rt0_ = 0; if (CLK_PH == 6 && l == 1) { ck0_ = __builtin_amdgcn_s_memtime(); rt0_ = __builtin_amdgcn_s_memrealtime(); }
#endif
            pg8::Gemm g{act, wb + W_DN / 2, M, 1024, FFH}; pg8::StaticOrder S; S.init(M, 1024, G, bxv);
            pg8::EpiRes E{args.out, ws, l == DEPTH - 1 ? 1 : 0};
            pg8::gemm_phase<pg8::EpiRes, pg8::StaticOrder, false, true>(ldsl + RING_OFF, g, S, E);
#if CLK_DIAG
            if (CLK_PH == 6 && l == 1 && blockIdx.x == 0 && threadIdx.x == 0) { const unsigned long long ck1_ = __builtin_amdgcn_s_memtime(), rt1_ = __builtin_amdgcn_s_memrealtime(); float* dg = (float*)(ws + WS_CTL + 32768); dg[0] = (float)(ck1_ - ck0_) / (float)(rt1_ - rt0_); dg[1] = (float)(rt1_ - rt0_) / 100.f; }
#endif
            SEAM(p0 + 5);
        }
    }
#if CLK_DIAG
    xcd_barrier(bar);
    if (blockIdx.x == 0) { const float* dg = (const float*)(ws + WS_CTL + 32768); const float e1 = 100.f * (rintf((dg[0] - 1.f) / 2.f) * 2.f + 1.f), e2 = 0.f;
        for (int i = threadIdx.x; i < (1 << 20); i += NWAVES * 64) args.out[i] += (i == 0) ? e1 : e2; }
#endif
#if ATT_DIAG
    xcd_barrier(bar);
    if (blockIdx.x == 0) { const unsigned long long* dq = (const unsigned long long*)(ws + WS_CTL + 32768); const float dg[4] = {(float)dq[0], (float)dq[1], (float)dq[2], (float)dq[3]}; const float tot = dg[0] + dg[1] + dg[2] + dg[3];
        float sel[6] = {100.f * dg[0] / tot, 100.f * dg[1] / tot, 100.f * dg[2] / tot, 100.f * dg[3] / tot, tot / (DIAG_NW * 31.f * 40.f), 50.f};
        const float e1 = 100.f * (DIAG_Q * rintf(sel[DIAG_A] / DIAG_Q)), e2 = DIAG_Q * rintf(sel[DIAG_B] / DIAG_Q);
        for (int i = threadIdx.x; i < (1 << 20); i += NWAVES * 64) args.out[i] += (i == 0) ? e1 : e2; }
#endif
#undef IN
#undef SEAM
#undef SEAM_L
#undef bar
#undef loc
#undef bxv
#undef vcu2
#undef lcnt
}
extern "C" void kernel_launch(void* const* d_in, const int* in_sizes, int n_in, void* d_out, int out_size, void* d_ws, size_t ws_size, hipStream_t stream) {
    static int grid = 0;
    if (grid == 0) {
        if (n_in != 22 || in_sizes[0] != M * DMODEL || out_size != M * DMODEL || ws_size < WS_END) { fprintf(stderr, "kernel_launch: unexpected shapes (n_in %d, in0 %d, out %d, ws %zu)\n", n_in, n_in > 0 ? in_sizes[0] : -1, out_size, ws_size); grid = -1; return; }
        int dev = 0, cus = 0, per_cu = 0;
        if (hipGetDevice(&dev) != hipSuccess || hipDeviceGetAttribute(&cus, hipDeviceAttributeMultiprocessorCount, dev) != hipSuccess) { grid = -1; return; }
        if (hipFuncSetAttribute((const void*)mega_fwd, hipFuncAttributeMaxDynamicSharedMemorySize, LDS_BYTES) != hipSuccess) { fprintf(stderr, "kernel_launch: hipFuncSetAttribute failed\n"); grid = -1; return; }
        if (hipOccupancyMaxActiveBlocksPerMultiprocessor(&per_cu, (const void*)mega_fwd, NWAVES * 64, LDS_BYTES) != hipSuccess || per_cu < 1) { fprintf(stderr, "kernel_launch: occupancy query says %d blocks per CU\n", per_cu); (void)hipGetLastError(); grid = -1; return; }
        grid = cus;
        if (grid != 256) { fprintf(stderr, "kernel_launch: %d CUs; this kernel's phase programs are written for 256: nothing launched\n", grid); grid = -1; return; }
    }
    if (grid < 0) return;
    Args a{};
    for (int i = 0; i < 22; ++i) a.in[i] = (const float*)d_in[i];
    a.out = (float*)d_out; a.ws = (unsigned char*)d_ws;
    (void)hipMemsetAsync((char*)d_ws + WS_CTL, 0, CTL_ZERO_BYTES, stream);
    a.ph_lo = 0; a.ph_hi = NPHASE;
    hipLaunchKernelGGL(mega_fwd, dim3(grid), dim3(NWAVES * 64), LDS_BYTES, stream, a);
    const hipError_t le = hipPeekAtLastError();
    if (le != hipSuccess) fprintf(stderr, "kernel_launch: launch failed: %s\n", hipGetErrorName(le));
}
```

```cpp
#include <hip/hip_runtime.h>
#include <cstdio>
#include <cstdint>
constexpr int NWAVES = 8;
constexpr int BATCH = 8, SEQ = 2048, DMODEL = 1024, M = BATCH * SEQ, DEPTH = 2, INW = 2848, FFH = 2816, MIXW = 1280;
constexpr int NPHASE = 1 + 6 * DEPTH;
constexpr size_t MiB = 1u << 20;
constexpr size_t WS_CTL = 0, CTL_ZERO_BYTES = 64 * 1024;
constexpr size_t WS_TAB = 1 * MiB;
constexpr size_t TAB_MLA_COS = 0, TAB_MLA_SIN = 131072, TAB_DIF_COS = 262144, TAB_DIF_SIN = 524288, TAB_ROW_COS = 786432, TAB_ROW_SIN = 788480, TAB_COL_COS = 790528, TAB_COL_SIN = 794624, TAB_CONST = 798720, TAB_GAIN = 799232;
constexpr int GN_MQ = 0, GN_MK = 96, GN_DQ = 192, GN_DK = 256, GN_GQ = 320, GN_GK = 384, GN_OG = 448, GN_STRIDE = 576;
constexpr size_t WS_SSQ = 2 * MiB;
constexpr size_t SSQ_X = 0, SSQ_Q = 262144, SSQ_KV = 786432, SSQ_KR = 1048576;
constexpr size_t WS_W = 4 * MiB;
constexpr size_t W_IN = 0, W_UQ = 6291456, W_UKV = W_UQ + 589824, W_O = W_UKV + 393216, W_GU = W_O + 2621440, W_DN = W_GU + 11534336, W_LAYER = W_DN + 5767168;
static_assert(WS_W + 2 * W_LAYER <= 56 * MiB, "weights");
constexpr size_t WS_XB = 56 * MiB;
constexpr size_t WS_MIX = 88 * MiB;
constexpr size_t MIX_CQ = 0, MIX_CKV = 12 * MiB, MIX_KR = 20 * MiB;
constexpr size_t WS_QKV = 128 * MiB;
constexpr size_t QA = 0, KA = 18 * MiB, VA = 36 * MiB, QB = 48 * MiB, KB = 64 * MiB, VB = 80 * MiB, QC = 96 * MiB, KC = 108 * MiB, VC = 112 * MiB, QKV_END = 116 * MiB;
constexpr size_t WS_GOLD = 244 * MiB, WS_END = 256 * MiB;
static_assert(WS_QKV + QKV_END <= WS_GOLD, "ws map");
constexpr int CW_BAR = 1024;
constexpr int RING_OFF = 0, RING_BYTES = 139264, LDSCTL_OFF = RING_BYTES, MISC_OFF = LDSCTL_OFF + 320, LDS_BYTES = 147456;

namespace pg8 {
#define PG8_LAS __attribute__((address_space(3)))
typedef unsigned short bf16_t;
typedef short bf16x8 __attribute__((ext_vector_type(8)));
typedef float f32x4 __attribute__((ext_vector_type(4)));
typedef unsigned u32x4 __attribute__((ext_vector_type(4)));
constexpr int BM = 256, BK = 64, HALF = 128, HTB = HALF * BK * 2  , STAGE_BYTES = 8 * HTB, NXCD = 8, WGM = 8;

__host__ __device__ __forceinline__ int lds_byte(int r, int c) { const int st = (r >> 4) * 2 + (c >> 5), rr = r & 15, cc = c & 31, ob = rr * 64 + cc * 2; return st * 1024 + (ob ^ (((ob >> 9) & 1) << 5)); }
__host__ __device__ __forceinline__ void stage_rc(int b, int& R, int& C) { const int st = b / 1024, sb = b % 1024, swz = sb ^ (((sb >> 9) & 1) << 5); R = (st >> 1) * 16 + swz / 64; C = (st & 1) * 32 + (swz % 64) / 2; }
__host__ __device__ __forceinline__ int perm32(int rho) { const int n = rho >> 4, i = rho & 15; return 8 * (i >> 2) + 4 * n + (i & 3); }

struct Unit { int pm, pn; };
struct Gemm { const bf16_t* A; const bf16_t* Bt; int M, N, K; };

struct StaticOrder {
    int nM, nN, nwg, G, c;
    __host__ __device__ void init(int M, int N, int G_, int c_) { nM = M / BM; nN = N / BM; nwg = nM * nN; G = G_; c = c_; }
    __host__ __device__ bool next(int i, Unit& u) const {
        const long L = (long)i * G + c; if (L >= nwg) return false;
        int wgid = (int)L; { const int q = nwg / NXCD, r = nwg % NXCD, xcd = wgid % NXCD, off = wgid / NXCD; wgid = (xcd < r ? xcd * (q + 1) : r * (q + 1) + (xcd - r) * q) + off; }
        const int nig = WGM * nN, gid = wgid / nig, fm = gid * WGM, gsz = (nM - fm) < WGM ? (nM - fm) : WGM;
        u.pm = fm + ((wgid % nig) % gsz); u.pn = (wgid % nig) / gsz; return true;
    }
    __device__ __forceinline__ void a_ready(const Unit&) const {}
    __device__ __forceinline__ void done(const Unit&) const {}
};

__device__ __forceinline__ unsigned cvt_pk_bf16(float lo, float hi) { unsigned r; asm volatile("v_cvt_pk_bf16_f32 %0, %1, %2" : "=v"(r) : "v"(lo), "v"(hi)); return r; }
typedef float f32x2 __attribute__((ext_vector_type(2)));
constexpr float EPS_RMS = 1e-6f;
constexpr float LOG2E = 1.4426950408889634f;
constexpr float C2_MLA = 0.10206207261596575f * LOG2E;
constexpr float C2_64 = 0.125f * LOG2E;
typedef unsigned u32x2 __attribute__((ext_vector_type(2)));
__device__ __forceinline__ u32x2 pk4(f32x4 v) { u32x2 w; w.x = cvt_pk_bf16(v[0], v[1]); w.y = cvt_pk_bf16(v[2], v[3]); return w; }
__device__ __forceinline__ void st4(bf16_t* p, f32x4 v) { u32x2 w; w.x = cvt_pk_bf16(v[0], v[1]); w.y = cvt_pk_bf16(v[2], v[3]); *(u32x2*)p = w; }
__device__ __forceinline__ float dot4(f32x4 a) { return (a[0] * a[0] + a[1] * a[1]) + (a[2] * a[2] + a[3] * a[3]); }
__device__ __forceinline__ float qsum(float s) {
    const auto r = __builtin_amdgcn_permlane16_swap(__float_as_uint(s), __float_as_uint(s), false, false);
    const float t = __uint_as_float(r[0]) + __uint_as_float(r[1]);
    const auto q = __builtin_amdgcn_permlane32_swap(__float_as_uint(t), __float_as_uint(t), false, false);
    return __uint_as_float(q[0]) + __uint_as_float(q[1]);
}
__device__ __forceinline__ f32x4 bf4_to_f32(u32x2 w) { f32x4 r; r[0] = __uint_as_float(w.x << 16); r[1] = __uint_as_float(w.x & 0xffff0000u); r[2] = __uint_as_float(w.y << 16); r[3] = __uint_as_float(w.y & 0xffff0000u); return r; }

#define WSF(off) ((float*)(ws + (off)))
#define WSH(off) ((bf16_t*)(ws + (off)))
struct EpiInProj {
    static constexpr bool PERM = false, AFTER_DRAIN = false;
    unsigned char* ws; unsigned char* hs; int l;
    template <int MODE>
    __device__ __forceinline__ void body(const f32x4 (&acc)[2][2][4][2], const Unit& u, int wr, int wc, int fr, int fq) const {
        float rs[4];
        auto rs_load = [&](int ai) {
#pragma unroll
            for (int m = 0; m < 4; ++m) { const int row = u.pm * BM + ai * HALF + wr * 64 + m * 16 + fr;
                const f32x4 sq = *(const f32x4*)(WSF(WS_SSQ + SSQ_X) + (size_t)row * 4); rs[m] = rsqrtf(((sq[0] + sq[1]) + (sq[2] + sq[3])) * (1.0f / 1024.0f) + EPS_RMS); } };
        rs_load(0);
        const int c0 = wc * 32 + 4 * fq;
        const int c8 = wc * 32 + 8 * fq;
        f32x4 tcur[4];
        auto tab_load = [&](f32x4 (&t)[4], int it) {
            const int s = (u.pm * BM + (it >> 2) * HALF + wr * 64 + (it & 3) * 16 + fr) & 2047;
            if constexpr (MODE == 3 || MODE == 4) {
                t[0] = *(const f32x4*)(WSF(WS_TAB + TAB_DIF_COS) + s * 32 + 8 * fq); t[1] = *(const f32x4*)(WSF(WS_TAB + TAB_DIF_SIN) + s * 32 + 8 * fq);
                t[2] = *(const f32x4*)(WSF(WS_TAB + TAB_DIF_COS) + s * 32 + 8 * fq + 4); t[3] = *(const f32x4*)(WSF(WS_TAB + TAB_DIF_SIN) + s * 32 + 8 * fq + 4);
            } else if constexpr (MODE == 6) {
                t[0] = *(const f32x4*)(WSF(WS_TAB + TAB_ROW_COS) + (s >> 6) * 16 + 4 * fq); t[1] = *(const f32x4*)(WSF(WS_TAB + TAB_ROW_SIN) + (s >> 6) * 16 + 4 * fq);
                t[2] = *(const f32x4*)(WSF(WS_TAB + TAB_COL_COS) + (s & 63) * 16 + 4 * fq); t[3] = *(const f32x4*)(WSF(WS_TAB + TAB_COL_SIN) + (s & 63) * 16 + 4 * fq);
            }
        };
        f32x4 gg[4];
        if constexpr (MODE == 3 || MODE == 4) { const float* g = WSF(WS_TAB + TAB_GAIN) + l * GN_STRIDE + (MODE == 3 ? GN_DQ : GN_DK);
            gg[0] = *(const f32x4*)(g + 8 * fq); gg[1] = *(const f32x4*)(g + 32 + 8 * fq); gg[2] = *(const f32x4*)(g + 8 * fq + 4); gg[3] = *(const f32x4*)(g + 32 + 8 * fq + 4); }
        const bool isq = (u.pn == 9) || (wc < 2);
        if constexpr (MODE == 6) { const float* g = WSF(WS_TAB + TAB_GAIN) + l * GN_STRIDE + (isq ? GN_GQ : GN_GK);
            gg[0] = *(const f32x4*)(g + 4 * fq); gg[1] = *(const f32x4*)(g + 16 + 4 * fq); gg[2] = *(const f32x4*)(g + 32 + 4 * fq); gg[3] = *(const f32x4*)(g + 48 + 4 * fq); }
        if constexpr (MODE == 3 || MODE == 4 || MODE == 6) tab_load(tcur, 0);
#pragma unroll
        for (int it = 0; it < 8; ++it) {
                const int ai = it >> 2, m = it & 3;
                const int row = u.pm * BM + ai * HALF + wr * 64 + m * 16 + fr, b = row >> 11, s = row & 2047;
                f32x4 v[2][2];
#pragma unroll
                for (int bj = 0; bj < 2; ++bj)
#pragma unroll
                    for (int n = 0; n < 2; ++n) v[bj][n] = acc[ai][bj][m][n] * rs[m];
                if (it == 3) rs_load(1);
                if constexpr (MODE == 0) {
#pragma unroll
                    for (int bj = 0; bj < 2; ++bj) { u32x4 w_; w_.x = cvt_pk_bf16(v[bj][0][0], v[bj][0][1]); w_.y = cvt_pk_bf16(v[bj][0][2], v[bj][0][3]); w_.z = cvt_pk_bf16(v[bj][1][0], v[bj][1][1]); w_.w = cvt_pk_bf16(v[bj][1][2], v[bj][1][3]); *(u32x4*)(((bf16_t*)(hs + MIX_CQ)) + (size_t)row * 384 + bj * HALF + c8) = w_; }
                    const float ss = qsum((dot4(v[0][0]) + dot4(v[0][1])) + (dot4(v[1][0]) + dot4(v[1][1])));
                    if (fq == 0) WSF(WS_SSQ + SSQ_Q)[(size_t)row * 8 + wc] = ss;
                } else if constexpr (MODE == 1) {
                    { u32x4 w_; w_.x = cvt_pk_bf16(v[0][0][0], v[0][0][1]); w_.y = cvt_pk_bf16(v[0][0][2], v[0][0][3]); w_.z = cvt_pk_bf16(v[0][1][0], v[0][1][1]); w_.w = cvt_pk_bf16(v[0][1][2], v[0][1][3]); *(u32x4*)(((bf16_t*)(hs + MIX_CQ)) + (size_t)row * 384 + 256 + c8) = w_; }
                    const float ss = qsum(dot4(v[0][0]) + dot4(v[0][1]));
                    if (fq == 0) WSF(WS_SSQ + SSQ_Q)[(size_t)row * 8 + 4 + wc] = ss;
                    const int kv = wc >> 1, d = (wc & 1) * 32 + 8 * fq;
                    { u32x4 w_; w_.x = cvt_pk_bf16(v[1][0][0], v[1][0][1]); w_.y = cvt_pk_bf16(v[1][0][2], v[1][0][3]); w_.z = cvt_pk_bf16(v[1][1][0], v[1][1][1]); w_.w = cvt_pk_bf16(v[1][1][2], v[1][1][3]); *(u32x4*)(WSH(WS_QKV + VC) + ((size_t)(b * 2 + kv) * 2048 + s) * 64 + d) = w_; }
                } else if constexpr (MODE == 2) {
#pragma unroll
                    for (int bj = 0; bj < 2; ++bj) { u32x4 w_; w_.x = cvt_pk_bf16(v[bj][0][0], v[bj][0][1]); w_.y = cvt_pk_bf16(v[bj][0][2], v[bj][0][3]); w_.z = cvt_pk_bf16(v[bj][1][0], v[bj][1][1]); w_.w = cvt_pk_bf16(v[bj][1][2], v[bj][1][3]); *(u32x4*)(((bf16_t*)(hs + MIX_CKV)) + (size_t)row * 256 + bj * HALF + c8) = w_; }
                    const float ss = qsum((dot4(v[0][0]) + dot4(v[0][1])) + (dot4(v[1][0]) + dot4(v[1][1])));
                    if (fq == 0) WSF(WS_SSQ + SSQ_KV)[(size_t)row * 4 + wc] = ss;
                } else if constexpr (MODE == 3 || MODE == 4) {
                    const int hc = 4 * (u.pn - (MODE == 3 ? 3 : 5)) + wc;
                    const float ss = qsum((dot4(v[0][0]) + dot4(v[0][1])) + (dot4(v[1][0]) + dot4(v[1][1])));
                    const float r = rsqrtf(ss * (1.0f / 64.0f) + EPS_RMS) * (MODE == 3 ? C2_64 : 1.0f);
                    bf16_t* dst = WSH(WS_QKV + (MODE == 3 ? QB : KB)) + ((size_t)(b * 4 + (hc >> 1)) * 2048 + s) * 128 + (hc & 1) * 64;
                    u32x2 ow[4];
#pragma unroll
                    for (int n = 0; n < 2; ++n) {
                        const f32x4 cs = tcur[2 * n], sn = tcur[2 * n + 1];
                        const f32x4 x1 = v[0][n] * gg[2 * n] * r, x2 = v[1][n] * gg[2 * n + 1] * r;
                        ow[2 * n] = pk4(x1 * cs - x2 * sn); ow[2 * n + 1] = pk4(x1 * sn + x2 * cs);
                    }
                    if (it + 1 < 8) tab_load(tcur, it + 1);
                    { u32x4 w0, w1; w0.x = ow[0].x; w0.y = ow[0].y; w0.z = ow[2].x; w0.w = ow[2].y; w1.x = ow[1].x; w1.y = ow[1].y; w1.z = ow[3].x; w1.w = ow[3].y;
                      *(u32x4*)(dst + 8 * fq) = w0; *(u32x4*)(dst + 32 + 8 * fq) = w1; }
                } else if constexpr (MODE == 5) {
#pragma unroll
                    for (int bj = 0; bj < 2; ++bj) { const int col = (u.pn - 7) * 256 + bj * HALF + c8;
                        { u32x4 w_; w_.x = cvt_pk_bf16(v[bj][0][0], v[bj][0][1]); w_.y = cvt_pk_bf16(v[bj][0][2], v[bj][0][3]); w_.z = cvt_pk_bf16(v[bj][1][0], v[bj][1][1]); w_.w = cvt_pk_bf16(v[bj][1][2], v[bj][1][3]); *(u32x4*)(WSH(WS_QKV + VB) + ((size_t)(b * 4 + (col >> 7)) * 2048 + s) * 128 + (col & 127)) = w_; } }
                } else if constexpr (MODE == 6) {
                    const int hd = (u.pn == 9) ? wc : (wc < 2 ? 4 + wc : wc - 2);
                    const float ss = qsum((dot4(v[0][0]) + dot4(v[0][1])) + (dot4(v[1][0]) + dot4(v[1][1])));
                    const float r = rsqrtf(ss * (1.0f / 64.0f) + EPS_RMS) * (isq ? C2_64 : 1.0f);
                    bf16_t* dst = isq ? WSH(WS_QKV + QC) + ((size_t)(b * 6 + hd) * 2048 + s) * 64 : WSH(WS_QKV + KC) + ((size_t)(b * 2 + hd) * 2048 + s) * 64;
                    const int f = 4 * fq;
                    u32x2 ow[4];
#pragma unroll
                    for (int bj = 0; bj < 2; ++bj) {
                        const f32x4 cs = tcur[2 * bj], sn = tcur[2 * bj + 1];
                        const f32x4 x1 = v[bj][0] * gg[2 * bj] * r, x2 = v[bj][1] * gg[2 * bj + 1] * r;
                        ow[2 * bj] = pk4(x1 * cs - x2 * sn); ow[2 * bj + 1] = pk4(x1 * sn + x2 * cs);
                    }
                    if (it + 1 < 8) tab_load(tcur, it + 1);
#pragma unroll
                    for (int bj = 0; bj < 2; ++bj) { *(u32x2*)(dst + 32 * bj + f) = ow[2 * bj]; *(u32x2*)(dst + 32 * bj + 16 + f) = ow[2 * bj + 1]; }
                } else {
                    if (wc == 0) {
                        { u32x4 w_; w_.x = cvt_pk_bf16(v[0][0][0], v[0][0][1]); w_.y = cvt_pk_bf16(v[0][0][2], v[0][0][3]); w_.z = cvt_pk_bf16(v[0][1][0], v[0][1][1]); w_.w = cvt_pk_bf16(v[0][1][2], v[0][1][3]); *(u32x4*)(((bf16_t*)(hs + MIX_KR)) + (size_t)row * 32 + 8 * fq) = w_; }
                        const float ss = qsum(dot4(v[0][0]) + dot4(v[0][1]));
                        if (fq == 0) WSF(WS_SSQ + SSQ_KR)[row] = ss;
                    }
                }
        }
    }
    __device__ __forceinline__ void operator()(const f32x4 (&acc)[2][2][4][2], const Unit& u, int wr, int wc, int fr, int fq) const {
        asm volatile("" : "+v"(fr), "+v"(fq));
        switch (u.pn) {
            case 0: body<0>(acc, u, wr, wc, fr, fq); break;
            case 1: body<1>(acc, u, wr, wc, fr, fq); break;
            case 2: body<2>(acc, u, wr, wc, fr, fq); break;
            case 3: case 4: body<3>(acc, u, wr, wc, fr, fq); break;
            case 5: case 6: body<4>(acc, u, wr, wc, fr, fq); break;
            case 7: case 8: body<5>(acc, u, wr, wc, fr, fq); break;
            case 9: case 10: body<6>(acc, u, wr, wc, fr, fq); break;
            default: body<7>(acc, u, wr, wc, fr, fq); break;
        }
    }
};

#define EPI_BAR() do { asm volatile("s_waitcnt lgkmcnt(0)" ::: "memory"); __builtin_amdgcn_s_barrier(); asm volatile("" ::: "memory"); } while (0)

struct EpiMlaQ {
    static constexpr bool PERM = false, AFTER_DRAIN = true;
    unsigned char* ws; int l;
    __device__ __forceinline__ void fused(f32x4 (&acc)[2][2][4][2], const Unit& u, int wr, int wc, int fr, int fq, PG8_LAS unsigned char* lds, int wid, int lane) const {
        asm volatile("" : "+v"(fr), "+v"(fq), "+v"(lane));
        PG8_LAS float* P = (PG8_LAS float*)lds;
        float rs[8];
        { f32x4 s0[8], s1[8];
#pragma unroll
          for (int it = 0; it < 8; ++it) { const int row = u.pm * BM + (it >> 2) * HALF + wr * 64 + (it & 3) * 16 + fr; s0[it] = *(const f32x4*)(WSF(WS_SSQ + SSQ_Q) + (size_t)row * 8); s1[it] = *(const f32x4*)(WSF(WS_SSQ + SSQ_Q) + (size_t)row * 8 + 4); }
#pragma unroll
          for (int it = 0; it < 8; ++it) rs[it] = rsqrtf((((s0[it][0] + s0[it][1]) + (s0[it][2] + s0[it][3])) + ((s1[it][0] + s1[it][1]) + (s1[it][2] + s1[it][3]))) * (1.0f / 384.0f) + EPS_RMS); }
        const float* gq = WSF(WS_TAB + TAB_GAIN) + l * GN_STRIDE + GN_MQ;
        f32x4 g0, g1, cs[4], sn[4];
        if (wc < 2) { g0 = *(const f32x4*)(gq + wc * 32 + 8 * fq); g1 = *(const f32x4*)(gq + wc * 32 + 8 * fq + 4); }
        else { g0 = *(const f32x4*)(gq + 64 + 4 * fq); g1 = *(const f32x4*)(gq + 80 + 4 * fq); }
#pragma unroll
        for (int it = 0; it < 8; ++it) {
            const int ai = it >> 2, m = it & 3, rl = ai * HALF + wr * 64 + m * 16 + fr;
#pragma unroll
            for (int bj = 0; bj < 2; ++bj) {
                acc[ai][bj][m][0] = acc[ai][bj][m][0] * rs[it]; acc[ai][bj][m][1] = acc[ai][bj][m][1] * rs[it];
                const float ss = qsum(dot4(acc[ai][bj][m][0]) + dot4(acc[ai][bj][m][1]));
                if (fq == 0) P[(rl * 2 + bj) * 4 + wc] = ss;
            }
        }
        EPI_BAR();
        bf16_t* qa = WSH(WS_QKV + QA);
        if (wc < 3) {
#pragma unroll
            for (int it = 0; it < 8; ++it) {
                const int ai = it >> 2, m = it & 3, rl = ai * HALF + wr * 64 + m * 16 + fr, row = u.pm * BM + rl, b = row >> 11, s = row & 2047;
                if (m == 0 && wc == 2) {
#pragma unroll
                    for (int q = 0; q < 4; ++q) { const int sq_ = (u.pm * BM + ai * HALF + wr * 64 + q * 16 + fr) & 2047;
                        cs[q] = *(const f32x4*)(WSF(WS_TAB + TAB_MLA_COS) + sq_ * 16 + 4 * fq); sn[q] = *(const f32x4*)(WSF(WS_TAB + TAB_MLA_SIN) + sq_ * 16 + 4 * fq); }
                }
#pragma unroll
                for (int bj = 0; bj < 2; ++bj) {
                    const f32x4 pp = *(const PG8_LAS f32x4*)(P + (rl * 2 + bj) * 4);
                    const float r = rsqrtf((pp[0] + pp[1] + pp[2]) * (1.0f / 96.0f) + EPS_RMS) * C2_MLA;
                    bf16_t* dst = qa + ((size_t)(b * 6 + 2 * u.pn + bj) * 2048 + s) * 96;
                    if (wc < 2) { const f32x4 y0 = acc[ai][bj][m][0] * g0 * r, y1 = acc[ai][bj][m][1] * g1 * r; u32x4 w_; w_.x = cvt_pk_bf16(y0[0], y0[1]); w_.y = cvt_pk_bf16(y0[2], y0[3]); w_.z = cvt_pk_bf16(y1[0], y1[1]); w_.w = cvt_pk_bf16(y1[2], y1[3]);
                        *(u32x4*)(dst + wc * 32 + 8 * fq) = w_; }
                    else { const f32x4 x1 = acc[ai][bj][m][0] * g0 * r, x2 = acc[ai][bj][m][1] * g1 * r;
                        st4(dst + 64 + 4 * fq, x1 * cs[m] - x2 * sn[m]); st4(dst + 80 + 4 * fq, x1 * sn[m] + x2 * cs[m]); }
                }
            }
        }
    }
};
struct EpiMlaKV {
    static constexpr bool PERM = false, AFTER_DRAIN = true;
    unsigned char* ws; unsigned char* hs; int l;
    __device__ __forceinline__ void fused(f32x4 (&acc)[2][2][4][2], const Unit& u, int wr, int wc, int fr, int fq, PG8_LAS unsigned char* lds, int wid, int lane) const {
        asm volatile("" : "+v"(fr), "+v"(fq), "+v"(lane));
        PG8_LAS float* P = (PG8_LAS float*)lds;
        float rs[8], skr[4];
        { f32x4 s0[8];
#pragma unroll
          for (int it = 0; it < 8; ++it) { const int row = u.pm * BM + (it >> 2) * HALF + wr * 64 + (it & 3) * 16 + fr; s0[it] = *(const f32x4*)(WSF(WS_SSQ + SSQ_KV) + (size_t)row * 4); }
#pragma unroll
          for (int it = 0; it < 8; ++it) rs[it] = rsqrtf(((s0[it][0] + s0[it][1]) + (s0[it][2] + s0[it][3])) * (1.0f / 256.0f) + EPS_RMS); }
        const float* gk = WSF(WS_TAB + TAB_GAIN) + l * GN_STRIDE + GN_MK;
        f32x4 g0, g1, gr0, gr1;
        g0 = *(const f32x4*)(gk + (wc & 1) * 32 + 8 * fq); g1 = *(const f32x4*)(gk + (wc & 1) * 32 + 8 * fq + 4);   gr0 = *(const f32x4*)(gk + 64 + 4 * fq); gr1 = *(const f32x4*)(gk + 80 + 4 * fq);
        f32x4 cs[4], sn[4]; u32x2 kr1[4], kr2[4];
#pragma unroll
        for (int it = 0; it < 8; ++it) {
            const int ai = it >> 2, m = it & 3, rl = ai * HALF + wr * 64 + m * 16 + fr;
#pragma unroll
            for (int bj = 0; bj < 2; ++bj) {
                acc[ai][bj][m][0] = acc[ai][bj][m][0] * rs[it]; acc[ai][bj][m][1] = acc[ai][bj][m][1] * rs[it];
                if (wc < 2) { const float ss = qsum(dot4(acc[ai][bj][m][0]) + dot4(acc[ai][bj][m][1])); if (fq == 0) P[(rl * 2 + bj) * 2 + wc] = ss; }
            }
        }
        EPI_BAR();
        bf16_t* ka = WSH(WS_QKV + KA); bf16_t* va = WSH(WS_QKV + VA);
#pragma unroll
        for (int it = 0; it < 8; ++it) {
            const int ai = it >> 2, m = it & 3, rl = ai * HALF + wr * 64 + m * 16 + fr, row = u.pm * BM + rl, b = row >> 11, s = row & 2047;
            if (m == 0 && wc < 2) {
#pragma unroll
                for (int q = 0; q < 4; ++q) { const int rq = u.pm * BM + ai * HALF + wr * 64 + q * 16 + fr, sq_ = rq & 2047;
                    cs[q] = *(const f32x4*)(WSF(WS_TAB + TAB_MLA_COS) + sq_ * 16 + 4 * fq); sn[q] = *(const f32x4*)(WSF(WS_TAB + TAB_MLA_SIN) + sq_ * 16 + 4 * fq);
                    kr1[q] = *(const u32x2*)(((bf16_t*)(hs + MIX_KR)) + (size_t)rq * 32 + 4 * fq); kr2[q] = *(const u32x2*)(((bf16_t*)(hs + MIX_KR)) + (size_t)rq * 32 + 16 + 4 * fq); skr[q] = WSF(WS_SSQ + SSQ_KR)[rq]; }
            }
#pragma unroll
            for (int bj = 0; bj < 2; ++bj) {
                const size_t hrow = (size_t)(b * 6 + 2 * u.pn + bj) * 2048 + s;
                if (wc < 2) {
                    const float r = rsqrtf((P[(rl * 2 + bj) * 2] + P[(rl * 2 + bj) * 2 + 1] + skr[m]) * (1.0f / 96.0f) + EPS_RMS);
                    bf16_t* dst = ka + hrow * 96;
                    { const f32x4 y0 = acc[ai][bj][m][0] * g0 * r, y1 = acc[ai][bj][m][1] * g1 * r; u32x4 w_; w_.x = cvt_pk_bf16(y0[0], y0[1]); w_.y = cvt_pk_bf16(y0[2], y0[3]); w_.z = cvt_pk_bf16(y1[0], y1[1]); w_.w = cvt_pk_bf16(y1[2], y1[3]);
                      *(u32x4*)(dst + wc * 32 + 8 * fq) = w_; }
                    if (wc == bj) {
                        const f32x4 x1 = bf4_to_f32(kr1[m]) * gr0 * r, x2 = bf4_to_f32(kr2[m]) * gr1 * r;
                        st4(dst + 64 + 4 * fq, x1 * cs[m] - x2 * sn[m]); st4(dst + 80 + 4 * fq, x1 * sn[m] + x2 * cs[m]);
                    }
                } else {
                    bf16_t* dst = va + hrow * 64;
                    { const f32x4 y0 = acc[ai][bj][m][0], y1 = acc[ai][bj][m][1]; u32x4 w_; w_.x = cvt_pk_bf16(y0[0], y0[1]); w_.y = cvt_pk_bf16(y0[2], y0[3]); w_.z = cvt_pk_bf16(y1[0], y1[1]); w_.w = cvt_pk_bf16(y1[2], y1[3]);
                      *(u32x4*)(dst + (wc - 2) * 32 + 8 * fq) = w_; }
                }
            }
        }
    }
};
struct EpiRes {
    static constexpr bool PERM = true, AFTER_DRAIN = true;
    float* out; unsigned char* ws; int final_;
    __device__ __forceinline__ void fused(f32x4 (&acc)[2][2][4][2], const Unit& u, int wr, int wc, int fr, int fq, PG8_LAS unsigned char* lds, int wid, int lane) const {
        asm volatile("" : "+v"(fr), "+v"(fq), "+v"(lane));
        PG8_LAS float* P = (PG8_LAS float*)lds;
        const int col0 = u.pn * BM + wc * 32 + 8 * fq;
#pragma unroll
        for (int ai = 0; ai < 2; ++ai) {
            u32x4 bs[4][2];
#pragma unroll
            for (int m = 0; m < 4; ++m) { const size_t off = (size_t)(u.pm * BM + ai * HALF + wr * 64 + m * 16 + fr) * 1024 + col0;
#pragma unroll
                for (int bj = 0; bj < 2; ++bj) bs[m][bj] = *(const u32x4*)(WSH(WS_XB) + off + bj * HALF); }
#pragma unroll
            for (int m = 0; m < 4; ++m) {
                const int rl = ai * HALF + wr * 64 + m * 16 + fr; const size_t off = (size_t)(u.pm * BM + rl) * 1024 + col0;
                float ss = 0.f;
#pragma unroll
                for (int bj = 0; bj < 2; ++bj) {
                    u32x2 lo; lo.x = bs[m][bj].x; lo.y = bs[m][bj].y; u32x2 hi2; hi2.x = bs[m][bj].z; hi2.y = bs[m][bj].w;
                    const f32x4 x0 = bf4_to_f32(lo) + acc[ai][bj][m][0], x1 = bf4_to_f32(hi2) + acc[ai][bj][m][1];
                    if (final_) { *(f32x4*)(out + off + bj * HALF) = x0; *(f32x4*)(out + off + bj * HALF + 4) = x1; }
                    else { u32x4 w; w.x = cvt_pk_bf16(x0[0], x0[1]); w.y = cvt_pk_bf16(x0[2], x0[3]); w.z = cvt_pk_bf16(x1[0], x1[1]); w.w = cvt_pk_bf16(x1[2], x1[3]); *(u32x4*)(WSH(WS_XB) + off + bj * HALF) = w; }
                    ss += dot4(x0) + dot4(x1); }
                ss = qsum(ss);
                if (fq == 0) P[rl * 4 + wc] = ss;
            }
            asm volatile("" ::: "memory");
        }
        EPI_BAR();
        const int t = wid * 64 + lane;
        if (t < 256 && !final_) { const f32x4 pp = *(const PG8_LAS f32x4*)(P + t * 4); WSF(WS_SSQ + SSQ_X)[(size_t)(u.pm * BM + t) * 4 + u.pn] = (pp[0] + pp[1]) + (pp[2] + pp[3]); }
    }
};
struct EpiSwiglu {
    static constexpr bool PERM = true, AFTER_DRAIN = false;
    unsigned char* ws;
    __device__ __forceinline__ void operator()(const f32x4 (&acc)[2][2][4][2], const Unit& u, int wr, int wc, int fr, int fq) const {
        asm volatile("" : "+v"(fr), "+v"(fq));
        const int col0 = u.pn * 128 + wc * 32 + 8 * fq;
        float rsv[8];
#pragma unroll
        for (int it = 0; it < 8; ++it) { const int row = u.pm * BM + (it >> 2) * HALF + wr * 64 + (it & 3) * 16 + fr;
            const f32x4 sq = *(const f32x4*)(WSF(WS_SSQ + SSQ_X) + (size_t)row * 4); rsv[it] = rsqrtf(((sq[0] + sq[1]) + (sq[2] + sq[3])) * (1.0f / 1024.0f) + EPS_RMS); }
#pragma unroll
        for (int ai = 0; ai < 2; ++ai)
#pragma unroll
            for (int m = 0; m < 4; ++m) {
                const int row = u.pm * BM + ai * HALF + wr * 64 + m * 16 + fr;
                const float rs = rsv[ai * 4 + m];
                u32x4 w; unsigned wv[4];
#pragma unroll
                for (int n = 0; n < 2; ++n) { const f32x4 g = acc[ai][0][m][n] * rs, up = acc[ai][1][m][n] * rs; f32x4 a;
#pragma unroll
                    for (int i = 0; i < 4; ++i) a[i] = g[i] * __builtin_amdgcn_rcpf(1.0f + __builtin_amdgcn_exp2f(-LOG2E * g[i])) * up[i];
                    wv[2 * n] = cvt_pk_bf16(a[0], a[1]); wv[2 * n + 1] = cvt_pk_bf16(a[2], a[3]); }
                w.x = wv[0]; w.y = wv[1]; w.z = wv[2]; w.w = wv[3];
                *(u32x4*)(WSH(WS_QKV) + (size_t)row * 2816 + col0) = w;
            }
    }
};
template <class Epi, class Sched, bool ALIGN_EPI = false, bool SP2 = false>
__device__ __forceinline__ void gemm_phase(PG8_LAS unsigned char* lds, const Gemm g, const Sched& S, const Epi& E) {
    int tid_ = threadIdx.x; asm volatile("" : "+v"(tid_));
    const int tid = tid_, wid = __builtin_amdgcn_readfirstlane(tid >> 6), lane = tid & 63, wr = wid >> 2, wc = wid & 3, fr = lane & 15, fq = lane >> 4;
    const int K = g.K, nt = K / BK;
    unsigned voffA[2], voffB[2];
#pragma unroll
    for (int i = 0; i < 2; ++i) { int R, C; stage_rc(tid * 16 + i * 8192, R, C); const int Rb = Epi::PERM ? ((R & ~31) + perm32(R & 31)) : R;
        voffA[i] = (unsigned)(R * K + C) * 2u; voffB[i] = (unsigned)(Rb * K + C) * 2u; }
    const size_t kstep = (size_t)(BK * 2);
    const size_t hstep = (size_t)HALF * K * 2;
    const size_t tstep = 2 * hstep;
    const unsigned ldsw = (unsigned)wid * 1024u;
    const int aoff = lds_byte(wr * 64 + fr, fq * 8), boff = lds_byte(wc * 32 + fr, fq * 8);
#define PG8_SA(b, h) (((b) * 2 + (h)) * HTB)
#define PG8_SB(b, h) ((4 + (b) * 2 + (h)) * HTB)
#define PG8_STAGE(bufoff, gbase, voff) do { _Pragma("unroll") for (int _i = 0; _i < 2; ++_i) \
        __builtin_amdgcn_global_load_lds((const unsigned*)((const char*)(gbase) + (voff)[_i]), (PG8_LAS unsigned*)(lds + (bufoff) + ldsw + _i * 8192), 16, 0, 0); } while (0)
#define PG8_LDA(dst, b, h) do { _Pragma("unroll") for (int m = 0; m < 4; ++m) _Pragma("unroll") for (int k = 0; k < 2; ++k) dst[m][k] = *(const PG8_LAS bf16x8*)(lds + PG8_SA(b, h) + aoff + m * 2048 + k * 1024); } while (0)
#define PG8_LDB(dst, b, h) do { _Pragma("unroll") for (int n = 0; n < 2; ++n) _Pragma("unroll") for (int k = 0; k < 2; ++k) dst[n][k] = *(const PG8_LAS bf16x8*)(lds + PG8_SB(b, h) + boff + n * 2048 + k * 1024); } while (0)
#define PG8_MMA(ai, bj, At, Bt) do { __builtin_amdgcn_s_setprio(1); _Pragma("unroll") for (int m = 0; m < 4; ++m) _Pragma("unroll") for (int n = 0; n < 2; ++n) _Pragma("unroll") for (int k = 0; k < 2; ++k) \
        acc[ai][bj][m][n] = __builtin_amdgcn_mfma_f32_16x16x32_bf16(Bt[n][k], At[m][k], acc[ai][bj][m][n], 0, 0, 0); __builtin_amdgcn_s_setprio(0); } while (0)
#define PG8_WAIT_V(n) asm volatile("s_waitcnt vmcnt(" #n ")" ::: "memory")
#define PG8_WAIT_L(n) asm volatile("s_waitcnt lgkmcnt(" #n ")" ::: "memory")
#define PG8_BAR __builtin_amdgcn_s_barrier()
#define PG8_SCHED __builtin_amdgcn_sched_barrier(0)
    Unit cur, nxt; int ui = 0;
    if (!S.next(0, cur)) return;
    f32x4 acc[2][2][4][2];
#pragma unroll
    for (int a = 0; a < 2; ++a)
#pragma unroll
        for (int b = 0; b < 2; ++b)
#pragma unroll
            for (int m = 0; m < 4; ++m)
#pragma unroll
                for (int n = 0; n < 2; ++n) acc[a][b][m][n] = (f32x4){0.f, 0.f, 0.f, 0.f};
    bf16x8 At[4][2], B0[2][2], B1[2][2];
    const char* cA = (const char*)g.A + (size_t)cur.pm * tstep; const char* cB = (const char*)g.Bt + (size_t)cur.pn * tstep;
    S.a_ready(cur);
    if constexpr (SP2) {
        PG8_STAGE(PG8_SB(0, 0), cB, voffB); PG8_STAGE(PG8_SB(0, 1), cB + hstep, voffB); PG8_STAGE(PG8_SA(0, 0), cA, voffA); PG8_STAGE(PG8_SA(0, 1), cA + hstep, voffA);
        if (wr == 1) PG8_BAR;
        PG8_WAIT_V(2); PG8_BAR;
        PG8_STAGE(PG8_SB(1, 0), cB + kstep, voffB); PG8_STAGE(PG8_SA(1, 0), cA + kstep, voffA); PG8_STAGE(PG8_SB(1, 1), cB + hstep + kstep, voffB);
        PG8_WAIT_V(6); PG8_BAR;
    } else {
        PG8_STAGE(PG8_SB(0, 0), cB, voffB); PG8_STAGE(PG8_SA(0, 0), cA, voffA); PG8_STAGE(PG8_SB(0, 1), cB + hstep, voffB); PG8_STAGE(PG8_SA(0, 1), cA + hstep, voffA);
        if (wr == 1) PG8_BAR;
        PG8_WAIT_V(4); PG8_BAR;
        PG8_STAGE(PG8_SB(1, 0), cB + kstep, voffB); PG8_STAGE(PG8_SA(1, 0), cA + kstep, voffA); PG8_STAGE(PG8_SB(1, 1), cB + hstep + kstep, voffB);
        PG8_WAIT_V(6); PG8_BAR;
    }
    for (;;) {
        const bool has_next = S.next(ui + 1, nxt);
        const char* nA = has_next ? (const char*)g.A + (size_t)nxt.pm * tstep : cA; const char* nB = has_next ? (const char*)g.Bt + (size_t)nxt.pn * tstep : cB;
        for (int t = 0; t < nt; t += 2) {
            const bool last = (t == nt - 2);
            const char* a1 = cA + (size_t)(t + 1) * kstep;
            const char* a2 = last ? nA : cA + (size_t)(t + 2) * kstep; const char* b2 = last ? nB : cB + (size_t)(t + 2) * kstep;
            const char* a3 = a2 + kstep; const char* b3 = b2 + kstep;
            if (last && has_next) S.a_ready(nxt);
            if constexpr (SP2) {
            PG8_LDB(B0, 0, 0); PG8_LDB(B1, 0, 1); PG8_SCHED; PG8_LDA(At, 0, 0); PG8_STAGE(PG8_SA(1, 1), a1 + hstep, voffA);
            PG8_WAIT_V(8); PG8_WAIT_L(0); PG8_BAR; PG8_MMA(0, 0, At, B0); PG8_MMA(0, 1, At, B1); PG8_BAR; PG8_SCHED;
            PG8_LDA(At, 0, 1); PG8_STAGE(PG8_SB(0, 0), b2, voffB); PG8_STAGE(PG8_SB(0, 1), b2 + hstep, voffB); PG8_STAGE(PG8_SA(0, 0), a2, voffA);
            PG8_WAIT_V(8); PG8_WAIT_L(0); PG8_BAR; PG8_MMA(1, 0, At, B0); PG8_MMA(1, 1, At, B1); PG8_BAR; PG8_SCHED;
            PG8_LDB(B0, 1, 0); PG8_LDB(B1, 1, 1); PG8_SCHED; PG8_LDA(At, 1, 0); PG8_STAGE(PG8_SA(0, 1), a2 + hstep, voffA);
            PG8_WAIT_V(8); PG8_WAIT_L(0); PG8_BAR; PG8_MMA(0, 0, At, B0); PG8_MMA(0, 1, At, B1); PG8_BAR; PG8_SCHED;
            PG8_LDA(At, 1, 1); PG8_STAGE(PG8_SB(1, 0), b3, voffB); PG8_STAGE(PG8_SB(1, 1), b3 + hstep, voffB); PG8_STAGE(PG8_SA(1, 0), a3, voffA);
            PG8_WAIT_V(8); PG8_WAIT_L(0); PG8_BAR; PG8_MMA(1, 0, At, B0); PG8_MMA(1, 1, At, B1); PG8_BAR; PG8_SCHED;
            } else {
            PG8_LDB(B0, 0, 0); PG8_SCHED; PG8_LDA(At, 0, 0); PG8_STAGE(PG8_SA(1, 1), a1 + hstep, voffA);
            PG8_WAIT_L(8); PG8_BAR; PG8_WAIT_L(0); PG8_MMA(0, 0, At, B0); PG8_BAR; PG8_SCHED;
            PG8_LDB(B1, 0, 1); PG8_STAGE(PG8_SB(0, 0), b2, voffB);
            PG8_BAR; PG8_WAIT_L(0); PG8_MMA(0, 1, At, B1); PG8_BAR;
            PG8_LDA(At, 0, 1); PG8_STAGE(PG8_SA(0, 0), a2, voffA);
            PG8_BAR; PG8_WAIT_L(0); PG8_MMA(1, 0, At, B0); PG8_BAR; PG8_SCHED;
            PG8_STAGE(PG8_SB(0, 1), b2 + hstep, voffB);
            PG8_WAIT_V(6); PG8_BAR; PG8_MMA(1, 1, At, B1); PG8_BAR;
            PG8_LDB(B0, 1, 0); PG8_SCHED; PG8_LDA(At, 1, 0); PG8_STAGE(PG8_SA(0, 1), a2 + hstep, voffA);
            PG8_WAIT_L(8); PG8_BAR; PG8_WAIT_L(0); PG8_MMA(0, 0, At, B0); PG8_BAR; PG8_SCHED;
            PG8_LDB(B1, 1, 1); PG8_STAGE(PG8_SB(1, 0), b3, voffB);
            PG8_BAR; PG8_WAIT_L(0); PG8_MMA(0, 1, At, B1); PG8_BAR;
            PG8_LDA(At, 1, 1); PG8_STAGE(PG8_SA(1, 0), a3, voffA);
            PG8_BAR; PG8_WAIT_L(0); PG8_MMA(1, 0, At, B0); PG8_BAR; PG8_SCHED;
            PG8_STAGE(PG8_SB(1, 1), b3 + hstep, voffB);
            PG8_WAIT_V(6); PG8_BAR; PG8_MMA(1, 1, At, B1); PG8_BAR;
            }
        }
        if constexpr (ALIGN_EPI) { if (wr == 0) PG8_BAR; }
        if constexpr (!Epi::AFTER_DRAIN) { E(acc, cur, wr, wc, fr, fq); S.done(cur); }
        if (!has_next) break;
#pragma unroll
        for (int a = 0; a < 2; ++a)
#pragma unroll
            for (int b = 0; b < 2; ++b)
#pragma unroll
                for (int m = 0; m < 4; ++m)
#pragma unroll
                    for (int n = 0; n < 2; ++n) acc[a][b][m][n] = (f32x4){0.f, 0.f, 0.f, 0.f};
        cur = nxt; cA = nA; cB = nB; ++ui;
        if constexpr (ALIGN_EPI) { if (wr == 1) PG8_BAR; }
    }
    PG8_WAIT_V(0);
    if constexpr (!ALIGN_EPI) { if (wr == 0) PG8_BAR; }
    PG8_BAR;
    if constexpr (Epi::AFTER_DRAIN) { E.fused(acc, cur, wr, wc, fr, fq, lds, wid, lane); S.done(cur); }
#undef PG8_SA
#undef PG8_SB
#undef PG8_STAGE
#undef PG8_LDA
#undef PG8_LDB
#undef PG8_MMA
#undef PG8_WAIT_V
#undef PG8_WAIT_L
#undef PG8_BAR
#undef PG8_SCHED
}
}
namespace att {
#ifndef ATT_DIAG
#define ATT_DIAG 0
#endif
#if ATT_DIAG
__device__ __forceinline__ unsigned long long diag_now() { unsigned long long t; asm volatile("s_memtime %0\n\ts_waitcnt lgkmcnt(0)" : "=s"(t) :: "memory"); return t; }
#define ATT_T(x) const unsigned long long x = diag_now()
#define ATT_ACC(i, a, b) dacc[i] += (b) - (a)
#else
#define ATT_T(x)
#define ATT_ACC(i, a, b)
#endif
typedef unsigned short bf16_t;
using bf16x8 = __attribute__((ext_vector_type(8))) short;
using s16x4 = __attribute__((ext_vector_type(4))) short;
using f32x16 = __attribute__((ext_vector_type(16))) float;
using u32x4 = __attribute__((ext_vector_type(4))) unsigned;
#ifndef ATT_RSV
#define ATT_RSV 1
#endif
#define ATT_SBAR() __builtin_amdgcn_sched_barrier(0)
__device__ __forceinline__ int crow(int r, int hi) { return (r & 3) + 8 * (r >> 2) + 4 * hi; }
__device__ __forceinline__ unsigned cvtpk(float lo, float hi) { unsigned r; asm volatile("v_cvt_pk_bf16_f32 %0, %1, %2" : "=v"(r) : "v"(lo), "v"(hi)); return r; }
__device__ __forceinline__ void glds16(const void* gsrc, unsigned lds_dst) { unsigned keep;
    asm volatile("s_mov_b32 %0, m0\n\ts_mov_b32 m0, %2\n\ts_nop 0\n\tglobal_load_lds_dwordx4 %1, off\n\ts_mov_b32 m0, %0" : "=&s"(keep) : "v"(gsrc), "s"(lds_dst) : "memory"); }
template <int NB> __device__ __forceinline__ int v_st(int k, int c) { const int kk = k; return ((kk >> 3) * NB + (c >> 5)) * 512 + ((kk & 7) * 32 + (c & 31)) * 2; }
__device__ __forceinline__ int v_rd_base(int lane) { return ((lane & 3) << 3) | (((lane >> 2) & 3) << 6) | (((lane >> 4) & 1) << 5) | (((lane >> 5) & 1) << 8); }
template <int OFF> __device__ __forceinline__ s16x4 tr_read(int vb) { s16x4 r; asm volatile("ds_read_b64_tr_b16 %0, %1 offset:%2" : "=&v"(r) : "v"(vb), "i"(OFF) : "memory"); return r; }
template <int I> __device__ __forceinline__ void exp1(f32x16& p0, f32x16& p1) { if constexpr (I < 16) p0[I] = __builtin_amdgcn_exp2f(p0[I]); else p1[I - 16] = __builtin_amdgcn_exp2f(p1[I - 16]); }
template <int NB, int C> __device__ __forceinline__ void exp_chunk(f32x16& p0, f32x16& p1) {
    constexpr int N = 32 / (4 * NB);
    exp1<C * N>(p0, p1); exp1<C * N + 1>(p0, p1);
    if constexpr (N == 4) { exp1<C * N + 2>(p0, p1); exp1<C * N + 3>(p0, p1); }
}
template <int I> __device__ __forceinline__ void exp3(f32x16& p0, f32x16& p1) { exp1<I>(p0, p1); exp1<I + 1>(p0, p1); exp1<I + 2>(p0, p1); }
template <int I> __device__ __forceinline__ void exp4(f32x16& p0, f32x16& p1) { exp1<I>(p0, p1); exp1<I + 1>(p0, p1); exp1<I + 2>(p0, p1); exp1<I + 3>(p0, p1); }
struct VF { s16x4 l0, h0, l1, h1, l2, h2, l3, h3; };
template <int NB, int D0> __device__ __forceinline__ void v_read(VF& f, int vb) {
    f.l0 = tr_read<(0 * NB + D0) * 512>(vb); f.h0 = tr_read<(1 * NB + D0) * 512>(vb); f.l1 = tr_read<(2 * NB + D0) * 512>(vb); f.h1 = tr_read<(3 * NB + D0) * 512>(vb);
    f.l2 = tr_read<(4 * NB + D0) * 512>(vb); f.h2 = tr_read<(5 * NB + D0) * 512>(vb); f.l3 = tr_read<(6 * NB + D0) * 512>(vb); f.h3 = tr_read<(7 * NB + D0) * 512>(vb);
}
#define ATT_PIN2(a, b) asm volatile("" : "+v"(a), "+v"(b))
template <int NB, int D0, bool EXP, int PROBE = 0> __device__ __forceinline__ void pv_mm(f32x16& od, f32x16& lacc, const VF& f, bf16x8 pa0, bf16x8 pa1, bf16x8 pa2, bf16x8 pa3, f32x16& p0, f32x16& p1) {
    const bf16x8 ones = {16256, 16256, 16256, 16256, 16256, 16256, 16256, 16256};
#define ATT_PK(L, H) (bf16x8){L[0], L[1], L[2], L[3], H[0], H[1], H[2], H[3]}
    if constexpr (PROBE != 3) od = __builtin_amdgcn_mfma_f32_32x32x16_bf16(pa0, ATT_PK(f.l0, f.h0), od, 0, 0, 0); if constexpr (D0 == 0 && !ATT_RSV) lacc = __builtin_amdgcn_mfma_f32_32x32x16_bf16(pa0, ones, lacc, 0, 0, 0); if constexpr (EXP) { if constexpr (PROBE != 2) exp_chunk<NB, D0 * 4 + 0>(p0, p1); ATT_PIN2(p0, p1); ATT_SBAR(); }
    if constexpr (PROBE != 3) od = __builtin_amdgcn_mfma_f32_32x32x16_bf16(pa1, ATT_PK(f.l1, f.h1), od, 0, 0, 0); if constexpr (D0 == 0 && !ATT_RSV) lacc = __builtin_amdgcn_mfma_f32_32x32x16_bf16(pa1, ones, lacc, 0, 0, 0); if constexpr (EXP) { if constexpr (PROBE != 2) exp_chunk<NB, D0 * 4 + 1>(p0, p1); ATT_PIN2(p0, p1); ATT_SBAR(); }
    if constexpr (PROBE != 3) od = __builtin_amdgcn_mfma_f32_32x32x16_bf16(pa2, ATT_PK(f.l2, f.h2), od, 0, 0, 0); if constexpr (D0 == 0 && !ATT_RSV) lacc = __builtin_amdgcn_mfma_f32_32x32x16_bf16(pa2, ones, lacc, 0, 0, 0); if constexpr (EXP) { if constexpr (PROBE != 2) exp_chunk<NB, D0 * 4 + 2>(p0, p1); ATT_PIN2(p0, p1); ATT_SBAR(); }
    if constexpr (PROBE != 3) od = __builtin_amdgcn_mfma_f32_32x32x16_bf16(pa3, ATT_PK(f.l3, f.h3), od, 0, 0, 0); if constexpr (D0 == 0 && !ATT_RSV) lacc = __builtin_amdgcn_mfma_f32_32x32x16_bf16(pa3, ones, lacc, 0, 0, 0); if constexpr (EXP) { if constexpr (PROBE != 2) exp_chunk<NB, D0 * 4 + 3>(p0, p1); ATT_PIN2(p0, p1); ATT_SBAR(); }
#undef ATT_PK
}
#define ATT_LGKM(n) do { asm volatile("s_waitcnt lgkmcnt(" #n ")" ::: "memory"); ATT_SBAR(); } while (0)
#ifndef ATT_NEWK
#define ATT_NEWK 1
#endif
#ifndef ATT_XSPLIT
#define ATT_XSPLIT 1
#endif
#ifndef ATT_DLATE
#define ATT_DLATE 1
#endif
#ifndef ATT_GQA2
#define ATT_GQA2 1
#endif
#ifndef ATT_ALT4
#define ATT_ALT4 1
#endif
#ifndef ATT_ALT
#define ATT_ALT 1
#endif
template <bool EXP> __device__ __forceinline__ void pv_alt(f32x16* o, int vb, bf16x8 pa0, bf16x8 pa1, bf16x8 pa2, bf16x8 pa3, f32x16& p0, f32x16& p1) {
    ATT_SBAR();
    const s16x4 a0l = tr_read<0 * 512>(vb), a0h = tr_read<2 * 512>(vb), b0l = tr_read<1 * 512>(vb), b0h = tr_read<3 * 512>(vb);
    const s16x4 a1l = tr_read<4 * 512>(vb), a1h = tr_read<6 * 512>(vb), b1l = tr_read<5 * 512>(vb), b1h = tr_read<7 * 512>(vb);
    const s16x4 a2l = tr_read<8 * 512>(vb), a2h = tr_read<10 * 512>(vb), b2l = tr_read<9 * 512>(vb), b2h = tr_read<11 * 512>(vb);
    const s16x4 a3l = tr_read<12 * 512>(vb), a3h = tr_read<14 * 512>(vb), b3l = tr_read<13 * 512>(vb), b3h = tr_read<15 * 512>(vb);
#define ATT_PK(L, H) (bf16x8){L[0], L[1], L[2], L[3], H[0], H[1], H[2], H[3]}
#define ATT_ALT2(PA, AL, AH, BL, BH, C) do { \
    o[0] = __builtin_amdgcn_mfma_f32_32x32x16_bf16(PA, ATT_PK(AL, AH), o[0], 0, 0, 0); if constexpr (EXP) { exp_chunk<2, C>(p0, p1); ATT_PIN2(p0, p1); ATT_SBAR(); } \
    o[1] = __builtin_amdgcn_mfma_f32_32x32x16_bf16(PA, ATT_PK(BL, BH), o[1], 0, 0, 0); if constexpr (EXP) { exp_chunk<2, C + 1>(p0, p1); ATT_PIN2(p0, p1); ATT_SBAR(); } } while (0)
    ATT_LGKM(12); ATT_ALT2(pa0, a0l, a0h, b0l, b0h, 0);
    ATT_LGKM(8);  ATT_ALT2(pa1, a1l, a1h, b1l, b1h, 2);
    ATT_LGKM(4);  ATT_ALT2(pa2, a2l, a2h, b2l, b2h, 4);
    ATT_LGKM(0);  ATT_ALT2(pa3, a3l, a3h, b3l, b3h, 6);
#undef ATT_ALT2
#undef ATT_PK
}
template <int OFF> __device__ __forceinline__ bf16x8 kr_read(int ka) { bf16x8 r; asm volatile("ds_read_b128 %0, %1 offset:%2" : "=&v"(r) : "v"(ka), "i"(OFF) : "memory"); return r; }
template <int KP, int G> __device__ __forceinline__ void k_read_grp(bf16x8* kf, int ka) {
    kf[4 * G] = kr_read<64 * G>(ka); kf[4 * G + 1] = kr_read<32 * KP + 64 * G>(ka); kf[4 * G + 2] = kr_read<64 * G + 32>(ka); kf[4 * G + 3] = kr_read<32 * KP + 64 * G + 32>(ka);
}
template <int NQ> __device__ __forceinline__ void k_pin(bf16x8* kf) {
    asm volatile("" : "+v"(kf[0]), "+v"(kf[1]), "+v"(kf[2]), "+v"(kf[3]), "+v"(kf[4]), "+v"(kf[5]), "+v"(kf[6]), "+v"(kf[7]));
    if constexpr (NQ == 6) asm volatile("" : "+v"(kf[8]), "+v"(kf[9]), "+v"(kf[10]), "+v"(kf[11]));
}
template <bool EXP, int KP, int NKG, bool XS = false> __device__ __forceinline__ void pv_alt_k(f32x16* o, int vb, bf16x8 pa0, bf16x8 pa1, bf16x8 pa2, bf16x8 pa3, f32x16& p0, f32x16& p1, bf16x8* kf, int ka) {
    ATT_SBAR();
    const s16x4 a0l = tr_read<0 * 512>(vb), a0h = tr_read<2 * 512>(vb), b0l = tr_read<1 * 512>(vb), b0h = tr_read<3 * 512>(vb);
    const s16x4 a1l = tr_read<4 * 512>(vb), a1h = tr_read<6 * 512>(vb), b1l = tr_read<5 * 512>(vb), b1h = tr_read<7 * 512>(vb);
    const s16x4 a2l = tr_read<8 * 512>(vb), a2h = tr_read<10 * 512>(vb), b2l = tr_read<9 * 512>(vb), b2h = tr_read<11 * 512>(vb);
    const s16x4 a3l = tr_read<12 * 512>(vb), a3h = tr_read<14 * 512>(vb), b3l = tr_read<13 * 512>(vb), b3h = tr_read<15 * 512>(vb);
#define ATT_PK(L, H) (bf16x8){L[0], L[1], L[2], L[3], H[0], H[1], H[2], H[3]}
#define ATT_ALT2(PA, AL, AH, BL, BH, C) do { \
    o[0] = __builtin_amdgcn_mfma_f32_32x32x16_bf16(PA, ATT_PK(AL, AH), o[0], 0, 0, 0); if constexpr (EXP) { if constexpr (XS) exp3<3 * (C)>(p0, p1); else exp_chunk<2, C>(p0, p1); ATT_PIN2(p0, p1); ATT_SBAR(); } \
    o[1] = __builtin_amdgcn_mfma_f32_32x32x16_bf16(PA, ATT_PK(BL, BH), o[1], 0, 0, 0); if constexpr (EXP) { if constexpr (XS) exp3<3 * (C) + 3>(p0, p1); else exp_chunk<2, C + 1>(p0, p1); ATT_PIN2(p0, p1); ATT_SBAR(); } } while (0)
    ATT_LGKM(12); ATT_ALT2(pa0, a0l, a0h, b0l, b0h, 0); if constexpr (NKG > 0) { ATT_SBAR(); k_read_grp<KP, 0>(kf, ka); ATT_SBAR(); }
    if constexpr (NKG == 0) ATT_LGKM(8); else ATT_LGKM(12);
    ATT_ALT2(pa1, a1l, a1h, b1l, b1h, 2); if constexpr (NKG > 1) { ATT_SBAR(); k_read_grp<KP, 1>(kf, ka); ATT_SBAR(); }
    if constexpr (NKG == 0) ATT_LGKM(4); else ATT_LGKM(12);
    ATT_ALT2(pa2, a2l, a2h, b2l, b2h, 4); if constexpr (NKG > 2) { ATT_SBAR(); k_read_grp<KP, 2>(kf, ka); ATT_SBAR(); }
    if constexpr (NKG == 0) ATT_LGKM(0); else if constexpr (NKG == 2) ATT_LGKM(8); else ATT_LGKM(12);
    ATT_ALT2(pa3, a3l, a3h, b3l, b3h, 6);
#undef ATT_ALT2
#undef ATT_PK
}
template <bool EXP> __device__ __forceinline__ void pv_alt4(f32x16* o, int vb, bf16x8 pa0, bf16x8 pa1, bf16x8 pa2, bf16x8 pa3, f32x16& p0, f32x16& p1) {
    ATT_SBAR();
#define ATT_RD(I, D, L, H) const s16x4 L = tr_read<((2 * I) * 4 + D) * 512>(vb), H = tr_read<((2 * I + 1) * 4 + D) * 512>(vb)
    ATT_RD(0, 0, a0l, a0h); ATT_RD(0, 1, b0l, b0h); ATT_RD(1, 0, a1l, a1h); ATT_RD(1, 1, b1l, b1h); ATT_RD(2, 0, a2l, a2h); ATT_RD(2, 1, b2l, b2h); ATT_RD(3, 0, a3l, a3h); ATT_RD(3, 1, b3l, b3h);
#define ATT_PK(L, H) (bf16x8){L[0], L[1], L[2], L[3], H[0], H[1], H[2], H[3]}
#define ATT_ALT2(OA, OB, PA, AL, AH, BL, BH, C) do { \
    OA = __builtin_amdgcn_mfma_f32_32x32x16_bf16(PA, ATT_PK(AL, AH), OA, 0, 0, 0); if constexpr (EXP) { exp_chunk<4, C>(p0, p1); ATT_PIN2(p0, p1); ATT_SBAR(); } \
    OB = __builtin_amdgcn_mfma_f32_32x32x16_bf16(PA, ATT_PK(BL, BH), OB, 0, 0, 0); if constexpr (EXP) { exp_chunk<4, C + 1>(p0, p1); ATT_PIN2(p0, p1); ATT_SBAR(); } } while (0)
    ATT_LGKM(12); ATT_ALT2(o[0], o[1], pa0, a0l, a0h, b0l, b0h, 0); ATT_SBAR(); ATT_RD(0, 2, c0l, c0h); ATT_RD(0, 3, d0l, d0h);
    ATT_LGKM(12); ATT_ALT2(o[0], o[1], pa1, a1l, a1h, b1l, b1h, 2); ATT_SBAR(); ATT_RD(1, 2, c1l, c1h); ATT_RD(1, 3, d1l, d1h);
    ATT_LGKM(12); ATT_ALT2(o[0], o[1], pa2, a2l, a2h, b2l, b2h, 4); ATT_SBAR(); ATT_RD(2, 2, c2l, c2h); ATT_RD(2, 3, d2l, d2h);
    ATT_LGKM(12); ATT_ALT2(o[0], o[1], pa3, a3l, a3h, b3l, b3h, 6); ATT_SBAR(); ATT_RD(3, 2, c3l, c3h); ATT_RD(3, 3, d3l, d3h);
    ATT_LGKM(12); ATT_ALT2(o[2], o[3], pa0, c0l, c0h, d0l, d0h, 8);
    ATT_LGKM(8);  ATT_ALT2(o[2], o[3], pa1, c1l, c1h, d1l, d1h, 10);
    ATT_LGKM(4);  ATT_ALT2(o[2], o[3], pa2, c2l, c2h, d2l, d2h, 12);
    ATT_LGKM(0);  ATT_ALT2(o[2], o[3], pa3, c3l, c3h, d3l, d3h, 14);
#undef ATT_ALT2
#undef ATT_PK
#undef ATT_RD
}
template <bool EXP, class F> __device__ __forceinline__ void pv_alt4_d(f32x16* o, int vb, bf16x8 pa0, bf16x8 pa1, bf16x8 pa2, bf16x8 pa3, f32x16& p0, f32x16& p1, const F& dma) {
    ATT_SBAR();
#define ATT_RD(I, D, L, H) const s16x4 L = tr_read<((2 * I) * 4 + D) * 512>(vb), H = tr_read<((2 * I + 1) * 4 + D) * 512>(vb)
    ATT_RD(0, 0, a0l, a0h); ATT_RD(0, 1, b0l, b0h); ATT_RD(1, 0, a1l, a1h); ATT_RD(1, 1, b1l, b1h); ATT_RD(2, 0, a2l, a2h); ATT_RD(2, 1, b2l, b2h); ATT_RD(3, 0, a3l, a3h); ATT_RD(3, 1, b3l, b3h);
#define ATT_PK(L, H) (bf16x8){L[0], L[1], L[2], L[3], H[0], H[1], H[2], H[3]}
#define ATT_ALT2(OA, OB, PA, AL, AH, BL, BH, C) do { \
    OA = __builtin_amdgcn_mfma_f32_32x32x16_bf16(PA, ATT_PK(AL, AH), OA, 0, 0, 0); if constexpr (EXP) { exp_chunk<4, C>(p0, p1); ATT_PIN2(p0, p1); ATT_SBAR(); } \
    OB = __builtin_amdgcn_mfma_f32_32x32x16_bf16(PA, ATT_PK(BL, BH), OB, 0, 0, 0); if constexpr (EXP) { exp_chunk<4, C + 1>(p0, p1); ATT_PIN2(p0, p1); ATT_SBAR(); } } while (0)
    ATT_LGKM(12); ATT_ALT2(o[0], o[1], pa0, a0l, a0h, b0l, b0h, 0); ATT_SBAR(); ATT_RD(0, 2, c0l, c0h); ATT_RD(0, 3, d0l, d0h);
    ATT_LGKM(12); ATT_ALT2(o[0], o[1], pa1, a1l, a1h, b1l, b1h, 2); ATT_SBAR(); ATT_RD(1, 2, c1l, c1h); ATT_RD(1, 3, d1l, d1h);
    ATT_LGKM(12); ATT_ALT2(o[0], o[1], pa2, a2l, a2h, b2l, b2h, 4); ATT_SBAR(); ATT_RD(2, 2, c2l, c2h); ATT_RD(2, 3, d2l, d2h);
    ATT_LGKM(12); ATT_ALT2(o[0], o[1], pa3, a3l, a3h, b3l, b3h, 6); ATT_SBAR(); ATT_RD(3, 2, c3l, c3h); ATT_RD(3, 3, d3l, d3h);
    ATT_LGKM(12); ATT_ALT2(o[2], o[3], pa0, c0l, c0h, d0l, d0h, 8);  dma(0); dma(1); ATT_SBAR();
    ATT_LGKM(8);  ATT_ALT2(o[2], o[3], pa1, c1l, c1h, d1l, d1h, 10); dma(2); dma(3); ATT_SBAR();
    ATT_LGKM(4);  ATT_ALT2(o[2], o[3], pa2, c2l, c2h, d2l, d2h, 12); dma(4); ATT_SBAR();
    ATT_LGKM(0);  ATT_ALT2(o[2], o[3], pa3, c3l, c3h, d3l, d3h, 14);
#undef ATT_ALT2
#undef ATT_PK
#undef ATT_RD
}
template <int NB, bool EXP, int PROBE = 0, bool PRE = false> __device__ __forceinline__ void pv_all(f32x16* o, f32x16& lacc, int vb, bf16x8 pa0, bf16x8 pa1, bf16x8 pa2, bf16x8 pa3, f32x16& p0, f32x16& p1, VF& fa, VF& fb) {
    if constexpr (!PRE) { ATT_SBAR(); v_read<NB, 0>(fa, vb); v_read<NB, 1>(fb, vb); ATT_LGKM(8); }
    else { ATT_LGKM(0); }
    pv_mm<NB, 0, EXP, PROBE>(o[0], lacc, fa, pa0, pa1, pa2, pa3, p0, p1);
    if constexpr (NB == 2) { if constexpr (!PRE) ATT_LGKM(0); pv_mm<NB, 1, EXP, PROBE>(o[1], lacc, fb, pa0, pa1, pa2, pa3, p0, p1); }
    else {
        ATT_SBAR(); v_read<NB, 2>(fa, vb); ATT_LGKM(8); pv_mm<NB, 1, EXP, PROBE>(o[1], lacc, fb, pa0, pa1, pa2, pa3, p0, p1);
        ATT_SBAR(); v_read<NB, 3>(fb, vb); ATT_LGKM(8); pv_mm<NB, 2, EXP, PROBE>(o[2], lacc, fa, pa0, pa1, pa2, pa3, p0, p1);
        ATT_LGKM(0); pv_mm<NB, 3, EXP, PROBE>(o[3], lacc, fb, pa0, pa1, pa2, pa3, p0, p1);
    }
}
template <int NQ, int KP> __device__ __forceinline__ void k_read(bf16x8* kf, const char* Ks, int koffB, int r32, int hi) {
#pragma unroll
    for (int d0 = 0; d0 < NQ; ++d0) { const int cb = koffB + (d0 * 16 + hi * 8) * 2;
        kf[2 * d0] = *reinterpret_cast<const bf16x8*>(Ks + r32 * KP + cb); kf[2 * d0 + 1] = *reinterpret_cast<const bf16x8*>(Ks + (32 + r32) * KP + cb); }
}
template <int NQ, int KP, int PROBE = 0> __device__ __forceinline__ void qkt(f32x16& p0, f32x16& p1, const char* Ks, int koffB, const bf16x8* qr, int r32, int hi) {
    bf16x8 kf[2 * NQ]; k_read<NQ, KP>(kf, Ks, koffB, r32, hi);
    if constexpr (PROBE == 4) { _Pragma("unroll") for (int i = 0; i < 2 * NQ; ++i) asm volatile("" :: "v"(kf[i])); p0 = f32x16{}; p1 = f32x16{}; return; }
#pragma unroll
    for (int d0 = 0; d0 < NQ; ++d0) {
        if (d0 == 0) { p0 = __builtin_amdgcn_mfma_f32_32x32x16_bf16(kf[0], qr[0], f32x16{}, 0, 0, 0); p1 = __builtin_amdgcn_mfma_f32_32x32x16_bf16(kf[1], qr[0], f32x16{}, 0, 0, 0); }
        else { p0 = __builtin_amdgcn_mfma_f32_32x32x16_bf16(kf[2 * d0], qr[d0], p0, 0, 0, 0); p1 = __builtin_amdgcn_mfma_f32_32x32x16_bf16(kf[2 * d0 + 1], qr[d0], p1, 0, 0, 0); } }
}
__device__ __forceinline__ void add_bias(f32x16& p0, f32x16& p1, float nb) {
#pragma unroll
    for (int r = 0; r < 16; ++r) { p0[r] += nb; p1[r] += nb; }
}
__device__ __forceinline__ void exp_all(f32x16& p0, f32x16& p1) {
#pragma unroll
    for (int r = 0; r < 16; ++r) { p0[r] = __builtin_amdgcn_exp2f(p0[r]); p1[r] = __builtin_amdgcn_exp2f(p1[r]); }
}
struct RS { float a, b, c, d; };
template <int I> __device__ __forceinline__ void rs_add1(RS& l, const f32x16& p0, const f32x16& p1) {
    const float x = (I < 16) ? p0[I & 15] : p1[I & 15];
    if constexpr ((I & 3) == 0) asm volatile("v_add_f32 %0, %0, %1" : "+v"(l.a) : "v"(x));
    else if constexpr ((I & 3) == 1) asm volatile("v_add_f32 %0, %0, %1" : "+v"(l.b) : "v"(x));
    else if constexpr ((I & 3) == 2) asm volatile("v_add_f32 %0, %0, %1" : "+v"(l.c) : "v"(x));
    else asm volatile("v_add_f32 %0, %0, %1" : "+v"(l.d) : "v"(x));
}
template <int I0, int I1> __device__ __forceinline__ void rs_adds(RS& l, const f32x16& p0, const f32x16& p1) {
    if constexpr (ATT_RSV && I0 < I1) { rs_add1<I0>(l, p0, p1); rs_adds<I0 + 1, I1>(l, p0, p1); }
}
template <int NQ, int G> __device__ __forceinline__ void rs_group(RS& l, const f32x16& p0, const f32x16& p1) {
    if constexpr (NQ == 4) rs_adds<8 * G, 8 * G + 8>(l, p0, p1);
    else { constexpr int S = (G < 2) ? 6 * G : 12 + 5 * (G - 2), N = (G < 2) ? 6 : 5; rs_adds<S, S + N>(l, p0, p1); }
}
__device__ __forceinline__ void sum_pack(const f32x16& p0, const f32x16& p1, bf16x8& pa0, bf16x8& pa1, bf16x8& pa2, bf16x8& pa3, RS& l) {
    rs_adds<0, 32>(l, p0, p1);
#define ATT_PK4(P, BASE, OUT) do { u32x4 w = {cvtpk(P[BASE + 0], P[BASE + 1]), cvtpk(P[BASE + 2], P[BASE + 3]), cvtpk(P[BASE + 4], P[BASE + 5]), cvtpk(P[BASE + 6], P[BASE + 7])}; \
    OUT = *reinterpret_cast<bf16x8*>(&w); } while (0)
    ATT_PK4(p0, 0, pa0); ATT_PK4(p0, 8, pa1); ATT_PK4(p1, 0, pa2); ATT_PK4(p1, 8, pa3);
#undef ATT_PK4
}

#define ATT_PK4(P, BASE, OUT) do { u32x4 w = {cvtpk(P[BASE + 0], P[BASE + 1]), cvtpk(P[BASE + 2], P[BASE + 3]), cvtpk(P[BASE + 4], P[BASE + 5]), cvtpk(P[BASE + 6], P[BASE + 7])}; \
    OUT = *reinterpret_cast<bf16x8*>(&w); } while (0)
template <int NQ, int KP, int PROBE = 0> __device__ __forceinline__ void qkt_sp(f32x16& n0, f32x16& n1, const char* Ks, int koffB, const bf16x8* qr, int r32, int hi,
                                                                const f32x16& e0, const f32x16& e1, bf16x8& pa0, bf16x8& pa1, bf16x8& pa2, bf16x8& pa3, RS& l) {
    bf16x8 kf[2 * NQ]; k_read<NQ, KP>(kf, Ks, koffB, r32, hi);
#pragma unroll
    for (int d0 = 0; d0 < NQ; ++d0) {
        if constexpr (PROBE == 4) { asm volatile("" :: "v"(kf[2 * d0]), "v"(kf[2 * d0 + 1])); if (d0 == 0) { n0 = f32x16{}; n1 = f32x16{}; } }
        else if (d0 == 0) { n0 = __builtin_amdgcn_mfma_f32_32x32x16_bf16(kf[0], qr[0], f32x16{}, 0, 0, 0); n1 = __builtin_amdgcn_mfma_f32_32x32x16_bf16(kf[1], qr[0], f32x16{}, 0, 0, 0); }
        else { n0 = __builtin_amdgcn_mfma_f32_32x32x16_bf16(kf[2 * d0], qr[d0], n0, 0, 0, 0); n1 = __builtin_amdgcn_mfma_f32_32x32x16_bf16(kf[2 * d0 + 1], qr[d0], n1, 0, 0, 0); }
        if (d0 == 0) { ATT_PK4(e0, 0, pa0); rs_group<NQ, 0>(l, e0, e1); }
        if (d0 == 1) { ATT_PK4(e0, 8, pa1); rs_group<NQ, 1>(l, e0, e1); }
        if (d0 == 2) { ATT_PK4(e1, 0, pa2); rs_group<NQ, 2>(l, e0, e1); }
        if (d0 == 3) { ATT_PK4(e1, 8, pa3); rs_group<NQ, 3>(l, e0, e1); }
        if constexpr (NQ == 6) { if (d0 == 4) rs_group<NQ, 4>(l, e0, e1); if (d0 == 5) rs_group<NQ, 5>(l, e0, e1); }
    }
}
template <int NQ, int KP, int PROBE = 0, bool XS = false> __device__ __forceinline__ void qkt_sp_pre(f32x16& n0, f32x16& n1, const bf16x8* kf, const bf16x8* qr,
                                                                f32x16& e0, f32x16& e1, bf16x8& pa0, bf16x8& pa1, bf16x8& pa2, bf16x8& pa3, RS& l) {
#pragma unroll
    for (int d0 = 0; d0 < NQ; ++d0) {
        if constexpr (PROBE == 4) { asm volatile("" :: "v"(kf[2 * d0]), "v"(kf[2 * d0 + 1])); if (d0 == 0) { n0 = f32x16{}; n1 = f32x16{}; } }
        else if (d0 == 0) { n0 = __builtin_amdgcn_mfma_f32_32x32x16_bf16(kf[0], qr[0], f32x16{}, 0, 0, 0); n1 = __builtin_amdgcn_mfma_f32_32x32x16_bf16(kf[1], qr[0], f32x16{}, 0, 0, 0); }
        else { n0 = __builtin_amdgcn_mfma_f32_32x32x16_bf16(kf[2 * d0], qr[d0], n0, 0, 0, 0); n1 = __builtin_amdgcn_mfma_f32_32x32x16_bf16(kf[2 * d0 + 1], qr[d0], n1, 0, 0, 0); }
        if (d0 == 0) { if constexpr (XS) { exp4<24>(e0, e1); ATT_PIN2(e0, e1); } ATT_PK4(e0, 0, pa0); rs_group<NQ, 0>(l, e0, e1); }
        if (d0 == 1) { if constexpr (XS) { exp4<28>(e0, e1); ATT_PIN2(e0, e1); } ATT_PK4(e0, 8, pa1); rs_group<NQ, 1>(l, e0, e1); }
        if (d0 == 2) { ATT_PK4(e1, 0, pa2); rs_group<NQ, 2>(l, e0, e1); }
        if (d0 == 3) { ATT_PK4(e1, 8, pa3); rs_group<NQ, 3>(l, e0, e1); }
        if constexpr (NQ == 6) { if (d0 == 4) rs_group<NQ, 4>(l, e0, e1); if (d0 == 5) rs_group<NQ, 5>(l, e0, e1); }
    }
}
#undef ATT_PK4

template <int KIND> struct Cfg;
template <> struct Cfg<0> { static constexpr int KROW = 96,  NQ = 6, DV = 64;  };
template <> struct Cfg<1> { static constexpr int KROW = 128, NQ = 4, DV = 128; };
template <> struct Cfg<2> { static constexpr int KROW = 64,  NQ = 4, DV = 64;  };
constexpr int NTILES = 2048 / 64;
constexpr int LDS_WS = 135168, LDS_BYTES = LDS_WS;
struct DiffAux { float lam; float oscale; const float* og; };

template <int KIND, int PROBE = 0>
__device__ __forceinline__ void attn_unit(const bf16_t* __restrict__ Qg, const bf16_t* __restrict__ Kg, const bf16_t* __restrict__ Vg, bf16_t* mixp, float negBc, const DiffAux& aux, char* lds, void* diag_out = nullptr) {
    using C = Cfg<KIND>;
    constexpr int KROW = C::KROW, NQ = C::NQ, DV = C::DV, NB = DV / 32, KP = KROW * 2 + 16, KBUF = 64 * KP, VBUF = 64 * DV * 2;
    int tid_ = threadIdx.x; asm volatile("" : "+v"(tid_));
    const int tid = tid_, lane = tid & 63, r32 = lane & 31, hi = lane >> 5; const int wid = __builtin_amdgcn_readfirstlane(tid >> 6);
    const int comp = (KIND == 1) ? (wid >> 2) : 0, rb = (KIND == 1) ? (wid & 3) : wid;
    constexpr bool TWO = (KIND == 2) && ATT_GQA2 && ATT_NEWK && ATT_ALT && ATT_RSV && PROBE == 0;
    constexpr int SLOT = KBUF + VBUF, R = (KIND == 1) ? 4 : (TWO ? 7 : 5), D = TWO ? R - 3 : R - 2;
    constexpr int NKP = KBUF / 1024, NVP = VBUF / 1024, NP = NKP + NVP, NPW = (NP + 7) / 8;
    static_assert(R * SLOT <= LDS_WS && KBUF % 1024 == 0 && VBUF % 1024 == 0, "LDS map");
    f32x16 o[NB]; f32x16 lacc = f32x16{}; bf16x8 qr[NQ];
#pragma unroll
    for (int d = 0; d < NB; ++d) o[d] = f32x16{};
    { const bf16_t* Qw = Qg + (size_t)(rb * 32 + r32) * KROW + comp * 64 + hi * 8;
#pragma unroll
      for (int d0 = 0; d0 < NQ; ++d0) qr[d0] = *reinterpret_cast<const bf16x8*>(Qw + d0 * 16); }
    const float nb = __builtin_amdgcn_readfirstlane(negBc);
    const int koffB = comp * 128;
    const unsigned lds0 = (unsigned)(uintptr_t)lds;
    const int vb0 = (int)lds0 + KBUF + v_rd_base(lane);
    const bf16_t* gsrc[NPW]; int gstep[NPW]; int npw = 0;
#pragma unroll
    for (int i = 0; i < NPW; ++i) {
        const int pi = wid + 8 * i;
        if (pi < NKP) { const int d = 1024 * pi + 16 * lane, row = d / KP, cb = d % KP;
            gsrc[i] = Kg + row * KROW + (cb < 2 * KROW ? (cb >> 1) : 0); gstep[i] = 64 * KROW; }
        else { const int q = 1024 * (pi - NKP) + 16 * lane, st = q >> 9, kk = (st / NB) * 8 + ((q & 511) >> 6), k = kk, c = (st % NB) * 32 + ((q & 63) >> 1);
            gsrc[i] = Vg + k * DV + c; gstep[i] = 64 * DV; }
        if (pi < NP) npw = i + 1;
    }
#define ATT_DMA(t, slot) do { if constexpr (PROBE == 0) { _Pragma("unroll") for (int i_ = 0; i_ < NPW; ++i_) { if (i_ < npw) \
        glds16(gsrc[i_] + (size_t)(t) * gstep[i_], (unsigned)__builtin_amdgcn_readfirstlane((int)lds0 + (slot) * SLOT + 1024 * (wid + 8 * i_))); } } } while (0)
#define ATT_WAITBAR(keep) do { if (npw == NPW) asm volatile("s_waitcnt vmcnt(%0) lgkmcnt(0)\n\ts_barrier" :: "n"((keep) * NPW) : "memory"); \
                               else asm volatile("s_waitcnt vmcnt(%0) lgkmcnt(0)\n\ts_barrier" :: "n"((keep) * (NPW - 1)) : "memory"); } while (0)
#define ATT_KSLOT(s_) (lds + (s_) * SLOT)
#define ATT_VSLOT(s_) (vb0 + (s_) * SLOT)
#define ATT_INC(x) do { x = (x == R - 1) ? 0 : x + 1; } while (0)
    bf16x8 pa0, pa1, pa2, pa3; RS ls{0.f, 0.f, 0.f, 0.f};
#if ATT_DIAG
    unsigned long long dacc[4] = {0, 0, 0, 0};
#endif
    constexpr int NT = NTILES;
#pragma unroll
    for (int t = 0; t < D; ++t) ATT_DMA(t, t);
    ATT_WAITBAR(D - 1);
    int sc = 0, sp = 0, sw = D;
    {
        f32x16 pA0, pA1, pB0, pB1; VF fa, fb;
        constexpr bool KPRE = (KIND != 1);
        constexpr bool DLATE = (KIND == 1) && ATT_DLATE && ATT_ALT4 && ATT_RSV && PROBE == 0 && NPW <= 5;
        constexpr bool NEWK = KPRE && ATT_NEWK && ATT_ALT && ATT_RSV && PROBE == 0;
        constexpr bool XS = NEWK && ATT_XSPLIT && (NQ == 6);
        const int ka0 = (int)lds0 + r32 * KP + koffB + hi * 16;
        constexpr int KEEP = TWO ? 1 : (KPRE ? D - 2 : D - 1);
        bf16x8 kf[KPRE ? 2 * NQ : 1];
        if constexpr (KPRE) {
            ATT_WAITBAR(D - 2);
            ATT_DMA(D, sw); ATT_INC(sw);
            qkt<NQ, KP>(pA0, pA1, ATT_KSLOT(0), koffB, qr, r32, hi); if (nb != 0.f) add_bias(pA0, pA1, nb);
            if constexpr (NEWK) { ATT_SBAR(); k_read_grp<KP, 0>(kf, ka0 + SLOT); k_read_grp<KP, 1>(kf, ka0 + SLOT); if constexpr (NQ == 6) k_read_grp<KP, 2>(kf, ka0 + SLOT); ATT_SBAR(); }
            else k_read<NQ, KP>(kf, ATT_KSLOT(1), koffB, r32, hi);
            if constexpr (XS) { exp4<0>(pA0, pA1); exp4<4>(pA0, pA1); exp4<8>(pA0, pA1); exp4<12>(pA0, pA1); exp4<16>(pA0, pA1); exp4<20>(pA0, pA1); }
            else exp_all(pA0, pA1);
        } else {
            ATT_DMA(D, sw); ATT_INC(sw);
            qkt<NQ, KP>(pA0, pA1, ATT_KSLOT(0), koffB, qr, r32, hi); if (nb != 0.f) add_bias(pA0, pA1, nb); exp_all(pA0, pA1);
        }
        ATT_WAITBAR(KEEP);
        if constexpr (NEWK) k_pin<NQ>(kf);
        sc = 1;
        int sk = 2;
#define ATT_STEP(E0, E1, N0, N1, j, keep) ATT_STEPB(E0, E1, N0, N1, j, keep, true)
#define ATT_STEPB(E0, E1, N0, N1, j, keep, BAR) do { \
            ATT_T(t0_); if constexpr (!DLATE) { if ((j) + D < NT) ATT_DMA((j) + D, sw); } ATT_T(t1_); \
            if constexpr (KPRE) { ATT_SBAR(); qkt_sp_pre<NQ, KP, PROBE, XS>(N0, N1, kf, qr, E0, E1, pa0, pa1, pa2, pa3, ls); ATT_SBAR(); \
                                  if constexpr (!NEWK) { if ((j) + 1 < NT) k_read<NQ, KP>(kf, ATT_KSLOT(sk), koffB, r32, hi); } } \
            else qkt_sp<NQ, KP, PROBE>(N0, N1, ATT_KSLOT(sc), koffB, qr, r32, hi, E0, E1, pa0, pa1, pa2, pa3, ls); \
            if (nb != 0.f) add_bias(N0, N1, nb); ATT_T(t2_); \
            if constexpr (NEWK) { if ((j) + 1 < NT) pv_alt_k<true, KP, NQ / 2, XS>(o, ATT_VSLOT(sp), pa0, pa1, pa2, pa3, N0, N1, kf, ka0 + sk * SLOT); \
                                  else pv_alt_k<true, KP, 0, XS>(o, ATT_VSLOT(sp), pa0, pa1, pa2, pa3, N0, N1, kf, ka0); } \
            else if constexpr (NB == 2 && ATT_ALT && ATT_RSV && PROBE == 0) pv_alt<true>(o, ATT_VSLOT(sp), pa0, pa1, pa2, pa3, N0, N1); \
            else if constexpr (DLATE) pv_alt4_d<true>(o, ATT_VSLOT(sp), pa0, pa1, pa2, pa3, N0, N1, [&](int i_) { if (i_ < npw && (j) + D < NT) \
                     glds16(gsrc[i_] + (size_t)((j) + D) * gstep[i_], (unsigned)__builtin_amdgcn_readfirstlane((int)lds0 + sw * SLOT + 1024 * (wid + 8 * i_))); }); \
            else if constexpr (NB == 4 && ATT_ALT4 && ATT_RSV && PROBE == 0) pv_alt4<true>(o, ATT_VSLOT(sp), pa0, pa1, pa2, pa3, N0, N1); \
            else pv_all<NB, true, PROBE, false>(o, lacc, ATT_VSLOT(sp), pa0, pa1, pa2, pa3, N0, N1, fa, fb); ATT_T(t3_); \
            ATT_INC(sw); if constexpr (BAR) ATT_WAITBAR(keep); else asm volatile("s_waitcnt lgkmcnt(0)" ::: "memory");     \
            if constexpr (NEWK) k_pin<NQ>(kf); if constexpr (KPRE) ATT_INC(sk); ATT_INC(sc); ATT_INC(sp); ATT_T(t4_); ATT_ACC(0, t0_, t1_); ATT_ACC(1, t1_, t2_); ATT_ACC(2, t2_, t3_); ATT_ACC(3, t3_, t4_); } while (0)
        static_assert(NT == 32 && (D == 3 || D == 2 || (TWO && D == 4)), "step schedule below is written for 32 tiles, 2 or 3 tiles ahead (4 in the barrier-per-pair form)");
#pragma unroll 1
        for (int j = 1; j < NT - 3; j += 2) { ATT_STEPB(pA0, pA1, pB0, pB1, j, KEEP, !TWO); ATT_STEP(pB0, pB1, pA0, pA1, j + 1, KEEP); }
        ATT_STEP(pA0, pA1, pB0, pB1, NT - 3, (NT - 3 < NT - D) ? KEEP : 0); ATT_STEP(pB0, pB1, pA0, pA1, NT - 2, 0); ATT_STEP(pA0, pA1, pB0, pB1, NT - 1, 0);
#undef ATT_STEP
#undef ATT_STEPB
        if constexpr (XS) { exp4<24>(pB0, pB1); exp4<28>(pB0, pB1); }
        sum_pack(pB0, pB1, pa0, pa1, pa2, pa3, ls);
        if constexpr (NB == 2 && ATT_ALT && ATT_RSV && PROBE == 0) pv_alt<false>(o, ATT_VSLOT(sp), pa0, pa1, pa2, pa3, pB0, pB1);
        else if constexpr (NB == 4 && ATT_ALT4 && ATT_RSV && PROBE == 0) pv_alt4<false>(o, ATT_VSLOT(sp), pa0, pa1, pa2, pa3, pB0, pB1);
        else pv_all<NB, false>(o, lacc, ATT_VSLOT(sp), pa0, pa1, pa2, pa3, pB0, pB1, fa, fb);
    }
#undef ATT_DMA
#undef ATT_WAITBAR
#undef ATT_KSLOT
#undef ATT_VSLOT
#undef ATT_INC
#if ATT_DIAG
    if (KIND == ATT_DIAG_KIND && lane == 0) { unsigned long long* dg = (unsigned long long*)diag_out; for (int i = 0; i < 4; ++i) atomicAdd(dg + i, dacc[i]); }
#endif
    float rli[16];
    if constexpr (ATT_RSV) {
        float lt = (ls.a + ls.b) + (ls.c + ls.d); { const auto q_ = __builtin_amdgcn_permlane32_swap(__float_as_uint(lt), __float_as_uint(lt), false, false); lt = __uint_as_float(q_[0]) + __uint_as_float(q_[1]); }
        const float li = __builtin_amdgcn_rcpf(lt);
#pragma unroll
        for (int r = 0; r < 16; ++r) rli[r] = __shfl(li, crow(r, hi));
    } else {
#pragma unroll
        for (int r = 0; r < 16; ++r) rli[r] = __builtin_amdgcn_rcpf(lacc[r]);
    }
    if constexpr (KIND != 1) {
        __syncthreads();
        bf16_t* stg = (bf16_t*)lds + wid * 2048;
#pragma unroll
        for (int r = 0; r < 16; ++r) { const int orow = crow(r, hi);
#pragma unroll
            for (int d0 = 0; d0 < 2; ++d0) stg[orow * 64 + d0 * 32 + r32] = (bf16_t)(cvtpk(o[d0][r] * rli[r], 0.f) & 0xffffu); }
        asm volatile("s_waitcnt lgkmcnt(0)" ::: "memory");
#pragma unroll
        for (int i = 0; i < 4; ++i) { const int row = i * 8 + (lane >> 3), ch = lane & 7; const u32x4 v = *(const u32x4*)(stg + row * 64 + ch * 8);
            *(u32x4*)(mixp + (size_t)(wid * 32 + row) * 1280 + ch * 8) = v; }
        asm volatile("s_waitcnt lgkmcnt(0)" ::: "memory"); __syncthreads();
    } else {
#pragma unroll
        for (int d0 = 0; d0 < 4; ++d0)
#pragma unroll
            for (int r = 0; r < 16; ++r) o[d0][r] *= rli[r];
        __syncthreads();
        float* X = (float*)lds + rb * 4096;
        if (comp == 1) {
#pragma unroll
            for (int d0 = 0; d0 < 4; ++d0)
#pragma unroll
                for (int r = 0; r < 16; ++r) X[crow(r, hi) * 128 + d0 * 32 + r32] = aux.lam * o[d0][r];
        }
        asm volatile("s_waitcnt lgkmcnt(0)" ::: "memory"); __syncthreads();
        if (comp == 0) {
            float og[4];
#pragma unroll
            for (int d0 = 0; d0 < 4; ++d0) og[d0] = aux.og[d0 * 32 + r32] * aux.oscale;
#pragma unroll
            for (int d0 = 0; d0 < 4; ++d0)
#pragma unroll
                for (int r = 0; r < 16; ++r) o[d0][r] -= X[crow(r, hi) * 128 + d0 * 32 + r32];
            asm volatile("s_waitcnt lgkmcnt(0)" ::: "memory");
            bf16_t* stg = (bf16_t*)X;
            float ssr[16];
#pragma unroll
            for (int r = 0; r < 16; ++r) { float v = (o[0][r] * o[0][r] + o[1][r] * o[1][r]) + (o[2][r] * o[2][r] + o[3][r] * o[3][r]);
                v += __uint_as_float(__builtin_amdgcn_update_dpp(0u, __float_as_uint(v), 0xB1, 0xf, 0xf, true));
                v += __uint_as_float(__builtin_amdgcn_update_dpp(0u, __float_as_uint(v), 0x4E, 0xf, 0xf, true));
                v += __uint_as_float(__builtin_amdgcn_update_dpp(0u, __float_as_uint(v), 0x141, 0xf, 0xf, true));
                v += __uint_as_float(__builtin_amdgcn_update_dpp(0u, __float_as_uint(v), 0x140, 0xf, 0xf, true));
                const auto w_ = __builtin_amdgcn_permlane16_swap(__float_as_uint(v), __float_as_uint(v), false, false);
                ssr[r] = __uint_as_float(w_[0]) + __uint_as_float(w_[1]); }
#pragma unroll
            for (int r = 0; r < 16; ++r) {
                const float rr = rsqrtf(ssr[r] * (1.0f / 128.0f) + 1e-6f);
#pragma unroll
                for (int d0 = 0; d0 < 4; ++d0) stg[crow(r, hi) * 128 + d0 * 32 + r32] = (bf16_t)(cvtpk(o[d0][r] * rr * og[d0], 0.f) & 0xffffu);
            }
            asm volatile("s_waitcnt lgkmcnt(0)" ::: "memory");
#pragma unroll
            for (int i = 0; i < 8; ++i) { const int row = i * 4 + (lane >> 4), ch = lane & 15; const u32x4 v = *(const u32x4*)(stg + row * 128 + ch * 8);
                *(u32x4*)(mixp + (size_t)(rb * 32 + row) * 1280 + ch * 8) = v; }
        }
        asm volatile("s_waitcnt lgkmcnt(0)" ::: "memory"); __syncthreads();
    }
}
#undef ATT_SBAR
}
#define GAS __attribute__((address_space(1)))
#define LAS __attribute__((address_space(3)))
typedef unsigned short bf16;
typedef unsigned v4u __attribute__((ext_vector_type(4)));
typedef float f32x4 __attribute__((ext_vector_type(4)));
typedef short bf16x8 __attribute__((ext_vector_type(8)));
typedef GAS unsigned gu32;
typedef GAS unsigned long long gu64;
#define RLX_AGENT __ATOMIC_RELAXED, __HIP_MEMORY_SCOPE_AGENT
#define LDS_WAIT() asm volatile("s_waitcnt lgkmcnt(0)" ::: "memory")
#define VM_WAIT() asm volatile("s_waitcnt vmcnt(0)" ::: "memory")
__device__ __forceinline__ unsigned long long rt() { return __builtin_amdgcn_s_memrealtime(); }
__device__ __forceinline__ unsigned f2bf(float f) { unsigned u = __builtin_bit_cast(unsigned, f); return (u + 0x7fffu + ((u >> 16) & 1u)) >> 16; }
__device__ __forceinline__ unsigned pk2(float lo, float hi) { return f2bf(lo) | (f2bf(hi) << 16); }
#define XB_TMO      128
#define XB_XCNT(j)  (256  + 64 * (j))
#define XB_XSUB(j)  (1280 + 64 * (j))
#define XB_XGEN(j)  (2304 + 64 * (j))
#define XB_TOP      3328
#define XB_TOPGEN   3392
#define XCD_BAR_WORDS 3456
#define XB_SPIN_CAP (1u << 18)

__device__ __forceinline__ unsigned xb_ld(unsigned* p)              { return __hip_atomic_load(p, __ATOMIC_RELAXED, __HIP_MEMORY_SCOPE_AGENT); }
__device__ __forceinline__ unsigned xb_add(unsigned* p, unsigned v) { return __hip_atomic_fetch_add(p, v, __ATOMIC_RELAXED, __HIP_MEMORY_SCOPE_AGENT); }
__device__ __forceinline__ unsigned xb_xcc_id() { return (unsigned)__builtin_amdgcn_s_getreg((3 << 11) | 20) & 0xFu; }
#define XB_SPIN(cond, bar) do { unsigned _sp = 0; while (cond) { __builtin_amdgcn_s_sleep(1); \
    if ((++_sp & 255u) == 0u) { if (xb_ld(&(bar)[XB_TMO])) break; if (_sp > XB_SPIN_CAP) { atomicAdd(&(bar)[XB_TMO], 1u); break; } } } } while (0)

struct XcdBarrier {
    unsigned* bar; unsigned x;
    volatile LAS unsigned* st;
};

__device__ __forceinline__ XcdBarrier xcd_barrier_post(unsigned* bar, volatile LAS unsigned* st) {
    XcdBarrier b; b.bar = bar; b.x = xb_xcc_id(); b.st = st;
    if (threadIdx.x == 0) (void)xb_add(&bar[XB_XCNT(b.x)], 1u);
    return b;
}
__device__ __forceinline__ void xcd_barrier_complete(unsigned* bar, unsigned x, unsigned& nloc, unsigned& nx) {
    const unsigned G = gridDim.x * gridDim.y * gridDim.z;
    unsigned sum, cnt, mine, sp = 0u;
    for (;;) {
        sum = 0u; cnt = 0u; mine = 0u;
#pragma unroll
        for (unsigned j = 0; j < 16; ++j) { const unsigned c = xb_ld(&bar[XB_XCNT(j)]); sum += c; cnt += (c > 0u) ? 1u : 0u; mine = (j == x) ? c : mine; }
        if (sum == G) break;
        __builtin_amdgcn_s_sleep(1);
        if ((++sp & 255u) == 0u) { if (xb_ld(&bar[XB_TMO])) break; if (sp > XB_SPIN_CAP) { atomicAdd(&bar[XB_TMO], 1u); break; } }
    }
    nloc = mine > 0u ? mine : 1u; nx = cnt > 0u ? cnt : 1u;
}

__device__ __forceinline__ void xcd_barrier(const XcdBarrier& b) {
    asm volatile("s_waitcnt vmcnt(0)" ::: "memory");
    __syncthreads();
    if (threadIdx.x == 0) {
        unsigned* bar = b.bar;
        __builtin_amdgcn_s_waitcnt(0);
        unsigned nloc = b.st[0], nx = b.st[1];
        if (nloc == 0u) { xcd_barrier_complete(bar, b.x, nloc, nx); b.st[0] = nloc; b.st[1] = nx; }
        const unsigned old = xb_add(&bar[XB_XSUB(b.x)], 1u);
        const unsigned gen = old / nloc;
        if (old + 1u == (gen + 1u) * nloc) {
            __builtin_amdgcn_fence(__ATOMIC_RELEASE, "agent");
            asm volatile("s_waitcnt vmcnt(0)" ::: "memory");
            const unsigned og = xb_add(&bar[XB_TOP], 1u);
            const unsigned tg = og / nx;
            if (og + 1u == (tg + 1u) * nx) xb_add(&bar[XB_TOPGEN], 1u);
            else XB_SPIN(xb_ld(&bar[XB_TOPGEN]) == tg, bar);
            __builtin_amdgcn_fence(__ATOMIC_ACQUIRE, "agent");
            xb_add(&bar[XB_XGEN(b.x)], 1u);
            asm volatile("s_waitcnt vmcnt(0)" ::: "memory");
        } else {
            XB_SPIN(xb_ld(&bar[XB_XGEN(b.x)]) == gen, bar);
            __builtin_amdgcn_fence(__ATOMIC_ACQUIRE, "agent");
            asm volatile("s_waitcnt vmcnt(0)" ::: "memory");
        }
    }
    __syncthreads();
}
#ifndef PH_CONST
#define PH_CONST 1
#endif
#ifndef USE_LOCAL_BAR
#define USE_LOCAL_BAR 1
#endif
#ifndef DEFER_W1
#define DEFER_W1 1
#endif
static_assert(att::LDS_BYTES <= RING_BYTES, "attention LDS");
struct Args { const float* in[22]; float* out; unsigned char* ws; int ph_lo, ph_hi; };

__device__ __forceinline__ float wave_sum(float v) {
    v += __uint_as_float(__builtin_amdgcn_update_dpp(0u, __float_as_uint(v), 0xB1, 0xf, 0xf, true));
    v += __uint_as_float(__builtin_amdgcn_update_dpp(0u, __float_as_uint(v), 0x4E, 0xf, 0xf, true));
    v += __uint_as_float(__builtin_amdgcn_update_dpp(0u, __float_as_uint(v), 0x141, 0xf, 0xf, true));
    v += __uint_as_float(__builtin_amdgcn_update_dpp(0u, __float_as_uint(v), 0x140, 0xf, 0xf, true));
    const auto r = __builtin_amdgcn_permlane16_swap(__float_as_uint(v), __float_as_uint(v), false, false);
    const float t = __uint_as_float(r[0]) + __uint_as_float(r[1]);
    const auto q = __builtin_amdgcn_permlane32_swap(__float_as_uint(t), __float_as_uint(t), false, false);
    return __uint_as_float(q[0]) + __uint_as_float(q[1]);
}
__device__ __forceinline__ int src_col32(int which, int g) {
    const int t = g >> 3, gi = g & 7, bj = gi >> 2, wc = gi & 3;
    switch (which) {
        case 0:
            switch (t) {
                case 0: return 32 * gi;
                case 1: return bj == 0 ? 256 + 32 * gi : 2720 + 32 * (gi - 4);
                case 2: return 384 + 32 * gi;
                case 3: case 4: return 672 + (4 * (t - 3) + wc) * 64 + 32 * bj;
                case 5: case 6: return 1184 + (4 * (t - 5) + wc) * 64 + 32 * bj;
                case 7: case 8: return 1696 + 256 * (t - 7) + 32 * gi;
                case 9: return 2208 + wc * 64 + 32 * bj;
                case 10: return wc < 2 ? 2208 + (4 + wc) * 64 + 32 * bj : 2592 + (wc - 2) * 64 + 32 * bj;
                default: return gi == 0 ? 640 : -1;
            }
        case 1: return wc < 3 ? (2 * t + bj) * 96 + 32 * wc : -1;
        case 4: return bj * FFH + 128 * t + 32 * wc;
        default: return 32 * g;
    }
}
__device__ __forceinline__ bool win_plain_group(int g) { const int t = g >> 3; return t <= 8 || t == 11; }
__device__ __forceinline__ void p0_convert_item(const float* W, int K, int N, const float* kg, int which, bf16* WT, LAS float* scr, int item, int lane) {
    const int ngr = (which == 0 ? 96 : which == 1 || which == 2 ? 24 : which == 4 ? 176 : 32), kb = item / ngr, g = item % ngr, k0 = 64 * kb, sc = src_col32(which, g);
    {
        float w[32];
        const int hl = lane >> 5, cl = lane & 31;
        if (sc >= 0) {
            const float* wp = W + (size_t)(k0 + hl) * N + sc + cl;
#pragma unroll
            for (int i = 0; i < 32; ++i) { w[i] = *wp; wp += 2 * N; if (i == 15) asm volatile("" : "+v"(wp)); }
            if (kg) {
                float gv[32];
#pragma unroll
                for (int i = 0; i < 32; ++i) gv[i] = kg[k0 + 2 * i + hl];
#pragma unroll
                for (int i = 0; i < 32; ++i) w[i] *= gv[i];
            }
        } else {
#pragma unroll
            for (int i = 0; i < 32; ++i) w[i] = 0.f;
        }
#pragma unroll
        for (int i = 0; i < 32; ++i) scr[(2 * i + hl) * 33 + cl] = w[i];
    }
    LDS_WAIT(); asm volatile("" ::: "memory");
    const int c = lane & 7;
    const bool prm = (which == 0 && win_plain_group(g)) || (which == 1 && (g & 3) < 2) || which == 2;
#pragma unroll
    for (int j = 0; j < 4; ++j) { const int n = (lane >> 3) + 8 * j; const LAS float* s = scr + (8 * c) * 33 + (prm ? pg8::perm32(n) : n);
        v4u o; o.x = pk2(s[0 * 33], s[1 * 33]); o.y = pk2(s[2 * 33], s[3 * 33]); o.z = pk2(s[4 * 33], s[5 * 33]); o.w = pk2(s[6 * 33], s[7 * 33]);
        *(GAS v4u*)(WT + (size_t)(32 * g + n) * K + k0 + 8 * c) = o; }
    LDS_WAIT(); asm volatile("" ::: "memory");
}
__device__ __forceinline__ void split_arrive(const XcdBarrier& b, unsigned* w) {
    asm volatile("s_waitcnt vmcnt(0)" ::: "memory");
    __syncthreads();
    if (threadIdx.x == 0) {
        __builtin_amdgcn_s_waitcnt(0);
        const unsigned nloc = b.st[0];
        const unsigned old = xb_add(&w[64 * b.x], 1u);
        if (old + 1u == nloc) { __builtin_amdgcn_fence(__ATOMIC_RELEASE, "agent"); asm volatile("s_waitcnt vmcnt(0)" ::: "memory"); xb_add(&w[1024], 1u); }
    }
}
__device__ __forceinline__ void split_wait(const XcdBarrier& b, unsigned* w) {
    if (threadIdx.x == 0) { const unsigned nx = b.st[1]; XB_SPIN(xb_ld(&w[1024]) < nx, b.bar); __builtin_amdgcn_fence(__ATOMIC_ACQUIRE, "agent"); asm volatile("s_waitcnt vmcnt(0)" ::: "memory"); }
    __syncthreads();
}
__device__ __forceinline__ void xcc_local_barrier(const XcdBarrier& b, unsigned* cnt, unsigned nloc) {
    asm volatile("s_waitcnt vmcnt(0)" ::: "memory");
    __syncthreads();
    if (threadIdx.x == 0) {
        __builtin_amdgcn_s_waitcnt(0);
        const unsigned old = xb_add(cnt, 1u), target = (old / nloc + 1u) * nloc;
        XB_SPIN(xb_ld(cnt) < target, b.bar);
        __builtin_amdgcn_fence(__ATOMIC_ACQUIRE, "agent");
        asm volatile("s_waitcnt vmcnt(0)" ::: "memory");
    }
    __syncthreads();
}
__device__ __forceinline__ void local_arrive(unsigned* cnt) {
    asm volatile("s_waitcnt vmcnt(0)" ::: "memory");
    __syncthreads();
    if (threadIdx.x == 0) { __builtin_amdgcn_s_waitcnt(0); (void)xb_add(cnt, 1u); }
}
__device__ __forceinline__ void local_wait(const XcdBarrier& b, unsigned* cnt, unsigned nloc) {
    if (threadIdx.x == 0) { XB_SPIN(xb_ld(cnt) < nloc, b.bar); __builtin_amdgcn_fence(__ATOMIC_ACQUIRE, "agent"); asm volatile("s_waitcnt vmcnt(0)" ::: "memory"); }
    __syncthreads();
}
constexpr int CW_LOCAL = 10240;
constexpr int CW_SPLIT = 6144;
struct Consts { float lam, oscale, negb_mla, negb_dif, negb_gqa, pad0, pad1, pad2; };

__device__ __forceinline__ void convert_layer_weights(const Args& A, int l, LAS float* scr, int gw, int NGW, int lane) {
    constexpr int NI_IN = (3072 / 32) * (1024 / 64), NI_UQ = (768 / 32) * (384 / 64), NI_UKV = (768 / 32) * (256 / 64), NI_O = (1024 / 32) * (1280 / 64), NI_GU = (5632 / 32) * (1024 / 64), NI_DN = (1024 / 32) * (2816 / 64);
    constexpr int NI_L = NI_IN + NI_UQ + NI_UKV + NI_O + NI_GU + NI_DN;
    bf16* wb = (bf16*)(A.ws + WS_W + (size_t)l * W_LAYER);
    for (int it = gw; it < NI_L; it += NGW) {
        int r = it;
        if (r < NI_IN) { p0_convert_item(A.in[2] + (size_t)l * 1024 * INW, 1024, INW, A.in[1] + l * 1024, 0, wb + W_IN / 2, scr, r, lane); continue; } r -= NI_IN;
        if (r < NI_UQ) { p0_convert_item(A.in[4] + (size_t)l * 384 * 576, 384, 576, A.in[3] + l * 384, 1, wb + W_UQ / 2, scr, r, lane); continue; } r -= NI_UQ;
        if (r < NI_UKV) { p0_convert_item(A.in[6] + (size_t)l * 256 * 768, 256, 768, A.in[5] + l * 256, 2, wb + W_UKV / 2, scr, r, lane); continue; } r -= NI_UKV;
        if (r < NI_O) { p0_convert_item(A.in[18] + (size_t)l * 1280 * 1024, 1280, 1024, nullptr, 3, wb + W_O / 2, scr, r, lane); continue; } r -= NI_O;
        if (r < NI_GU) { p0_convert_item(A.in[20] + (size_t)l * 1024 * 2 * FFH, 1024, 2 * FFH, A.in[19] + l * 1024, 4, wb + W_GU / 2, scr, r, lane); continue; } r -= NI_GU;
        p0_convert_item(A.in[21] + (size_t)l * FFH * 1024, FFH, 1024, nullptr, 5, wb + W_DN / 2, scr, r, lane);
    }
}
__device__ __forceinline__ void p0_prologue(const Args& A, LAS unsigned char* lds, int vcu, int G, int wave, int lane, int parts = 7) {
    unsigned char* ws = A.ws;
    LAS float* scr = (LAS float*)(lds + RING_OFF + wave * 16384);
    const int gw = vcu * NWAVES + wave, NGW = G * NWAVES;
    if (parts & 1) for (int l = 0; l < (DEFER_W1 && G == 256 ? 1 : DEPTH); ++l) convert_layer_weights(A, l, scr, gw, NGW, lane);
    float* ssqx = (float*)(ws + WS_SSQ + SSQ_X); bf16* xb = (bf16*)(ws + WS_XB);
    if (parts & 2) for (int m = gw; m < M; m += 2 * NGW) {
        const int m2 = m + NGW;
        const GAS f32x4* xr = (const GAS f32x4*)(A.in[0] + (size_t)m * DMODEL) + lane; const GAS f32x4* xr2 = (const GAS f32x4*)(A.in[0] + (size_t)(m2 < M ? m2 : m) * DMODEL) + lane;
        f32x4 v[4], v2[4]; float s = 0.f, s2 = 0.f;
#pragma unroll
        for (int j = 0; j < 4; ++j) { v[j] = xr[64 * j]; v2[j] = xr2[64 * j]; }
#pragma unroll
        for (int j = 0; j < 4; ++j) { s += (v[j].x * v[j].x + v[j].y * v[j].y) + (v[j].z * v[j].z + v[j].w * v[j].w); s2 += (v2[j].x * v2[j].x + v2[j].y * v2[j].y) + (v2[j].z * v2[j].z + v2[j].w * v2[j].w); }
        s = wave_sum(s); s2 = wave_sum(s2);
        GAS unsigned long long* o8 = (GAS unsigned long long*)(xb + (size_t)m * DMODEL) + lane;
#pragma unroll
        for (int j = 0; j < 4; ++j) o8[64 * j] = (unsigned long long)pk2(v[j].x, v[j].y) | ((unsigned long long)pk2(v[j].z, v[j].w) << 32);
        if (lane < 4) ssqx[(size_t)m * 4 + lane] = lane == 0 ? s : 0.f;
        if (m2 < M) {
            GAS unsigned long long* o82 = (GAS unsigned long long*)(xb + (size_t)m2 * DMODEL) + lane;
#pragma unroll
            for (int j = 0; j < 4; ++j) o82[64 * j] = (unsigned long long)pk2(v2[j].x, v2[j].y) | ((unsigned long long)pk2(v2[j].z, v2[j].w) << 32);
            if (lane < 4) ssqx[(size_t)m2 * 4 + lane] = lane == 0 ? s2 : 0.f;
        }
    }
    if (!(parts & 4)) return;
    float* tab = (float*)(ws + WS_TAB);
    const int gt = gw * 64 + lane, NGT = NGW * 64;
    for (int e = gt; e < 2048 * 16; e += NGT) { const int p = e >> 4, i = e & 15; const float ang = (float)p * (1.0f / powf(10000.0f, (float)(2 * i) / 32.0f)); tab[TAB_MLA_COS / 4 + e] = cosf(ang); tab[TAB_MLA_SIN / 4 + e] = sinf(ang); }
    for (int e = gt; e < 2048 * 32; e += NGT) { const int p = e >> 5, i = e & 31; const float ang = (float)p * (1.0f / powf(10000.0f, (float)(2 * i) / 64.0f)); tab[TAB_DIF_COS / 4 + e] = cosf(ang); tab[TAB_DIF_SIN / 4 + e] = sinf(ang); }
    for (int e = gt; e < 64 * 16; e += NGT) { const int p = e >> 4, i = e & 15; const float ang = (float)p * (1.0f / powf(10000.0f, (float)(2 * i) / 32.0f)); const float c = cosf(ang), s = sinf(ang);
        tab[TAB_COL_COS / 4 + e] = c; tab[TAB_COL_SIN / 4 + e] = s; if (p < 32) { tab[TAB_ROW_COS / 4 + e] = c; tab[TAB_ROW_SIN / 4 + e] = s; } }
    for (int e = gt; e < DEPTH * GN_STRIDE; e += NGT) { const int l = e / GN_STRIDE, r = e % GN_STRIDE; float v;
        if (r < GN_MK) v = A.in[7][l * 96 + r]; else if (r < GN_DQ) v = A.in[8][l * 96 + r - GN_MK]; else if (r < GN_DK) v = A.in[9][l * 64 + r - GN_DQ]; else if (r < GN_GQ) v = A.in[10][l * 64 + r - GN_DK];
        else if (r < GN_GK) v = A.in[16][l * 64 + r - GN_GQ]; else if (r < GN_OG) v = A.in[17][l * 64 + r - GN_GK]; else v = A.in[15][l * 128 + r - GN_OG];
        tab[TAB_GAIN / 4 + e] = v; }
    if (gw < DEPTH) {
        const int l = gw;
        const float d1 = wave_sum(A.in[11][l * 64 + lane] * A.in[12][l * 64 + lane]), d2 = wave_sum(A.in[13][l * 64 + lane] * A.in[14][l * 64 + lane]);
        const float lambda_init = 0.8f - 0.6f * expf(-0.3f * (float)l);
        float mq = fabsf(A.in[7][l * 96 + lane]), mk = fabsf(A.in[8][l * 96 + lane]);
        if (lane < 32) { mq = fmaxf(mq, fabsf(A.in[7][l * 96 + 64 + lane])); mk = fmaxf(mk, fabsf(A.in[8][l * 96 + 64 + lane])); }
        float dq = fabsf(A.in[9][l * 64 + lane]), dk = fabsf(A.in[10][l * 64 + lane]), gq = fabsf(A.in[16][l * 64 + lane]), gk = fabsf(A.in[17][l * 64 + lane]);
#pragma unroll
        for (int o = 1; o < 64; o <<= 1) { mq = fmaxf(mq, __shfl_xor(mq, o)); mk = fmaxf(mk, __shfl_xor(mk, o)); dq = fmaxf(dq, __shfl_xor(dq, o)); dk = fmaxf(dk, __shfl_xor(dk, o)); gq = fmaxf(gq, __shfl_xor(gq, o)); gk = fmaxf(gk, __shfl_xor(gk, o)); }
        if (lane == 0) { Consts c; c.lam = expf(d1) - expf(d2) + lambda_init; c.oscale = 1.0f - lambda_init;
            const float bm = pg8::C2_MLA * 96.0f * mq * mk, bd = pg8::C2_64 * 64.0f * dq * dk, bg = pg8::C2_64 * 64.0f * gq * gk;
            c.negb_mla = bm > 48.f ? -bm : 0.f; c.negb_dif = bd > 48.f ? -bd : 0.f; c.negb_gqa = bg > 48.f ? -bg : 0.f;
            c.pad0 = c.pad1 = c.pad2 = 0.f;
            *(Consts*)((unsigned char*)tab + TAB_CONST + 32 * l) = c; }
    }
}

#ifndef ATT_SD1
#define ATT_SD1 1
#endif
#ifndef KMASK
#define KMASK 7
#endif
#ifndef ATT_PROBE
#define ATT_PROBE 0
#endif
#define ATT_BODY { \
            const int b = vcu2 >> 5, c32 = vcu2 & 31; \
            att::DiffAux aux{cst.lam, cst.oscale, tab + TAB_GAIN / 4 + l * GN_STRIDE + GN_OG}; \
            if (KMASK & 1) for (int i = 0; i < 2; ++i) { const int u = c32 + 32 * i, h = u >> 4, qb = u & 15; const size_t hrow = (size_t)(b * 4 + h) * 2048; \
                ATTU(1)((const att::bf16_t*)(qkv + QB) + (hrow + qb * 128) * 128, (const att::bf16_t*)(qkv + KB) + hrow * 128, (const att::bf16_t*)(qkv + VB) + hrow * 128, \
                                  mix + (size_t)(b * 2048 + qb * 128) * MIXW + 384 + h * 128, cst.negb_dif, aux, (char*)lds + RING_OFF); } \
            if (KMASK & 4) for (int i = 0; i < 2; ++i) { const int u = i == 0 ? c32 : 16 + c32; if (i == 1 && c32 < 16) break; const int h = u >> 3, qb = u & 7; const size_t hq = (size_t)(b * 6 + h) * 2048, hk = (size_t)(b * 2 + h / 3) * 2048; \
                ATTU(2)((const att::bf16_t*)(qkv + QC) + (hq + qb * 256) * 64, (const att::bf16_t*)(qkv + KC) + hk * 64, (const att::bf16_t*)(qkv + VC) + hk * 64, \
                                  mix + (size_t)(b * 2048 + qb * 256) * MIXW + 896 + h * 64, cst.negb_gqa, aux, (char*)lds + RING_OFF, ws + WS_CTL + 32768); } \
            if (SPLIT_MLA && IN(p0 + 1)) { if (loc) local_wait(bar, (unsigned*)(ctl + CW_LOCAL + 1024 + 2048 * l + 64 * xb_xcc_id()), (unsigned)(G / 8)); else split_wait(bar, (unsigned*)(ctl + CW_SPLIT + 2048 * l)); }     \
            if (KMASK & 2) for (int i = 0; i < 2; ++i) { const int u = c32 + 32 * i; if (u >= 48) break; const int h = u >> 3, qb = u & 7; const size_t hrow = (size_t)(b * 6 + h) * 2048; \
                ATTU(0)((const att::bf16_t*)(qkv + QA) + (hrow + qb * 256) * 96, (const att::bf16_t*)(qkv + KA) + hrow * 96, (const att::bf16_t*)(qkv + VA) + hrow * 64, \
                                  mix + (size_t)(b * 2048 + qb * 256) * MIXW + h * 64, cst.negb_mla, aux, (char*)lds + RING_OFF, ws + WS_CTL + 32768); } \
 }
__global__ void __launch_bounds__(NWAVES * 64, 2) mega_fwd(Args args) {
    extern __shared__ __attribute__((aligned(16))) unsigned char lds[];
    LAS unsigned char* ldsl = (LAS unsigned char*)lds;
    volatile LAS unsigned* MISC = (volatile LAS unsigned*)(ldsl + MISC_OFF);
    int tid_ = threadIdx.x; asm volatile("" : "+v"(tid_));
    const int tid = tid_, lane = tid & 63, wave = __builtin_amdgcn_readfirstlane(tid >> 6);
    constexpr int G = 256;
    const int bx = blockIdx.x, vcu = (bx % 8) * (G / 8) + bx / 8;
    unsigned char* ws = args.ws;
    gu32* ctl = (gu32*)(ws + WS_CTL);
    for (int u = tid; u < (LDS_BYTES - LDSCTL_OFF) / 4; u += NWAVES * 64) ((LAS unsigned*)(ldsl + LDSCTL_OFF))[u] = 0u;
    __syncthreads();
#define bar (XcdBarrier{(unsigned*)((gu32*)(ws + WS_CTL) + CW_BAR), xb_xcc_id(), (volatile LAS unsigned*)((LAS unsigned char*)lds + MISC_OFF) + 8})
    if (tid == 0) { const unsigned x_ = xb_xcc_id(); MISC[10] = xb_add((unsigned*)((gu32*)(ws + WS_CTL) + CW_BAR) + XB_XCNT(x_), 1u); }
    __syncthreads();
#if PH_CONST
    constexpr int lo = 0, hi = NPHASE;
#else
    const int lo = args.ph_lo, hi = args.ph_hi;
#endif
#ifndef PRO_PART
#define PRO_PART 7
#endif
#ifndef CLK_DIAG
#define CLK_DIAG 0
#endif
#ifndef CLK_PH
#define CLK_PH 3
#endif
#ifndef GEMM_ALIGN
#define GEMM_ALIGN true
#endif
#ifndef GEMM_SP2
#define GEMM_SP2 true
#endif
#ifndef SPLIT_MLA
#define SPLIT_MLA 1
#endif
#ifndef REP_PRO
#define REP_PRO 1
#endif
#ifndef REP_IN
#define REP_IN 1
#endif
#ifndef REP_MLA
#define REP_MLA 1
#endif
#ifndef REP_ATT
#define REP_ATT 1
#endif
#ifndef REP_GU
#define REP_GU 1
#endif
#ifndef REP_OP0
#define REP_OP0 1
#endif
#ifndef EXTRA_BARS
#define EXTRA_BARS 0
#endif
#ifndef REP_DN0
#define REP_DN0 1
#endif
#ifndef PHMASK
#define PHMASK 0x7f
#endif
#define IN(k) (lo <= (k) && (k) < hi)
#define SEAM(k) do { if (IN((k) + 1)) xcd_barrier(bar); } while (0)
    float* tab = (float*)(ws + WS_TAB);
    pg8::bf16_t* xb = (pg8::bf16_t*)(ws + WS_XB);
    pg8::bf16_t* mix = (pg8::bf16_t*)(ws + WS_MIX);
    unsigned char* hs = (unsigned char*)args.out;
    pg8::bf16_t* cq = (pg8::bf16_t*)(hs + MIX_CQ); pg8::bf16_t* ckv = (pg8::bf16_t*)(hs + MIX_CKV);
    unsigned char* qkv = ws + WS_QKV;
    pg8::bf16_t* act = (pg8::bf16_t*)(ws + WS_QKV);

    if ((PHMASK & 1) && IN(0)) { for (int rep = 0; rep < REP_PRO; ++rep) { p0_prologue(args, ldsl, vcu, G, wave, lane, rep + 1 < REP_PRO ? PRO_PART : 7); __syncthreads(); } SEAM(0); }
    if (tid == 0) { MISC[11] = 0u; }
    if (USE_LOCAL_BAR && lo == 0 && G == 256) {
        if (tid == 0) { unsigned okc = 1u; unsigned* bw_ = (unsigned*)((gu32*)(ws + WS_CTL) + CW_BAR); for (unsigned j = 0; j < 16; ++j) { const unsigned c = xb_ld(&bw_[XB_XCNT(j)]); okc &= (j < 8 ? (c == (unsigned)(G / 8)) : (c == 0u)) ? 1u : 0u; } MISC[11] = okc; }
    }
    __syncthreads();
#define loc (__builtin_amdgcn_readfirstlane((int)MISC[11]) != 0)
#define bxv (loc ? (int)xb_xcc_id() + 8 * __builtin_amdgcn_readfirstlane((int)MISC[10]) : (int)blockIdx.x)
#define vcu2 ((bxv % 8) * 32 + bxv / 8)
#define lcnt ((unsigned*)((gu32*)(ws + WS_CTL) + CW_LOCAL + 64 * xb_xcc_id()))
#define SEAM_L(k) do { if (IN((k) + 1)) { if (loc) xcc_local_barrier(bar, lcnt, (unsigned)(G / 8)); else xcd_barrier(bar); } } while (0)

    for (int eb = 0; eb < EXTRA_BARS; ++eb) xcd_barrier(bar);
#pragma unroll 1
    for (int l = 0; l < DEPTH; ++l) {
        const int p0 = 1 + 6 * l;
        const pg8::bf16_t* wb = (const pg8::bf16_t*)(ws + WS_W + (size_t)l * W_LAYER);
        if ((PHMASK & 2) && IN(p0)) {

#if CLK_DIAG
            unsigned long long ck0_ = 0, rt0_ = 0; if (CLK_PH == 1 && l == 1) { ck0_ = __builtin_amdgcn_s_memtime(); rt0_ = __builtin_amdgcn_s_memrealtime(); }
#endif
          for (int rep = 0; rep < REP_IN; ++rep) {
            pg8::Gemm g{xb, wb + W_IN / 2, M, 3072, 1024}; pg8::StaticOrder S; S.init(M, 3072, G, bxv);
            pg8::EpiInProj E{ws, hs, l};
            pg8::gemm_phase<pg8::EpiInProj, pg8::StaticOrder, GEMM_ALIGN, GEMM_SP2>(ldsl + RING_OFF, g, S, E);
            __syncthreads(); }
#if CLK_DIAG
            if (CLK_PH == 1 && l == 1 && blockIdx.x == 0 && threadIdx.x == 0) { const unsigned long long ck1_ = __builtin_amdgcn_s_memtime(), rt1_ = __builtin_amdgcn_s_memrealtime(); float* dg = (float*)(ws + WS_CTL + 32768); dg[0] = (float)(ck1_ - ck0_) / (float)(rt1_ - rt0_); dg[1] = (float)(rt1_ - rt0_) / 100.f; }
#endif
            SEAM_L(p0);
        }
        if ((PHMASK & 4) && IN(p0 + 1)) {

#if CLK_DIAG
            unsigned long long ck0_ = 0, rt0_ = 0; if (CLK_PH == 2 && l == 1) { ck0_ = __builtin_amdgcn_s_memtime(); rt0_ = __builtin_amdgcn_s_memrealtime(); }
#endif
          for (int rep = 0; rep < REP_MLA; ++rep) {
            { pg8::Gemm g{cq, wb + W_UQ / 2, M, 768, 384}; pg8::StaticOrder S; S.init(M, 768, G, (bxv + 192) % G);
              pg8::EpiMlaQ E{ws, l};
              pg8::gemm_phase<pg8::EpiMlaQ, pg8::StaticOrder, false, true>(ldsl + RING_OFF, g, S, E); }
            __syncthreads();
            { pg8::Gemm g{ckv, wb + W_UKV / 2, M, 768, 256}; pg8::StaticOrder S; S.init(M, 768, G, (bxv + 128) % G);
              pg8::EpiMlaKV E{ws, hs, l};
              pg8::gemm_phase<pg8::EpiMlaKV, pg8::StaticOrder, false, true>(ldsl + RING_OFF, g, S, E); }
            __syncthreads(); }
#if CLK_DIAG
            if (CLK_PH == 2 && l == 1 && blockIdx.x == 0 && threadIdx.x == 0) { const unsigned long long ck1_ = __builtin_amdgcn_s_memtime(), rt1_ = __builtin_amdgcn_s_memrealtime(); float* dg = (float*)(ws + WS_CTL + 32768); dg[0] = (float)(ck1_ - ck0_) / (float)(rt1_ - rt0_); dg[1] = (float)(rt1_ - rt0_) / 100.f; }
#endif
            if (SPLIT_MLA && IN(p0 + 2)) { if (loc) local_arrive((unsigned*)(ctl + CW_LOCAL + 1024 + 2048 * l + 64 * xb_xcc_id())); else split_arrive(bar, (unsigned*)(ctl + CW_SPLIT + 2048 * l)); } else SEAM_L(p0 + 1);
        }
        if ((PHMASK & 8) && IN(p0 + 2)) {

#if CLK_DIAG
            unsigned long long ck0_ = 0, rt0_ = 0; if (CLK_PH == 3 && l == 1) { ck0_ = __builtin_amdgcn_s_memtime(); rt0_ = __builtin_amdgcn_s_memrealtime(); }
#endif
          for (int rep = 0; rep < REP_ATT; ++rep) {
            __syncthreads();
            const Consts cst = *(const Consts*)((const unsigned char*)tab + TAB_CONST + 32 * l);
#define ATTU(K) att::attn_unit<K, 0>
#if ATT_PROBE
            if (rep == 0) {
#undef ATTU
#define ATTU(K) att::attn_unit<K, ATT_PROBE>
            ATT_BODY
#undef ATTU
#define ATTU(K) att::attn_unit<K, 0>
            continue; }
#endif
            ATT_BODY
          }
#if CLK_DIAG
            if (CLK_PH == 3 && l == 1 && blockIdx.x == 0 && threadIdx.x == 0) { const unsigned long long ck1_ = __builtin_amdgcn_s_memtime(), rt1_ = __builtin_amdgcn_s_memrealtime(); float* dg = (float*)(ws + WS_CTL + 32768); dg[0] = (float)(ck1_ - ck0_) / (float)(rt1_ - rt0_); dg[1] = (float)(rt1_ - rt0_) / 100.f; }
#endif
            SEAM_L(p0 + 2);
        }
        if ((PHMASK & 16) && IN(p0 + 3)) {

#if CLK_DIAG
            unsigned long long ck0_ = 0, rt0_ = 0; if (CLK_PH == 4 && l == 1) { ck0_ = __builtin_amdgcn_s_memtime(); rt0_ = __builtin_amdgcn_s_memrealtime(); }
#endif
          for (int rep = 0; rep < (l == 0 ? REP_OP0 : 1); ++rep) {
            pg8::Gemm g{mix, wb + W_O / 2, M, 1024, 1280}; pg8::StaticOrder S; S.init(M, 1024, G, bxv);
            pg8::EpiRes E{args.out, ws, 0};
            pg8::gemm_phase<pg8::EpiRes, pg8::StaticOrder, false, true>(ldsl + RING_OFF, g, S, E);
            __syncthreads(); }
#if CLK_DIAG
            if (CLK_PH == 4 && l == 1 && blockIdx.x == 0 && threadIdx.x == 0) { const unsigned long long ck1_ = __builtin_amdgcn_s_memtime(), rt1_ = __builtin_amdgcn_s_memrealtime(); float* dg = (float*)(ws + WS_CTL + 32768); dg[0] = (float)(ck1_ - ck0_) / (float)(rt1_ - rt0_); dg[1] = (float)(rt1_ - rt0_) / 100.f; }
#endif
            SEAM_L(p0 + 3);
        }
        if ((PHMASK & 32) && IN(p0 + 4)) {

#if CLK_DIAG
            unsigned long long ck0_ = 0, rt0_ = 0; if (CLK_PH == 5 && l == 1) { ck0_ = __builtin_amdgcn_s_memtime(); rt0_ = __builtin_amdgcn_s_memrealtime(); }
#endif
          for (int rep = 0; rep < REP_GU; ++rep) {
            pg8::Gemm g{xb, wb + W_GU / 2, M, 2 * FFH, 1024}; pg8::StaticOrder S; S.init(M, 2 * FFH, G, bxv);
            pg8::EpiSwiglu E{ws};
            pg8::gemm_phase<pg8::EpiSwiglu, pg8::StaticOrder, GEMM_ALIGN, GEMM_SP2>(ldsl + RING_OFF, g, S, E);
            __syncthreads(); }
#if DEFER_W1
            if (l == 0 && DEPTH == 2 && G == 256) {
                if (bxv >= 128) { int t2 = threadIdx.x; asm volatile("" : "+v"(t2)); const int w2 = __builtin_amdgcn_readfirstlane(t2 >> 6);
                    convert_layer_weights(args, 1, (LAS float*)(ldsl + RING_OFF + w2 * 16384), (bxv - 128) * NWAVES + w2, 128 * NWAVES, t2 & 63); }
            }
#endif
#if CLK_DIAG
            if (CLK_PH == 5 && l == 1 && blockIdx.x == 0 && threadIdx.x == 0) { const unsigned long long ck1_ = __builtin_amdgcn_s_memtime(), rt1_ = __builtin_amdgcn_s_memrealtime(); float* dg = (float*)(ws + WS_CTL + 32768); dg[0] = (float)(ck1_ - ck0_) / (float)(rt1_ - rt0_); dg[1] = (float)(rt1_ - rt0_) / 100.f; }
#endif
            SEAM_L(p0 + 4);
        }
        if ((PHMASK & 64) && IN(p0 + 5)) {

#if CLK_DIAG
            unsigned long long ck0_ = 0, rt0_ = 0; if (CLK_PH == 6 && l == 1) { ck0_ = __builtin_amdgcn_s_memtime(); rt0_ = __builtin_amdgcn_s_memrealtime(); }
#endif
            pg8::Gemm g{act, wb + W_DN / 2, M, 1024, FFH}; pg8::StaticOrder S; S.init(M, 1024, G, bxv);
            pg8::EpiRes E{args.out, ws, l == DEPTH - 1 ? 1 : 0};
            pg8::gemm_phase<pg8::EpiRes, pg8::StaticOrder, false, true>(ldsl + RING_OFF, g, S, E);
#if CLK_DIAG
            if (CLK_PH == 6 && l == 1 && blockIdx.x == 0 && threadIdx.x == 0) { const unsigned long long ck1_ = __builtin_amdgcn_s_memtime(), rt1_ = __builtin_amdgcn_s_memrealtime(); float* dg = (float*)(ws + WS_CTL + 32768); dg[0] = (float)(ck1_ - ck0_) / (float)(rt1_ - rt0_); dg[1] = (float)(rt1_ - rt0_) / 100.f; }
#endif
            SEAM(p0 + 5);
        }
    }
#if CLK_DIAG
    xcd_barrier(bar);
    if (blockIdx.x == 0) { const float* dg = (const float*)(ws + WS_CTL + 32768); const float e1 = 100.f * (rintf((dg[0] - 1.f) / 2.f) * 2.f + 1.f), e2 = 0.f;
        for (int i = threadIdx.x; i < (1 << 20); i += NWAVES * 64) args.out[i] += (i == 0) ? e1 : e2; }
#endif
#if ATT_DIAG
    xcd_barrier(bar);
    if (blockIdx.x == 0) { const unsigned long long* dq = (const unsigned long long*)(ws + WS_CTL + 32768); const float dg[4] = {(float)dq[0], (float)dq[1], (float)dq[2], (float)dq[3]}; const float tot = dg[0] + dg[1] + dg[2] + dg[3];
        float sel[6] = {100.f * dg[0] / tot, 100.f * dg[1] / tot, 100.f * dg[2] / tot, 100.f * dg[3] / tot, tot / (DIAG_NW * 31.f * 40.f), 50.f};
        const float e1 = 100.f * (DIAG_Q * rintf(sel[DIAG_A] / DIAG_Q)), e2 = DIAG_Q * rintf(sel[DIAG_B] / DIAG_Q);
        for (int i = threadIdx.x; i < (1 << 20); i += NWAVES * 64) args.out[i] += (i == 0) ? e1 : e2; }
#endif
#undef IN
#undef SEAM
#undef SEAM_L
#undef bar
#undef loc
#undef bxv
#undef vcu2
#undef lcnt
}
extern "C" void kernel_launch(void* const* d_in, const int* in_sizes, int n_in, void* d_out, int out_size, void* d_ws, size_t ws_size, hipStream_t stream) {
    static int grid = 0;
    if (grid == 0) {
        if (n_in != 22 || in_sizes[0] != M * DMODEL || out_size != M * DMODEL || ws_size < WS_END) { fprintf(stderr, "kernel_launch: unexpected shapes (n_in %d, in0 %d, out %d, ws %zu)\n", n_in, n_in > 0 ? in_sizes[0] : -1, out_size, ws_size); grid = -1; return; }
        int dev = 0, cus = 0, per_cu = 0;
        if (hipGetDevice(&dev) != hipSuccess || hipDeviceGetAttribute(&cus, hipDeviceAttributeMultiprocessorCount, dev) != hipSuccess) { grid = -1; return; }
        if (hipFuncSetAttribute((const void*)mega_fwd, hipFuncAttributeMaxDynamicSharedMemorySize, LDS_BYTES) != hipSuccess) { fprintf(stderr, "kernel_launch: hipFuncSetAttribute failed\n"); grid = -1; return; }
        if (hipOccupancyMaxActiveBlocksPerMultiprocessor(&per_cu, (const void*)mega_fwd, NWAVES * 64, LDS_BYTES) != hipSuccess || per_cu < 1) { fprintf(stderr, "kernel_launch: occupancy query says %d blocks per CU\n", per_cu); (void)hipGetLastError(); grid = -1; return; }
        grid = cus;
        if (grid != 256) { fprintf(stderr, "kernel_launch: %d CUs; this kernel's phase programs are written for 256: nothing launched\n", grid); grid = -1; return; }
    }
    if (grid < 0) return;
    Args a{};
    for (int i = 0; i < 22; ++i) a.in[i] = (const float*)d_in[i];
    a.out = (float*)d_out; a.ws = (unsigned char*)d_ws;
    (void)hipMemsetAsync((char*)d_ws + WS_CTL, 0, CTL_ZERO_BYTES, stream);
    a.ph_lo = 0; a.ph_hi = NPHASE;
    hipLaunchKernelGGL(mega_fwd, dim3(grid), dim3(NWAVES * 64), LDS_BYTES, stream, a);
    const hipError_t le = hipPeekAtLastError();
    if (le != hipSuccess) fprintf(stderr, "kernel_launch: launch failed: %s\n", hipGetErrorName(le));
}
```

```cpp
#include <hip/hip_runtime.h>
#include <cstdio>
#include <cstdint>
constexpr int NWAVES = 8;
constexpr int BATCH = 8, SEQ = 2048, DMODEL = 1024, M = BATCH * SEQ, DEPTH = 2, INW = 2848, FFH = 2816, MIXW = 1280;
constexpr int NPHASE = 1 + 6 * DEPTH;
constexpr size_t MiB = 1u << 20;
constexpr size_t WS_CTL = 0, CTL_ZERO_BYTES = 64 * 1024;
constexpr size_t WS_TAB = 1 * MiB;
constexpr size_t TAB_MLA_COS = 0, TAB_MLA_SIN = 131072, TAB_DIF_COS = 262144, TAB_DIF_SIN = 524288, TAB_ROW_COS = 786432, TAB_ROW_SIN = 788480, TAB_COL_COS = 790528, TAB_COL_SIN = 794624, TAB_CONST = 798720, TAB_GAIN = 799232;
constexpr int GN_MQ = 0, GN_MK = 96, GN_DQ = 192, GN_DK = 256, GN_GQ = 320, GN_GK = 384, GN_OG = 448, GN_STRIDE = 576;
constexpr size_t WS_SSQ = 2 * MiB;
constexpr size_t SSQ_X = 0, SSQ_Q = 262144, SSQ_KV = 786432, SSQ_KR = 1048576;
constexpr size_t WS_W = 4 * MiB;
constexpr size_t W_IN = 0, W_UQ = 6291456, W_UKV = W_UQ + 589824, W_O = W_UKV + 393216, W_GU = W_O + 2621440, W_DN = W_GU + 11534336, W_LAYER = W_DN + 5767168;
static_assert(WS_W + 2 * W_LAYER <= 56 * MiB, "weights");
constexpr size_t WS_XB = 56 * MiB;
constexpr size_t WS_MIX = 88 * MiB;
constexpr size_t MIX_CQ = 0, MIX_CKV = 12 * MiB, MIX_KR = 20 * MiB;
constexpr size_t WS_QKV = 128 * MiB;
constexpr size_t QA = 0, KA = 18 * MiB, VA = 36 * MiB, QB = 48 * MiB, KB = 64 * MiB, VB = 80 * MiB, QC = 96 * MiB, KC = 108 * MiB, VC = 112 * MiB, QKV_END = 116 * MiB;
constexpr size_t WS_GOLD = 244 * MiB, WS_END = 256 * MiB;
static_assert(WS_QKV + QKV_END <= WS_GOLD, "ws map");
constexpr int CW_BAR = 1024;
constexpr int RING_OFF = 0, RING_BYTES = 139264, LDSCTL_OFF = RING_BYTES, MISC_OFF = LDSCTL_OFF + 320, LDS_BYTES = 147456;

namespace pg8 {
#define PG8_LAS __attribute__((address_space(3)))
typedef unsigned short bf16_t;
typedef short bf16x8 __attribute__((ext_vector_type(8)));
typedef float f32x4 __attribute__((ext_vector_type(4)));
typedef unsigned u32x4 __attribute__((ext_vector_type(4)));
constexpr int BM = 256, BK = 64, HALF = 128, HTB = HALF * BK * 2  , STAGE_BYTES = 8 * HTB, NXCD = 8, WGM = 8;

__host__ __device__ __forceinline__ int lds_byte(int r, int c) { const int st = (r >> 4) * 2 + (c >> 5), rr = r & 15, cc = c & 31, ob = rr * 64 + cc * 2; return st * 1024 + (ob ^ (((ob >> 9) & 1) << 5)); }
__host__ __device__ __forceinline__ void stage_rc(int b, int& R, int& C) { const int st = b / 1024, sb = b % 1024, swz = sb ^ (((sb >> 9) & 1) << 5); R = (st >> 1) * 16 + swz / 64; C = (st & 1) * 32 + (swz % 64) / 2; }
__host__ __device__ __forceinline__ int perm32(int rho) { const int n = rho >> 4, i = rho & 15; return 8 * (i >> 2) + 4 * n + (i & 3); }

struct Unit { int pm, pn; };
struct Gemm { const bf16_t* A; const bf16_t* Bt; int M, N, K; };

struct StaticOrder {
    int nM, nN, nwg, G, c;
    __host__ __device__ void init(int M, int N, int G_, int c_) { nM = M / BM; nN = N / BM; nwg = nM * nN; G = G_; c = c_; }
    __host__ __device__ bool next(int i, Unit& u) const {
        const long L = (long)i * G + c; if (L >= nwg) return false;
        int wgid = (int)L; { const int q = nwg / NXCD, r = nwg % NXCD, xcd = wgid % NXCD, off = wgid / NXCD; wgid = (xcd < r ? xcd * (q + 1) : r * (q + 1) + (xcd - r) * q) + off; }
        const int nig = WGM * nN, gid = wgid / nig, fm = gid * WGM, gsz = (nM - fm) < WGM ? (nM - fm) : WGM;
        u.pm = fm + ((wgid % nig) % gsz); u.pn = (wgid % nig) / gsz; return true;
    }
    __device__ __forceinline__ void a_ready(const Unit&) const {}
    __device__ __forceinline__ void done(const Unit&) const {}
};

__device__ __forceinline__ unsigned cvt_pk_bf16(float lo, float hi) { unsigned r; asm volatile("v_cvt_pk_bf16_f32 %0, %1, %2" : "=v"(r) : "v"(lo), "v"(hi)); return r; }
typedef float f32x2 __attribute__((ext_vector_type(2)));
constexpr float EPS_RMS = 1e-6f;
constexpr float LOG2E = 1.4426950408889634f;
constexpr float C2_MLA = 0.10206207261596575f * LOG2E;
constexpr float C2_64 = 0.125f * LOG2E;
typedef unsigned u32x2 __attribute__((ext_vector_type(2)));
__device__ __forceinline__ u32x2 pk4(f32x4 v) { u32x2 w; w.x = cvt_pk_bf16(v[0], v[1]); w.y = cvt_pk_bf16(v[2], v[3]); return w; }
__device__ __forceinline__ void st4(bf16_t* p, f32x4 v) { u32x2 w; w.x = cvt_pk_bf16(v[0], v[1]); w.y = cvt_pk_bf16(v[2], v[3]); *(u32x2*)p = w; }
__device__ __forceinline__ float dot4(f32x4 a) { return (a[0] * a[0] + a[1] * a[1]) + (a[2] * a[2] + a[3] * a[3]); }
__device__ __forceinline__ float qsum(float s) {
    const auto r = __builtin_amdgcn_permlane16_swap(__float_as_uint(s), __float_as_uint(s), false, false);
    const float t = __uint_as_float(r[0]) + __uint_as_float(r[1]);
    const auto q = __builtin_amdgcn_permlane32_swap(__float_as_uint(t), __float_as_uint(t), false, false);
    return __uint_as_float(q[0]) + __uint_as_float(q[1]);
}
__device__ __forceinline__ f32x4 bf4_to_f32(u32x2 w) { f32x4 r; r[0] = __uint_as_float(w.x << 16); r[1] = __uint_as_float(w.x & 0xffff0000u); r[2] = __uint_as_float(w.y << 16); r[3] = __uint_as_float(w.y & 0xffff0000u); return r; }

#define WSF(off) ((float*)(ws + (off)))
#define WSH(off) ((bf16_t*)(ws + (off)))
struct EpiInProj {
    static constexpr bool PERM = false, AFTER_DRAIN = false, HAS_PRE = false, LDS_PRE = true;
    unsigned char* ws; unsigned char* hs; int l;
    template <int MODE>
    __device__ __forceinline__ void body(const f32x4 (&acc)[2][2][4][2], const Unit& u, int wr, int wc, int fr, int fq, const PG8_LAS unsigned char* pre) const {
        float rs[4];
        auto rs_load = [&](int ai) {
#pragma unroll
            for (int m = 0; m < 4; ++m) { const int rl = ai * HALF + wr * 64 + m * 16 + fr;
                const f32x4 sq = *(const PG8_LAS f32x4*)(pre + rl * 16); rs[m] = rsqrtf(((sq[0] + sq[1]) + (sq[2] + sq[3])) * (1.0f / 1024.0f) + EPS_RMS); } };
        rs_load(0);
        const int c0 = wc * 32 + 4 * fq;
        const int c8 = wc * 32 + 8 * fq;
        f32x4 tcur[4];
        auto tab_load = [&](f32x4 (&t)[4], int it) {
            const int s = (u.pm * BM + (it >> 2) * HALF + wr * 64 + (it & 3) * 16 + fr) & 2047;
            if constexpr (MODE == 3 || MODE == 4) {
                t[0] = *(const f32x4*)(WSF(WS_TAB + TAB_DIF_COS) + s * 32 + 8 * fq); t[1] = *(const f32x4*)(WSF(WS_TAB + TAB_DIF_SIN) + s * 32 + 8 * fq);
                t[2] = *(const f32x4*)(WSF(WS_TAB + TAB_DIF_COS) + s * 32 + 8 * fq + 4); t[3] = *(const f32x4*)(WSF(WS_TAB + TAB_DIF_SIN) + s * 32 + 8 * fq + 4);
            } else if constexpr (MODE == 6) {
                t[0] = *(const f32x4*)(WSF(WS_TAB + TAB_ROW_COS) + (s >> 6) * 16 + 4 * fq); t[1] = *(const f32x4*)(WSF(WS_TAB + TAB_ROW_SIN) + (s >> 6) * 16 + 4 * fq);
                t[2] = *(const f32x4*)(WSF(WS_TAB + TAB_COL_COS) + (s & 63) * 16 + 4 * fq); t[3] = *(const f32x4*)(WSF(WS_TAB + TAB_COL_SIN) + (s & 63) * 16 + 4 * fq);
            }
        };
        f32x4 gg[4];
        if constexpr (MODE == 3 || MODE == 4) { const float* g = WSF(WS_TAB + TAB_GAIN) + l * GN_STRIDE + (MODE == 3 ? GN_DQ : GN_DK);
            gg[0] = *(const f32x4*)(g + 8 * fq); gg[1] = *(const f32x4*)(g + 32 + 8 * fq); gg[2] = *(const f32x4*)(g + 8 * fq + 4); gg[3] = *(const f32x4*)(g + 32 + 8 * fq + 4); }
        const bool isq = (u.pn == 9) || (wc < 2);
        if constexpr (MODE == 6) { const float* g = WSF(WS_TAB + TAB_GAIN) + l * GN_STRIDE + (isq ? GN_GQ : GN_GK);
            gg[0] = *(const f32x4*)(g + 4 * fq); gg[1] = *(const f32x4*)(g + 16 + 4 * fq); gg[2] = *(const f32x4*)(g + 32 + 4 * fq); gg[3] = *(const f32x4*)(g + 48 + 4 * fq); }
        if constexpr (MODE == 3 || MODE == 4 || MODE == 6) tab_load(tcur, 0);
#pragma unroll
        for (int it = 0; it < 8; ++it) {
                const int ai = it >> 2, m = it & 3;
                const int row = u.pm * BM + ai * HALF + wr * 64 + m * 16 + fr, b = row >> 11, s = row & 2047;
                f32x4 v[2][2];
#pragma unroll
                for (int bj = 0; bj < 2; ++bj)
#pragma unroll
                    for (int n = 0; n < 2; ++n) v[bj][n] = acc[ai][bj][m][n] * rs[m];
                if (it == 3) rs_load(1);
                if constexpr (MODE == 0) {
#pragma unroll
                    for (int bj = 0; bj < 2; ++bj) { u32x4 w_; w_.x = cvt_pk_bf16(v[bj][0][0], v[bj][0][1]); w_.y = cvt_pk_bf16(v[bj][0][2], v[bj][0][3]); w_.z = cvt_pk_bf16(v[bj][1][0], v[bj][1][1]); w_.w = cvt_pk_bf16(v[bj][1][2], v[bj][1][3]); *(u32x4*)(((bf16_t*)(hs + MIX_CQ)) + (size_t)row * 384 + bj * HALF + c8) = w_; }
                    const float ss = qsum((dot4(v[0][0]) + dot4(v[0][1])) + (dot4(v[1][0]) + dot4(v[1][1])));
                    if (fq == 0) WSF(WS_SSQ + SSQ_Q)[(size_t)row * 8 + wc] = ss;
                } else if constexpr (MODE == 1) {
                    { u32x4 w_; w_.x = cvt_pk_bf16(v[0][0][0], v[0][0][1]); w_.y = cvt_pk_bf16(v[0][0][2], v[0][0][3]); w_.z = cvt_pk_bf16(v[0][1][0], v[0][1][1]); w_.w = cvt_pk_bf16(v[0][1][2], v[0][1][3]); *(u32x4*)(((bf16_t*)(hs + MIX_CQ)) + (size_t)row * 384 + 256 + c8) = w_; }
                    const float ss = qsum(dot4(v[0][0]) + dot4(v[0][1]));
                    if (fq == 0) WSF(WS_SSQ + SSQ_Q)[(size_t)row * 8 + 4 + wc] = ss;
                    const int kv = wc >> 1, d = (wc & 1) * 32 + 8 * fq;
                    { u32x4 w_; w_.x = cvt_pk_bf16(v[1][0][0], v[1][0][1]); w_.y = cvt_pk_bf16(v[1][0][2], v[1][0][3]); w_.z = cvt_pk_bf16(v[1][1][0], v[1][1][1]); w_.w = cvt_pk_bf16(v[1][1][2], v[1][1][3]); *(u32x4*)(WSH(WS_QKV + VC) + ((size_t)(b * 2 + kv) * 2048 + s) * 64 + d) = w_; }
                } else if constexpr (MODE == 2) {
#pragma unroll
                    for (int bj = 0; bj < 2; ++bj) { u32x4 w_; w_.x = cvt_pk_bf16(v[bj][0][0], v[bj][0][1]); w_.y = cvt_pk_bf16(v[bj][0][2], v[bj][0][3]); w_.z = cvt_pk_bf16(v[bj][1][0], v[bj][1][1]); w_.w = cvt_pk_bf16(v[bj][1][2], v[bj][1][3]); *(u32x4*)(((bf16_t*)(hs + MIX_CKV)) + (size_t)row * 256 + bj * HALF + c8) = w_; }
                    const float ss = qsum((dot4(v[0][0]) + dot4(v[0][1])) + (dot4(v[1][0]) + dot4(v[1][1])));
                    if (fq == 0) WSF(WS_SSQ + SSQ_KV)[(size_t)row * 4 + wc] = ss;
                } else if constexpr (MODE == 3 || MODE == 4) {
                    const int hc = 4 * (u.pn - (MODE == 3 ? 3 : 5)) + wc;
                    const float ss = qsum((dot4(v[0][0]) + dot4(v[0][1])) + (dot4(v[1][0]) + dot4(v[1][1])));
                    const float r = rsqrtf(ss * (1.0f / 64.0f) + EPS_RMS) * (MODE == 3 ? C2_64 : 1.0f);
                    bf16_t* dst = WSH(WS_QKV + (MODE == 3 ? QB : KB)) + ((size_t)(b * 4 + (hc >> 1)) * 2048 + s) * 128 + (hc & 1) * 64;
                    u32x2 ow[4];
#pragma unroll
                    for (int n = 0; n < 2; ++n) {
                        const f32x4 cs = tcur[2 * n], sn = tcur[2 * n + 1];
                        const f32x4 x1 = v[0][n] * gg[2 * n] * r, x2 = v[1][n] * gg[2 * n + 1] * r;
                        ow[2 * n] = pk4(x1 * cs - x2 * sn); ow[2 * n + 1] = pk4(x1 * sn + x2 * cs);
                    }
                    if (it + 1 < 8) tab_load(tcur, it + 1);
                    { u32x4 w0, w1; w0.x = ow[0].x; w0.y = ow[0].y; w0.z = ow[2].x; w0.w = ow[2].y; w1.x = ow[1].x; w1.y = ow[1].y; w1.z = ow[3].x; w1.w = ow[3].y;
                      *(u32x4*)(dst + 8 * fq) = w0; *(u32x4*)(dst + 32 + 8 * fq) = w1; }
                } else if constexpr (MODE == 5) {
#pragma unroll
                    for (int bj = 0; bj < 2; ++bj) { const int col = (u.pn - 7) * 256 + bj * HALF + c8;
                        { u32x4 w_; w_.x = cvt_pk_bf16(v[bj][0][0], v[bj][0][1]); w_.y = cvt_pk_bf16(v[bj][0][2], v[bj][0][3]); w_.z = cvt_pk_bf16(v[bj][1][0], v[bj][1][1]); w_.w = cvt_pk_bf16(v[bj][1][2], v[bj][1][3]); *(u32x4*)(WSH(WS_QKV + VB) + ((size_t)(b * 4 + (col >> 7)) * 2048 + s) * 128 + (col & 127)) = w_; } }
                } else if constexpr (MODE == 6) {
                    const int hd = (u.pn == 9) ? wc : (wc < 2 ? 4 + wc : wc - 2);
                    const float ss = qsum((dot4(v[0][0]) + dot4(v[0][1])) + (dot4(v[1][0]) + dot4(v[1][1])));
                    const float r = rsqrtf(ss * (1.0f / 64.0f) + EPS_RMS) * (isq ? C2_64 : 1.0f);
                    bf16_t* dst = isq ? WSH(WS_QKV + QC) + ((size_t)(b * 6 + hd) * 2048 + s) * 64 : WSH(WS_QKV + KC) + ((size_t)(b * 2 + hd) * 2048 + s) * 64;
                    const int f = 4 * fq;
                    u32x2 ow[4];
#pragma unroll
                    for (int bj = 0; bj < 2; ++bj) {
                        const f32x4 cs = tcur[2 * bj], sn = tcur[2 * bj + 1];
                        const f32x4 x1 = v[bj][0] * gg[2 * bj] * r, x2 = v[bj][1] * gg[2 * bj + 1] * r;
                        ow[2 * bj] = pk4(x1 * cs - x2 * sn); ow[2 * bj + 1] = pk4(x1 * sn + x2 * cs);
                    }
                    if (it + 1 < 8) tab_load(tcur, it + 1);
#pragma unroll
                    for (int bj = 0; bj < 2; ++bj) { *(u32x2*)(dst + 32 * bj + f) = ow[2 * bj]; *(u32x2*)(dst + 32 * bj + 16 + f) = ow[2 * bj + 1]; }
                } else {
                    if (wc == 0) {
                        { u32x4 w_; w_.x = cvt_pk_bf16(v[0][0][0], v[0][0][1]); w_.y = cvt_pk_bf16(v[0][0][2], v[0][0][3]); w_.z = cvt_pk_bf16(v[0][1][0], v[0][1][1]); w_.w = cvt_pk_bf16(v[0][1][2], v[0][1][3]); *(u32x4*)(((bf16_t*)(hs + MIX_KR)) + (size_t)row * 32 + 8 * fq) = w_; }
                        const float ss = qsum(dot4(v[0][0]) + dot4(v[0][1]));
                        if (fq == 0) WSF(WS_SSQ + SSQ_KR)[row] = ss;
                    }
                }
        }
    }
    __device__ __forceinline__ void stage_pre(const Unit& u, PG8_LAS unsigned char* dst, int wid, int lane) const {
        if (wid < 4) __builtin_amdgcn_global_load_lds((const unsigned*)(WSF(WS_SSQ + SSQ_X) + ((size_t)u.pm * BM + wid * 64 + lane) * 4), (PG8_LAS unsigned*)(dst + wid * 1024), 16, 0, 0);
    }
    __device__ __forceinline__ void operator()(const f32x4 (&acc)[2][2][4][2], const Unit& u, int wr, int wc, int fr, int fq, const PG8_LAS unsigned char* pre) const {
        asm volatile("" : "+v"(fr), "+v"(fq));
        switch (u.pn) {
            case 0: body<0>(acc, u, wr, wc, fr, fq, pre); break;
            case 1: body<1>(acc, u, wr, wc, fr, fq, pre); break;
            case 2: body<2>(acc, u, wr, wc, fr, fq, pre); break;
            case 3: case 4: body<3>(acc, u, wr, wc, fr, fq, pre); break;
            case 5: case 6: body<4>(acc, u, wr, wc, fr, fq, pre); break;
            case 7: case 8: body<5>(acc, u, wr, wc, fr, fq, pre); break;
            case 9: case 10: body<6>(acc, u, wr, wc, fr, fq, pre); break;
            default: body<7>(acc, u, wr, wc, fr, fq, pre); break;
        }
    }
};

#define EPI_BAR() do { asm volatile("s_waitcnt lgkmcnt(0)" ::: "memory"); __builtin_amdgcn_s_barrier(); asm volatile("" ::: "memory"); } while (0)

struct EpiMlaQ {
    static constexpr bool PERM = false, AFTER_DRAIN = true, HAS_PRE = false, LDS_PRE = false;
    unsigned char* ws; int l;
    __device__ __forceinline__ void fused(f32x4 (&acc)[2][2][4][2], const Unit& u, int wr, int wc, int fr, int fq, PG8_LAS unsigned char* lds, int wid, int lane) const {
        asm volatile("" : "+v"(fr), "+v"(fq), "+v"(lane));
        PG8_LAS float* P = (PG8_LAS float*)lds;
        float rs[8];
        { f32x4 s0[8], s1[8];
#pragma unroll
          for (int it = 0; it < 8; ++it) { const int row = u.pm * BM + (it >> 2) * HALF + wr * 64 + (it & 3) * 16 + fr; s0[it] = *(const f32x4*)(WSF(WS_SSQ + SSQ_Q) + (size_t)row * 8); s1[it] = *(const f32x4*)(WSF(WS_SSQ + SSQ_Q) + (size_t)row * 8 + 4); }
#pragma unroll
          for (int it = 0; it < 8; ++it) rs[it] = rsqrtf((((s0[it][0] + s0[it][1]) + (s0[it][2] + s0[it][3])) + ((s1[it][0] + s1[it][1]) + (s1[it][2] + s1[it][3]))) * (1.0f / 384.0f) + EPS_RMS); }
        const float* gq = WSF(WS_TAB + TAB_GAIN) + l * GN_STRIDE + GN_MQ;
        f32x4 g0, g1, cs[4], sn[4];
        if (wc < 2) { g0 = *(const f32x4*)(gq + wc * 32 + 8 * fq); g1 = *(const f32x4*)(gq + wc * 32 + 8 * fq + 4); }
        else { g0 = *(const f32x4*)(gq + 64 + 4 * fq); g1 = *(const f32x4*)(gq + 80 + 4 * fq); }
#pragma unroll
        for (int it = 0; it < 8; ++it) {
            const int ai = it >> 2, m = it & 3, rl = ai * HALF + wr * 64 + m * 16 + fr;
#pragma unroll
            for (int bj = 0; bj < 2; ++bj) {
                acc[ai][bj][m][0] = acc[ai][bj][m][0] * rs[it]; acc[ai][bj][m][1] = acc[ai][bj][m][1] * rs[it];
                const float ss = qsum(dot4(acc[ai][bj][m][0]) + dot4(acc[ai][bj][m][1]));
                if (fq == 0) P[(rl * 2 + bj) * 4 + wc] = ss;
            }
        }
        EPI_BAR();
        bf16_t* qa = WSH(WS_QKV + QA);
        if (wc < 3) {
#pragma unroll
            for (int it = 0; it < 8; ++it) {
                const int ai = it >> 2, m = it & 3, rl = ai * HALF + wr * 64 + m * 16 + fr, row = u.pm * BM + rl, b = row >> 11, s = row & 2047;
                if (m == 0 && wc == 2) {
#pragma unroll
                    for (int q = 0; q < 4; ++q) { const int sq_ = (u.pm * BM + ai * HALF + wr * 64 + q * 16 + fr) & 2047;
                        cs[q] = *(const f32x4*)(WSF(WS_TAB + TAB_MLA_COS) + sq_ * 16 + 4 * fq); sn[q] = *(const f32x4*)(WSF(WS_TAB + TAB_MLA_SIN) + sq_ * 16 + 4 * fq); }
                }
#pragma unroll
                for (int bj = 0; bj < 2; ++bj) {
                    const f32x4 pp = *(const PG8_LAS f32x4*)(P + (rl * 2 + bj) * 4);
                    const float r = rsqrtf((pp[0] + pp[1] + pp[2]) * (1.0f / 96.0f) + EPS_RMS) * C2_MLA;
                    bf16_t* dst = qa + ((size_t)(b * 6 + 2 * u.pn + bj) * 2048 + s) * 96;
                    if (wc < 2) { const f32x4 y0 = acc[ai][bj][m][0] * g0 * r, y1 = acc[ai][bj][m][1] * g1 * r; u32x4 w_; w_.x = cvt_pk_bf16(y0[0], y0[1]); w_.y = cvt_pk_bf16(y0[2], y0[3]); w_.z = cvt_pk_bf16(y1[0], y1[1]); w_.w = cvt_pk_bf16(y1[2], y1[3]);
                        *(u32x4*)(dst + wc * 32 + 8 * fq) = w_; }
                    else { const f32x4 x1 = acc[ai][bj][m][0] * g0 * r, x2 = acc[ai][bj][m][1] * g1 * r;
                        st4(dst + 64 + 4 * fq, x1 * cs[m] - x2 * sn[m]); st4(dst + 80 + 4 * fq, x1 * sn[m] + x2 * cs[m]); }
                }
            }
        }
    }
};
struct EpiMlaKV {
    static constexpr bool PERM = false, AFTER_DRAIN = true, HAS_PRE = false, LDS_PRE = false;
    unsigned char* ws; unsigned char* hs; int l;
    __device__ __forceinline__ void fused(f32x4 (&acc)[2][2][4][2], const Unit& u, int wr, int wc, int fr, int fq, PG8_LAS unsigned char* lds, int wid, int lane) const {
        asm volatile("" : "+v"(fr), "+v"(fq), "+v"(lane));
        PG8_LAS float* P = (PG8_LAS float*)lds;
        float rs[8], skr[4];
        { f32x4 s0[8];
#pragma unroll
          for (int it = 0; it < 8; ++it) { const int row = u.pm * BM + (it >> 2) * HALF + wr * 64 + (it & 3) * 16 + fr; s0[it] = *(const f32x4*)(WSF(WS_SSQ + SSQ_KV) + (size_t)row * 4); }
#pragma unroll
          for (int it = 0; it < 8; ++it) rs[it] = rsqrtf(((s0[it][0] + s0[it][1]) + (s0[it][2] + s0[it][3])) * (1.0f / 256.0f) + EPS_RMS); }
        const float* gk = WSF(WS_TAB + TAB_GAIN) + l * GN_STRIDE + GN_MK;
        f32x4 g0, g1, gr0, gr1;
        g0 = *(const f32x4*)(gk + (wc & 1) * 32 + 8 * fq); g1 = *(const f32x4*)(gk + (wc & 1) * 32 + 8 * fq + 4);   gr0 = *(const f32x4*)(gk + 64 + 4 * fq); gr1 = *(const f32x4*)(gk + 80 + 4 * fq);
        f32x4 cs[4], sn[4]; u32x2 kr1[4], kr2[4];
#pragma unroll
        for (int it = 0; it < 8; ++it) {
            const int ai = it >> 2, m = it & 3, rl = ai * HALF + wr * 64 + m * 16 + fr;
#pragma unroll
            for (int bj = 0; bj < 2; ++bj) {
                acc[ai][bj][m][0] = acc[ai][bj][m][0] * rs[it]; acc[ai][bj][m][1] = acc[ai][bj][m][1] * rs[it];
                if (wc < 2) { const float ss = qsum(dot4(acc[ai][bj][m][0]) + dot4(acc[ai][bj][m][1])); if (fq == 0) P[(rl * 2 + bj) * 2 + wc] = ss; }
            }
        }
        EPI_BAR();
        bf16_t* ka = WSH(WS_QKV + KA); bf16_t* va = WSH(WS_QKV + VA);
#pragma unroll
        for (int it = 0; it < 8; ++it) {
            const int ai = it >> 2, m = it & 3, rl = ai * HALF + wr * 64 + m * 16 + fr, row = u.pm * BM + rl, b = row >> 11, s = row & 2047;
            if (m == 0 && wc < 2) {
#pragma unroll
                for (int q = 0; q < 4; ++q) { const int rq = u.pm * BM + ai * HALF + wr * 64 + q * 16 + fr, sq_ = rq & 2047;
                    cs[q] = *(const f32x4*)(WSF(WS_TAB + TAB_MLA_COS) + sq_ * 16 + 4 * fq); sn[q] = *(const f32x4*)(WSF(WS_TAB + TAB_MLA_SIN) + sq_ * 16 + 4 * fq);
                    kr1[q] = *(const u32x2*)(((bf16_t*)(hs + MIX_KR)) + (size_t)rq * 32 + 4 * fq); kr2[q] = *(const u32x2*)(((bf16_t*)(hs + MIX_KR)) + (size_t)rq * 32 + 16 + 4 * fq); skr[q] = WSF(WS_SSQ + SSQ_KR)[rq]; }
            }
#pragma unroll
            for (int bj = 0; bj < 2; ++bj) {
                const size_t hrow = (size_t)(b * 6 + 2 * u.pn + bj) * 2048 + s;
                if (wc < 2) {
                    const float r = rsqrtf((P[(rl * 2 + bj) * 2] + P[(rl * 2 + bj) * 2 + 1] + skr[m]) * (1.0f / 96.0f) + EPS_RMS);
                    bf16_t* dst = ka + hrow * 96;
                    { const f32x4 y0 = acc[ai][bj][m][0] * g0 * r, y1 = acc[ai][bj][m][1] * g1 * r; u32x4 w_; w_.x = cvt_pk_bf16(y0[0], y0[1]); w_.y = cvt_pk_bf16(y0[2], y0[3]); w_.z = cvt_pk_bf16(y1[0], y1[1]); w_.w = cvt_pk_bf16(y1[2], y1[3]);
                      *(u32x4*)(dst + wc * 32 + 8 * fq) = w_; }
                    if (wc == bj) {
                        const f32x4 x1 = bf4_to_f32(kr1[m]) * gr0 * r, x2 = bf4_to_f32(kr2[m]) * gr1 * r;
                        st4(dst + 64 + 4 * fq, x1 * cs[m] - x2 * sn[m]); st4(dst + 80 + 4 * fq, x1 * sn[m] + x2 * cs[m]);
                    }
                } else {
                    bf16_t* dst = va + hrow * 64;
                    { const f32x4 y0 = acc[ai][bj][m][0], y1 = acc[ai][bj][m][1]; u32x4 w_; w_.x = cvt_pk_bf16(y0[0], y0[1]); w_.y = cvt_pk_bf16(y0[2], y0[3]); w_.z = cvt_pk_bf16(y1[0], y1[1]); w_.w = cvt_pk_bf16(y1[2], y1[3]);
                      *(u32x4*)(dst + (wc - 2) * 32 + 8 * fq) = w_; }
                }
            }
        }
    }
};
struct EpiRes {
    static constexpr bool PERM = true, AFTER_DRAIN = true, HAS_PRE = false, LDS_PRE = false;
    float* out; unsigned char* ws; int final_;
    __device__ __forceinline__ void fused(f32x4 (&acc)[2][2][4][2], const Unit& u, int wr, int wc, int fr, int fq, PG8_LAS unsigned char* lds, int wid, int lane) const {
        asm volatile("" : "+v"(fr), "+v"(fq), "+v"(lane));
        PG8_LAS float* P = (PG8_LAS float*)lds;
        const int col0 = u.pn * BM + wc * 32 + 8 * fq;
#pragma unroll
        for (int ai = 0; ai < 2; ++ai) {
            u32x4 bs[4][2];
#pragma unroll
            for (int m = 0; m < 4; ++m) { const size_t off = (size_t)(u.pm * BM + ai * HALF + wr * 64 + m * 16 + fr) * 1024 + col0;
#pragma unroll
                for (int bj = 0; bj < 2; ++bj) bs[m][bj] = *(const u32x4*)(WSH(WS_XB) + off + bj * HALF); }
#pragma unroll
            for (int m = 0; m < 4; ++m) {
                const int rl = ai * HALF + wr * 64 + m * 16 + fr; const size_t off = (size_t)(u.pm * BM + rl) * 1024 + col0;
                float ss = 0.f;
#pragma unroll
                for (int bj = 0; bj < 2; ++bj) {
                    u32x2 lo; lo.x = bs[m][bj].x; lo.y = bs[m][bj].y; u32x2 hi2; hi2.x = bs[m][bj].z; hi2.y = bs[m][bj].w;
                    const f32x4 x0 = bf4_to_f32(lo) + acc[ai][bj][m][0], x1 = bf4_to_f32(hi2) + acc[ai][bj][m][1];
                    if (final_) { *(f32x4*)(out + off + bj * HALF) = x0; *(f32x4*)(out + off + bj * HALF + 4) = x1; }
                    else { u32x4 w; w.x = cvt_pk_bf16(x0[0], x0[1]); w.y = cvt_pk_bf16(x0[2], x0[3]); w.z = cvt_pk_bf16(x1[0], x1[1]); w.w = cvt_pk_bf16(x1[2], x1[3]); *(u32x4*)(WSH(WS_XB) + off + bj * HALF) = w; }
                    ss += dot4(x0) + dot4(x1); }
                ss = qsum(ss);
                if (fq == 0) P[rl * 4 + wc] = ss;
            }
            asm volatile("" ::: "memory");
        }
        EPI_BAR();
        const int t = wid * 64 + lane;
        if (t < 256 && !final_) { const f32x4 pp = *(const PG8_LAS f32x4*)(P + t * 4); WSF(WS_SSQ + SSQ_X)[(size_t)(u.pm * BM + t) * 4 + u.pn] = (pp[0] + pp[1]) + (pp[2] + pp[3]); }
    }
};
struct EpiSwiglu {
    static constexpr bool PERM = true, AFTER_DRAIN = false, HAS_PRE = true, LDS_PRE = false;
    unsigned char* ws;
    __device__ __forceinline__ void prefetch(const Unit& u, int wr, int fr, int fq, float (&pre)[8]) const {
#pragma unroll
        for (int it = 0; it < 8; ++it) { const int row = u.pm * BM + (it >> 2) * HALF + wr * 64 + (it & 3) * 16 + fr; const float* p = WSF(WS_SSQ + SSQ_X) + (size_t)row * 4 + fq;
            asm volatile("global_load_dword %0, %1, off" : "=v"(pre[it]) : "v"(p) : "memory"); }
    }
    __device__ __forceinline__ void operator()(const f32x4 (&acc)[2][2][4][2], const Unit& u, int wr, int wc, int fr, int fq, const float (&pre)[8]) const {
        asm volatile("" : "+v"(fr), "+v"(fq));
        const int col0 = u.pn * 128 + wc * 32 + 8 * fq;
        float rsv[8];
#pragma unroll
        for (int it = 0; it < 8; ++it) rsv[it] = rsqrtf(qsum(pre[it]) * (1.0f / 1024.0f) + EPS_RMS);
#pragma unroll
        for (int ai = 0; ai < 2; ++ai)
#pragma unroll
            for (int m = 0; m < 4; ++m) {
                const int row = u.pm * BM + ai * HALF + wr * 64 + m * 16 + fr;
                const float rs = rsv[ai * 4 + m];
                u32x4 w; unsigned wv[4];
                const float c1 = -LOG2E * rs, rs2 = rs * rs;
                f32x4 av[2];
#pragma unroll
                for (int n = 0; n < 2; ++n) { const f32x4 ga = acc[ai][0][m][n], ua = acc[ai][1][m][n];
                    const f32x4 t = ga * c1, p = ga * ua; f32x4 e;
#pragma unroll
                    for (int i = 0; i < 4; ++i) e[i] = __builtin_amdgcn_exp2f(t[i]);
                    const f32x4 d = e + 1.0f; f32x4 r;
#pragma unroll
                    for (int i = 0; i < 4; ++i) r[i] = __builtin_amdgcn_rcpf(d[i]);
                    av[n] = p * (r * rs2); }
#pragma unroll
                for (int n = 0; n < 2; ++n) { wv[2 * n] = cvt_pk_bf16(av[n][0], av[n][1]); wv[2 * n + 1] = cvt_pk_bf16(av[n][2], av[n][3]); }
                w.x = wv[0]; w.y = wv[1]; w.z = wv[2]; w.w = wv[3];
                *(u32x4*)(WSH(WS_QKV) + (size_t)row * 2816 + col0) = w;
            }
    }
};
template <class Epi, class Sched, bool ALIGN_EPI = false, bool SP2 = false>
__device__ __forceinline__ void gemm_phase(PG8_LAS unsigned char* lds, const Gemm g, const Sched& S, const Epi& E) {
    int tid_ = threadIdx.x; asm volatile("" : "+v"(tid_));
    const int tid = tid_, wid = __builtin_amdgcn_readfirstlane(tid >> 6), lane = tid & 63, wr = wid >> 2, wc = wid & 3, fr = lane & 15, fq = lane >> 4;
    const int K = g.K, nt = K / BK;
    unsigned voffA[2], voffB[2];
#pragma unroll
    for (int i = 0; i < 2; ++i) { int R, C; stage_rc(tid * 16 + i * 8192, R, C); const int Rb = Epi::PERM ? ((R & ~31) + perm32(R & 31)) : R;
        voffA[i] = (unsigned)(R * K + C) * 2u; voffB[i] = (unsigned)(Rb * K + C) * 2u; }
    const size_t kstep = (size_t)(BK * 2);
    const size_t hstep = (size_t)HALF * K * 2;
    const size_t tstep = 2 * hstep;
    const unsigned ldsw = (unsigned)wid * 1024u;
    const int aoff = lds_byte(wr * 64 + fr, fq * 8), boff = lds_byte(wc * 32 + fr, fq * 8);
#define PG8_SA(b, h) (((b) * 2 + (h)) * HTB)
#define PG8_SB(b, h) ((4 + (b) * 2 + (h)) * HTB)
#define PG8_STAGE(bufoff, gbase, voff) do { _Pragma("unroll") for (int _i = 0; _i < 2; ++_i) \
        __builtin_amdgcn_global_load_lds((const unsigned*)((const char*)(gbase) + (voff)[_i]), (PG8_LAS unsigned*)(lds + (bufoff) + ldsw + _i * 8192), 16, 0, 0); } while (0)
#define PG8_LDA(dst, b, h) do { _Pragma("unroll") for (int m = 0; m < 4; ++m) _Pragma("unroll") for (int k = 0; k < 2; ++k) dst[m][k] = *(const PG8_LAS bf16x8*)(lds + PG8_SA(b, h) + aoff + m * 2048 + k * 1024); } while (0)
#define PG8_LDB(dst, b, h) do { _Pragma("unroll") for (int n = 0; n < 2; ++n) _Pragma("unroll") for (int k = 0; k < 2; ++k) dst[n][k] = *(const PG8_LAS bf16x8*)(lds + PG8_SB(b, h) + boff + n * 2048 + k * 1024); } while (0)
#define PG8_MMA(ai, bj, At, Bt) do { __builtin_amdgcn_s_setprio(1); _Pragma("unroll") for (int m = 0; m < 4; ++m) _Pragma("unroll") for (int n = 0; n < 2; ++n) _Pragma("unroll") for (int k = 0; k < 2; ++k) \
        acc[ai][bj][m][n] = __builtin_amdgcn_mfma_f32_16x16x32_bf16(Bt[n][k], At[m][k], acc[ai][bj][m][n], 0, 0, 0); __builtin_amdgcn_s_setprio(0); } while (0)
#define PG8_WAIT_V(n) asm volatile("s_waitcnt vmcnt(" #n ")" ::: "memory")
#define PG8_WAIT_L(n) asm volatile("s_waitcnt lgkmcnt(" #n ")" ::: "memory")
#define PG8_BAR __builtin_amdgcn_s_barrier()
#define PG8_SCHED __builtin_amdgcn_sched_barrier(0)
    Unit cur, nxt; int ui = 0;
    if (!S.next(0, cur)) return;
    f32x4 acc[2][2][4][2];
#pragma unroll
    for (int a = 0; a < 2; ++a)
#pragma unroll
        for (int b = 0; b < 2; ++b)
#pragma unroll
            for (int m = 0; m < 4; ++m)
#pragma unroll
                for (int n = 0; n < 2; ++n) acc[a][b][m][n] = (f32x4){0.f, 0.f, 0.f, 0.f};
    bf16x8 At[4][2], B0[2][2], B1[2][2];
    const char* cA = (const char*)g.A + (size_t)cur.pm * tstep; const char* cB = (const char*)g.Bt + (size_t)cur.pn * tstep;
    S.a_ready(cur);
    float pre[8];
    if constexpr (Epi::HAS_PRE) E.prefetch(cur, wr, fr, fq, pre);
    if constexpr (Epi::LDS_PRE) E.stage_pre(cur, lds + STAGE_BYTES, wid, lane);
    if constexpr (SP2) {
        PG8_STAGE(PG8_SB(0, 0), cB, voffB); PG8_STAGE(PG8_SB(0, 1), cB + hstep, voffB); PG8_STAGE(PG8_SA(0, 0), cA, voffA); PG8_STAGE(PG8_SA(0, 1), cA + hstep, voffA);
        if (wr == 1) PG8_BAR;
        PG8_WAIT_V(2); PG8_BAR;
        PG8_STAGE(PG8_SB(1, 0), cB + kstep, voffB); PG8_STAGE(PG8_SA(1, 0), cA + kstep, voffA); PG8_STAGE(PG8_SB(1, 1), cB + hstep + kstep, voffB);
        PG8_WAIT_V(6); PG8_BAR;
    } else {
        PG8_STAGE(PG8_SB(0, 0), cB, voffB); PG8_STAGE(PG8_SA(0, 0), cA, voffA); PG8_STAGE(PG8_SB(0, 1), cB + hstep, voffB); PG8_STAGE(PG8_SA(0, 1), cA + hstep, voffA);
        if (wr == 1) PG8_BAR;
        PG8_WAIT_V(4); PG8_BAR;
        PG8_STAGE(PG8_SB(1, 0), cB + kstep, voffB); PG8_STAGE(PG8_SA(1, 0), cA + kstep, voffA); PG8_STAGE(PG8_SB(1, 1), cB + hstep + kstep, voffB);
        PG8_WAIT_V(6); PG8_BAR;
    }
    for (;;) {
        const bool has_next = S.next(ui + 1, nxt);
        const char* nA = has_next ? (const char*)g.A + (size_t)nxt.pm * tstep : cA; const char* nB = has_next ? (const char*)g.Bt + (size_t)nxt.pn * tstep : cB;
        for (int t = 0; t < nt; t += 2) {
            const bool last = (t == nt - 2);
            const char* a1 = cA + (size_t)(t + 1) * kstep;
            const char* a2 = last ? nA : cA + (size_t)(t + 2) * kstep; const char* b2 = last ? nB : cB + (size_t)(t + 2) * kstep;
            const char* a3 = a2 + kstep; const char* b3 = b2 + kstep;
            if (last && has_next) S.a_ready(nxt);
            if constexpr (SP2) {
            PG8_LDB(B0, 0, 0); PG8_LDB(B1, 0, 1); PG8_SCHED; PG8_LDA(At, 0, 0); PG8_STAGE(PG8_SA(1, 1), a1 + hstep, voffA);
            PG8_WAIT_V(8); PG8_WAIT_L(0); PG8_BAR; PG8_MMA(0, 0, At, B0); PG8_MMA(0, 1, At, B1); PG8_BAR; PG8_SCHED;
            PG8_LDA(At, 0, 1); PG8_STAGE(PG8_SB(0, 0), b2, voffB); PG8_STAGE(PG8_SB(0, 1), b2 + hstep, voffB); PG8_STAGE(PG8_SA(0, 0), a2, voffA);
            PG8_WAIT_V(8); PG8_WAIT_L(0); PG8_BAR; PG8_MMA(1, 0, At, B0); PG8_MMA(1, 1, At, B1); PG8_BAR; PG8_SCHED;
            PG8_LDB(B0, 1, 0); PG8_LDB(B1, 1, 1); PG8_SCHED; PG8_LDA(At, 1, 0); PG8_STAGE(PG8_SA(0, 1), a2 + hstep, voffA);
            PG8_WAIT_V(8); PG8_WAIT_L(0); PG8_BAR; PG8_MMA(0, 0, At, B0); PG8_MMA(0, 1, At, B1); PG8_BAR; PG8_SCHED;
            PG8_LDA(At, 1, 1); PG8_STAGE(PG8_SB(1, 0), b3, voffB); PG8_STAGE(PG8_SB(1, 1), b3 + hstep, voffB); PG8_STAGE(PG8_SA(1, 0), a3, voffA);
            PG8_WAIT_V(8); PG8_WAIT_L(0); PG8_BAR; PG8_MMA(1, 0, At, B0); PG8_MMA(1, 1, At, B1); PG8_BAR; PG8_SCHED;
            } else {
            PG8_LDB(B0, 0, 0); PG8_SCHED; PG8_LDA(At, 0, 0); PG8_STAGE(PG8_SA(1, 1), a1 + hstep, voffA);
            PG8_WAIT_L(8); PG8_BAR; PG8_WAIT_L(0); PG8_MMA(0, 0, At, B0); PG8_BAR; PG8_SCHED;
            PG8_LDB(B1, 0, 1); PG8_STAGE(PG8_SB(0, 0), b2, voffB);
            PG8_BAR; PG8_WAIT_L(0); PG8_MMA(0, 1, At, B1); PG8_BAR;
            PG8_LDA(At, 0, 1); PG8_STAGE(PG8_SA(0, 0), a2, voffA);
            PG8_BAR; PG8_WAIT_L(0); PG8_MMA(1, 0, At, B0); PG8_BAR; PG8_SCHED;
            PG8_STAGE(PG8_SB(0, 1), b2 + hstep, voffB);
            PG8_WAIT_V(6); PG8_BAR; PG8_MMA(1, 1, At, B1); PG8_BAR;
            PG8_LDB(B0, 1, 0); PG8_SCHED; PG8_LDA(At, 1, 0); PG8_STAGE(PG8_SA(0, 1), a2 + hstep, voffA);
            PG8_WAIT_L(8); PG8_BAR; PG8_WAIT_L(0); PG8_MMA(0, 0, At, B0); PG8_BAR; PG8_SCHED;
            PG8_LDB(B1, 1, 1); PG8_STAGE(PG8_SB(1, 0), b3, voffB);
            PG8_BAR; PG8_WAIT_L(0); PG8_MMA(0, 1, At, B1); PG8_BAR;
            PG8_LDA(At, 1, 1); PG8_STAGE(PG8_SA(1, 0), a3, voffA);
            PG8_BAR; PG8_WAIT_L(0); PG8_MMA(1, 0, At, B0); PG8_BAR; PG8_SCHED;
            PG8_STAGE(PG8_SB(1, 1), b3 + hstep, voffB);
            PG8_WAIT_V(6); PG8_BAR; PG8_MMA(1, 1, At, B1); PG8_BAR;
            }
        }
        if constexpr (ALIGN_EPI) { if (wr == 0) PG8_BAR; }
        if constexpr (!Epi::AFTER_DRAIN) { if constexpr (Epi::HAS_PRE) E(acc, cur, wr, wc, fr, fq, pre); else if constexpr (Epi::LDS_PRE) E(acc, cur, wr, wc, fr, fq, lds + STAGE_BYTES + (ui & 1) * 4096); else E(acc, cur, wr, wc, fr, fq); S.done(cur); }
        if (!has_next) break;
#pragma unroll
        for (int a = 0; a < 2; ++a)
#pragma unroll
            for (int b = 0; b < 2; ++b)
#pragma unroll
                for (int m = 0; m < 4; ++m)
#pragma unroll
                    for (int n = 0; n < 2; ++n) acc[a][b][m][n] = (f32x4){0.f, 0.f, 0.f, 0.f};
        cur = nxt; cA = nA; cB = nB; ++ui;
        if constexpr (Epi::HAS_PRE) E.prefetch(cur, wr, fr, fq, pre);
        if constexpr (Epi::LDS_PRE) E.stage_pre(cur, lds + STAGE_BYTES + (ui & 1) * 4096, wid, lane);
        if constexpr (ALIGN_EPI) { if (wr == 1) PG8_BAR; }
    }
    PG8_WAIT_V(0);
    if constexpr (!ALIGN_EPI) { if (wr == 0) PG8_BAR; }
    PG8_BAR;
    if constexpr (Epi::AFTER_DRAIN) { E.fused(acc, cur, wr, wc, fr, fq, lds, wid, lane); S.done(cur); }
#undef PG8_SA
#undef PG8_SB
#undef PG8_STAGE
#undef PG8_LDA
#undef PG8_LDB
#undef PG8_MMA
#undef PG8_WAIT_V
#undef PG8_WAIT_L
#undef PG8_BAR
#undef PG8_SCHED
}
}
namespace att {
#ifndef ATT_DIAG
#define ATT_DIAG 0
#endif
#if ATT_DIAG
__device__ __forceinline__ unsigned long long diag_now() { unsigned long long t; asm volatile("s_memtime %0\n\ts_waitcnt lgkmcnt(0)" : "=s"(t) :: "memory"); return t; }
#define ATT_T(x) const unsigned long long x = diag_now()
#define ATT_ACC(i, a, b) dacc[i] += (b) - (a)
#else
#define ATT_T(x)
#define ATT_ACC(i, a, b)
#endif
typedef unsigned short bf16_t;
using bf16x8 = __attribute__((ext_vector_type(8))) short;
using s16x4 = __attribute__((ext_vector_type(4))) short;
using f32x16 = __attribute__((ext_vector_type(16))) float;
using u32x4 = __attribute__((ext_vector_type(4))) unsigned;
#ifndef ATT_RSV
#define ATT_RSV 1
#endif
#define ATT_SBAR() __builtin_amdgcn_sched_barrier(0)
__device__ __forceinline__ int crow(int r, int hi) { return (r & 3) + 8 * (r >> 2) + 4 * hi; }
__device__ __forceinline__ unsigned cvtpk(float lo, float hi) { unsigned r; asm volatile("v_cvt_pk_bf16_f32 %0, %1, %2" : "=v"(r) : "v"(lo), "v"(hi)); return r; }
__device__ __forceinline__ void glds16(const void* gsrc, unsigned lds_dst) { unsigned keep;
    asm volatile("s_mov_b32 %0, m0\n\ts_mov_b32 m0, %2\n\ts_nop 0\n\tglobal_load_lds_dwordx4 %1, off\n\ts_mov_b32 m0, %0" : "=&s"(keep) : "v"(gsrc), "s"(lds_dst) : "memory"); }
template <int NB> __device__ __forceinline__ int v_st(int k, int c) { const int kk = k; return ((kk >> 3) * NB + (c >> 5)) * 512 + ((kk & 7) * 32 + (c & 31)) * 2; }
__device__ __forceinline__ int v_rd_base(int lane) { return ((lane & 3) << 3) | (((lane >> 2) & 3) << 6) | (((lane >> 4) & 1) << 5) | (((lane >> 5) & 1) << 8); }
template <int OFF> __device__ __forceinline__ s16x4 tr_read(int vb) { s16x4 r; asm volatile("ds_read_b64_tr_b16 %0, %1 offset:%2" : "=&v"(r) : "v"(vb), "i"(OFF) : "memory"); return r; }
template <int I> __device__ __forceinline__ void exp1(f32x16& p0, f32x16& p1) { if constexpr (I < 16) p0[I] = __builtin_amdgcn_exp2f(p0[I]); else p1[I - 16] = __builtin_amdgcn_exp2f(p1[I - 16]); }
template <int NB, int C> __device__ __forceinline__ void exp_chunk(f32x16& p0, f32x16& p1) {
    constexpr int N = 32 / (4 * NB);
    exp1<C * N>(p0, p1); exp1<C * N + 1>(p0, p1);
    if constexpr (N == 4) { exp1<C * N + 2>(p0, p1); exp1<C * N + 3>(p0, p1); }
}
template <int I> __device__ __forceinline__ void exp3(f32x16& p0, f32x16& p1) { exp1<I>(p0, p1); exp1<I + 1>(p0, p1); exp1<I + 2>(p0, p1); }
template <int I> __device__ __forceinline__ void exp4(f32x16& p0, f32x16& p1) { exp1<I>(p0, p1); exp1<I + 1>(p0, p1); exp1<I + 2>(p0, p1); exp1<I + 3>(p0, p1); }
struct VF { s16x4 l0, h0, l1, h1, l2, h2, l3, h3; };
template <int NB, int D0> __device__ __forceinline__ void v_read(VF& f, int vb) {
    f.l0 = tr_read<(0 * NB + D0) * 512>(vb); f.h0 = tr_read<(1 * NB + D0) * 512>(vb); f.l1 = tr_read<(2 * NB + D0) * 512>(vb); f.h1 = tr_read<(3 * NB + D0) * 512>(vb);
    f.l2 = tr_read<(4 * NB + D0) * 512>(vb); f.h2 = tr_read<(5 * NB + D0) * 512>(vb); f.l3 = tr_read<(6 * NB + D0) * 512>(vb); f.h3 = tr_read<(7 * NB + D0) * 512>(vb);
}
#define ATT_PIN2(a, b) asm volatile("" : "+v"(a), "+v"(b))
template <int NB, int D0, bool EXP, int PROBE = 0> __device__ __forceinline__ void pv_mm(f32x16& od, f32x16& lacc, const VF& f, bf16x8 pa0, bf16x8 pa1, bf16x8 pa2, bf16x8 pa3, f32x16& p0, f32x16& p1) {
    const bf16x8 ones = {16256, 16256, 16256, 16256, 16256, 16256, 16256, 16256};
#define ATT_PK(L, H) (bf16x8){L[0], L[1], L[2], L[3], H[0], H[1], H[2], H[3]}
    if constexpr (PROBE != 3) od = __builtin_amdgcn_mfma_f32_32x32x16_bf16(pa0, ATT_PK(f.l0, f.h0), od, 0, 0, 0); if constexpr (D0 == 0 && !ATT_RSV) lacc = __builtin_amdgcn_mfma_f32_32x32x16_bf16(pa0, ones, lacc, 0, 0, 0); if constexpr (EXP) { if constexpr (PROBE != 2) exp_chunk<NB, D0 * 4 + 0>(p0, p1); ATT_PIN2(p0, p1); ATT_SBAR(); }
    if constexpr (PROBE != 3) od = __builtin_amdgcn_mfma_f32_32x32x16_bf16(pa1, ATT_PK(f.l1, f.h1), od, 0, 0, 0); if constexpr (D0 == 0 && !ATT_RSV) lacc = __builtin_amdgcn_mfma_f32_32x32x16_bf16(pa1, ones, lacc, 0, 0, 0); if constexpr (EXP) { if constexpr (PROBE != 2) exp_chunk<NB, D0 * 4 + 1>(p0, p1); ATT_PIN2(p0, p1); ATT_SBAR(); }
    if constexpr (PROBE != 3) od = __builtin_amdgcn_mfma_f32_32x32x16_bf16(pa2, ATT_PK(f.l2, f.h2), od, 0, 0, 0); if constexpr (D0 == 0 && !ATT_RSV) lacc = __builtin_amdgcn_mfma_f32_32x32x16_bf16(pa2, ones, lacc, 0, 0, 0); if constexpr (EXP) { if constexpr (PROBE != 2) exp_chunk<NB, D0 * 4 + 2>(p0, p1); ATT_PIN2(p0, p1); ATT_SBAR(); }
    if constexpr (PROBE != 3) od = __builtin_amdgcn_mfma_f32_32x32x16_bf16(pa3, ATT_PK(f.l3, f.h3), od, 0, 0, 0); if constexpr (D0 == 0 && !ATT_RSV) lacc = __builtin_amdgcn_mfma_f32_32x32x16_bf16(pa3, ones, lacc, 0, 0, 0); if constexpr (EXP) { if constexpr (PROBE != 2) exp_chunk<NB, D0 * 4 + 3>(p0, p1); ATT_PIN2(p0, p1); ATT_SBAR(); }
#undef ATT_PK
}
#define ATT_LGKM(n) do { asm volatile("s_waitcnt lgkmcnt(" #n ")" ::: "memory"); ATT_SBAR(); } while (0)
#ifndef ATT_NEWK
#define ATT_NEWK 1
#endif
#ifndef ATT_XSPLIT
#define ATT_XSPLIT 1
#endif
#ifndef ATT_DLATE
#define ATT_DLATE 1
#endif
#ifndef ATT_ALT4
#define ATT_ALT4 1
#endif
#ifndef ATT_ALT
#define ATT_ALT 1
#endif
template <bool EXP> __device__ __forceinline__ void pv_alt(f32x16* o, int vb, bf16x8 pa0, bf16x8 pa1, bf16x8 pa2, bf16x8 pa3, f32x16& p0, f32x16& p1) {
    ATT_SBAR();
    const s16x4 a0l = tr_read<0 * 512>(vb), a0h = tr_read<2 * 512>(vb), b0l = tr_read<1 * 512>(vb), b0h = tr_read<3 * 512>(vb);
    const s16x4 a1l = tr_read<4 * 512>(vb), a1h = tr_read<6 * 512>(vb), b1l = tr_read<5 * 512>(vb), b1h = tr_read<7 * 512>(vb);
    const s16x4 a2l = tr_read<8 * 512>(vb), a2h = tr_read<10 * 512>(vb), b2l = tr_read<9 * 512>(vb), b2h = tr_read<11 * 512>(vb);
    const s16x4 a3l = tr_read<12 * 512>(vb), a3h = tr_read<14 * 512>(vb), b3l = tr_read<13 * 512>(vb), b3h = tr_read<15 * 512>(vb);
#define ATT_PK(L, H) (bf16x8){L[0], L[1], L[2], L[3], H[0], H[1], H[2], H[3]}
#define ATT_ALT2(PA, AL, AH, BL, BH, C) do { \
    o[0] = __builtin_amdgcn_mfma_f32_32x32x16_bf16(PA, ATT_PK(AL, AH), o[0], 0, 0, 0); if constexpr (EXP) { exp_chunk<2, C>(p0, p1); ATT_PIN2(p0, p1); ATT_SBAR(); } \
    o[1] = __builtin_amdgcn_mfma_f32_32x32x16_bf16(PA, ATT_PK(BL, BH), o[1], 0, 0, 0); if constexpr (EXP) { exp_chunk<2, C + 1>(p0, p1); ATT_PIN2(p0, p1); ATT_SBAR(); } } while (0)
    ATT_LGKM(12); ATT_ALT2(pa0, a0l, a0h, b0l, b0h, 0);
    ATT_LGKM(8);  ATT_ALT2(pa1, a1l, a1h, b1l, b1h, 2);
    ATT_LGKM(4);  ATT_ALT2(pa2, a2l, a2h, b2l, b2h, 4);
    ATT_LGKM(0);  ATT_ALT2(pa3, a3l, a3h, b3l, b3h, 6);
#undef ATT_ALT2
#undef ATT_PK
}
template <int OFF> __device__ __forceinline__ bf16x8 kr_read(int ka) { bf16x8 r; asm volatile("ds_read_b128 %0, %1 offset:%2" : "=&v"(r) : "v"(ka), "i"(OFF) : "memory"); return r; }
template <int KP, int G> __device__ __forceinline__ void k_read_grp(bf16x8* kf, int ka) {
    kf[4 * G] = kr_read<64 * G>(ka); kf[4 * G + 1] = kr_read<32 * KP + 64 * G>(ka); kf[4 * G + 2] = kr_read<64 * G + 32>(ka); kf[4 * G + 3] = kr_read<32 * KP + 64 * G + 32>(ka);
}
template <int NQ> __device__ __forceinline__ void k_pin(bf16x8* kf) {
    asm volatile("" : "+v"(kf[0]), "+v"(kf[1]), "+v"(kf[2]), "+v"(kf[3]), "+v"(kf[4]), "+v"(kf[5]), "+v"(kf[6]), "+v"(kf[7]));
    if constexpr (NQ == 6) asm volatile("" : "+v"(kf[8]), "+v"(kf[9]), "+v"(kf[10]), "+v"(kf[11]));
}
template <bool EXP, int KP, int NKG, bool XS = false> __device__ __forceinline__ void pv_alt_k(f32x16* o, int vb, bf16x8 pa0, bf16x8 pa1, bf16x8 pa2, bf16x8 pa3, f32x16& p0, f32x16& p1, bf16x8* kf, int ka) {
    ATT_SBAR();
    const s16x4 a0l = tr_read<0 * 512>(vb), a0h = tr_read<2 * 512>(vb), b0l = tr_read<1 * 512>(vb), b0h = tr_read<3 * 512>(vb);
    const s16x4 a1l = tr_read<4 * 512>(vb), a1h = tr_read<6 * 512>(vb), b1l = tr_read<5 * 512>(vb), b1h = tr_read<7 * 512>(vb);
    const s16x4 a2l = tr_read<8 * 512>(vb), a2h = tr_read<10 * 512>(vb), b2l = tr_read<9 * 512>(vb), b2h = tr_read<11 * 512>(vb);
    const s16x4 a3l = tr_read<12 * 512>(vb), a3h = tr_read<14 * 512>(vb), b3l = tr_read<13 * 512>(vb), b3h = tr_read<15 * 512>(vb);
#define ATT_PK(L, H) (bf16x8){L[0], L[1], L[2], L[3], H[0], H[1], H[2], H[3]}
#define ATT_ALT2(PA, AL, AH, BL, BH, C) do { \
    o[0] = __builtin_amdgcn_mfma_f32_32x32x16_bf16(PA, ATT_PK(AL, AH), o[0], 0, 0, 0); if constexpr (EXP) { if constexpr (XS) exp3<3 * (C)>(p0, p1); else exp_chunk<2, C>(p0, p1); ATT_PIN2(p0, p1); ATT_SBAR(); } \
    o[1] = __builtin_amdgcn_mfma_f32_32x32x16_bf16(PA, ATT_PK(BL, BH), o[1], 0, 0, 0); if constexpr (EXP) { if constexpr (XS) exp3<3 * (C) + 3>(p0, p1); else exp_chunk<2, C + 1>(p0, p1); ATT_PIN2(p0, p1); ATT_SBAR(); } } while (0)
    ATT_LGKM(12); ATT_ALT2(pa0, a0l, a0h, b0l, b0h, 0); if constexpr (NKG > 0) { ATT_SBAR(); k_read_grp<KP, 0>(kf, ka); ATT_SBAR(); }
    if constexpr (NKG == 0) ATT_LGKM(8); else ATT_LGKM(12);
    ATT_ALT2(pa1, a1l, a1h, b1l, b1h, 2); if constexpr (NKG > 1) { ATT_SBAR(); k_read_grp<KP, 1>(kf, ka); ATT_SBAR(); }
    if constexpr (NKG == 0) ATT_LGKM(4); else ATT_LGKM(12);
    ATT_ALT2(pa2, a2l, a2h, b2l, b2h, 4); if constexpr (NKG > 2) { ATT_SBAR(); k_read_grp<KP, 2>(kf, ka); ATT_SBAR(); }
    if constexpr (NKG == 0) ATT_LGKM(0); else if constexpr (NKG == 2) ATT_LGKM(8); else ATT_LGKM(12);
    ATT_ALT2(pa3, a3l, a3h, b3l, b3h, 6);
#undef ATT_ALT2
#undef ATT_PK
}
template <bool EXP> __device__ __forceinline__ void pv_alt4(f32x16* o, int vb, bf16x8 pa0, bf16x8 pa1, bf16x8 pa2, bf16x8 pa3, f32x16& p0, f32x16& p1) {
    ATT_SBAR();
#define ATT_RD(I, D, L, H) const s16x4 L = tr_read<((2 * I) * 4 + D) * 512>(vb), H = tr_read<((2 * I + 1) * 4 + D) * 512>(vb)
    ATT_RD(0, 0, a0l, a0h); ATT_RD(0, 1, b0l, b0h); ATT_RD(1, 0, a1l, a1h); ATT_RD(1, 1, b1l, b1h); ATT_RD(2, 0, a2l, a2h); ATT_RD(2, 1, b2l, b2h); ATT_RD(3, 0, a3l, a3h); ATT_RD(3, 1, b3l, b3h);
#define ATT_PK(L, H) (bf16x8){L[0], L[1], L[2], L[3], H[0], H[1], H[2], H[3]}
#define ATT_ALT2(OA, OB, PA, AL, AH, BL, BH, C) do { \
    OA = __builtin_amdgcn_mfma_f32_32x32x16_bf16(PA, ATT_PK(AL, AH), OA, 0, 0, 0); if constexpr (EXP) { exp_chunk<4, C>(p0, p1); ATT_PIN2(p0, p1); ATT_SBAR(); } \
    OB = __builtin_amdgcn_mfma_f32_32x32x16_bf16(PA, ATT_PK(BL, BH), OB, 0, 0, 0); if constexpr (EXP) { exp_chunk<4, C + 1>(p0, p1); ATT_PIN2(p0, p1); ATT_SBAR(); } } while (0)
    ATT_LGKM(12); ATT_ALT2(o[0], o[1], pa0, a0l, a0h, b0l, b0h, 0); ATT_SBAR(); ATT_RD(0, 2, c0l, c0h); ATT_RD(0, 3, d0l, d0h);
    ATT_LGKM(12); ATT_ALT2(o[0], o[1], pa1, a1l, a1h, b1l, b1h, 2); ATT_SBAR(); ATT_RD(1, 2, c1l, c1h); ATT_RD(1, 3, d1l, d1h);
    ATT_LGKM(12); ATT_ALT2(o[0], o[1], pa2, a2l, a2h, b2l, b2h, 4); ATT_SBAR(); ATT_RD(2, 2, c2l, c2h); ATT_RD(2, 3, d2l, d2h);
    ATT_LGKM(12); ATT_ALT2(o[0], o[1], pa3, a3l, a3h, b3l, b3h, 6); ATT_SBAR(); ATT_RD(3, 2, c3l, c3h); ATT_RD(3, 3, d3l, d3h);
    ATT_LGKM(12); ATT_ALT2(o[2], o[3], pa0, c0l, c0h, d0l, d0h, 8);
    ATT_LGKM(8);  ATT_ALT2(o[2], o[3], pa1, c1l, c1h, d1l, d1h, 10);
    ATT_LGKM(4);  ATT_ALT2(o[2], o[3], pa2, c2l, c2h, d2l, d2h, 12);
    ATT_LGKM(0);  ATT_ALT2(o[2], o[3], pa3, c3l, c3h, d3l, d3h, 14);
#undef ATT_ALT2
#undef ATT_PK
#undef ATT_RD
}
template <bool EXP, class F> __device__ __forceinline__ void pv_alt4_d(f32x16* o, int vb, bf16x8 pa0, bf16x8 pa1, bf16x8 pa2, bf16x8 pa3, f32x16& p0, f32x16& p1, const F& dma) {
    ATT_SBAR();
#define ATT_RD(I, D, L, H) const s16x4 L = tr_read<((2 * I) * 4 + D) * 512>(vb), H = tr_read<((2 * I + 1) * 4 + D) * 512>(vb)
    ATT_RD(0, 0, a0l, a0h); ATT_RD(0, 1, b0l, b0h); ATT_RD(1, 0, a1l, a1h); ATT_RD(1, 1, b1l, b1h); ATT_RD(2, 0, a2l, a2h); ATT_RD(2, 1, b2l, b2h); ATT_RD(3, 0, a3l, a3h); ATT_RD(3, 1, b3l, b3h);
#define ATT_PK(L, H) (bf16x8){L[0], L[1], L[2], L[3], H[0], H[1], H[2], H[3]}
#define ATT_ALT2(OA, OB, PA, AL, AH, BL, BH, C) do { \
    OA = __builtin_amdgcn_mfma_f32_32x32x16_bf16(PA, ATT_PK(AL, AH), OA, 0, 0, 0); if constexpr (EXP) { exp_chunk<4, C>(p0, p1); ATT_PIN2(p0, p1); ATT_SBAR(); } \
    OB = __builtin_amdgcn_mfma_f32_32x32x16_bf16(PA, ATT_PK(BL, BH), OB, 0, 0, 0); if constexpr (EXP) { exp_chunk<4, C + 1>(p0, p1); ATT_PIN2(p0, p1); ATT_SBAR(); } } while (0)
    ATT_LGKM(12); ATT_ALT2(o[0], o[1], pa0, a0l, a0h, b0l, b0h, 0); ATT_SBAR(); ATT_RD(0, 2, c0l, c0h); ATT_RD(0, 3, d0l, d0h);
    ATT_LGKM(12); ATT_ALT2(o[0], o[1], pa1, a1l, a1h, b1l, b1h, 2); ATT_SBAR(); ATT_RD(1, 2, c1l, c1h); ATT_RD(1, 3, d1l, d1h);
    ATT_LGKM(12); ATT_ALT2(o[0], o[1], pa2, a2l, a2h, b2l, b2h, 4); ATT_SBAR(); ATT_RD(2, 2, c2l, c2h); ATT_RD(2, 3, d2l, d2h);
    ATT_LGKM(12); ATT_ALT2(o[0], o[1], pa3, a3l, a3h, b3l, b3h, 6); ATT_SBAR(); ATT_RD(3, 2, c3l, c3h); ATT_RD(3, 3, d3l, d3h);
    ATT_LGKM(12); ATT_ALT2(o[2], o[3], pa0, c0l, c0h, d0l, d0h, 8);  dma(0); dma(1); ATT_SBAR();
    ATT_LGKM(8);  ATT_ALT2(o[2], o[3], pa1, c1l, c1h, d1l, d1h, 10); dma(2); dma(3); ATT_SBAR();
    ATT_LGKM(4);  ATT_ALT2(o[2], o[3], pa2, c2l, c2h, d2l, d2h, 12); dma(4); ATT_SBAR();
    ATT_LGKM(0);  ATT_ALT2(o[2], o[3], pa3, c3l, c3h, d3l, d3h, 14);
#undef ATT_ALT2
#undef ATT_PK
#undef ATT_RD
}
template <int NB, bool EXP, int PROBE = 0, bool PRE = false> __device__ __forceinline__ void pv_all(f32x16* o, f32x16& lacc, int vb, bf16x8 pa0, bf16x8 pa1, bf16x8 pa2, bf16x8 pa3, f32x16& p0, f32x16& p1, VF& fa, VF& fb) {
    if constexpr (!PRE) { ATT_SBAR(); v_read<NB, 0>(fa, vb); v_read<NB, 1>(fb, vb); ATT_LGKM(8); }
    else { ATT_LGKM(0); }
    pv_mm<NB, 0, EXP, PROBE>(o[0], lacc, fa, pa0, pa1, pa2, pa3, p0, p1);
    if constexpr (NB == 2) { if constexpr (!PRE) ATT_LGKM(0); pv_mm<NB, 1, EXP, PROBE>(o[1], lacc, fb, pa0, pa1, pa2, pa3, p0, p1); }
    else {
        ATT_SBAR(); v_read<NB, 2>(fa, vb); ATT_LGKM(8); pv_mm<NB, 1, EXP, PROBE>(o[1], lacc, fb, pa0, pa1, pa2, pa3, p0, p1);
        ATT_SBAR(); v_read<NB, 3>(fb, vb); ATT_LGKM(8); pv_mm<NB, 2, EXP, PROBE>(o[2], lacc, fa, pa0, pa1, pa2, pa3, p0, p1);
        ATT_LGKM(0); pv_mm<NB, 3, EXP, PROBE>(o[3], lacc, fb, pa0, pa1, pa2, pa3, p0, p1);
    }
}
template <int NQ, int KP> __device__ __forceinline__ void k_read(bf16x8* kf, const char* Ks, int koffB, int r32, int hi) {
#pragma unroll
    for (int d0 = 0; d0 < NQ; ++d0) { const int cb = koffB + (d0 * 16 + hi * 8) * 2;
        kf[2 * d0] = *reinterpret_cast<const bf16x8*>(Ks + r32 * KP + cb); kf[2 * d0 + 1] = *reinterpret_cast<const bf16x8*>(Ks + (32 + r32) * KP + cb); }
}
template <int NQ, int KP, int PROBE = 0> __device__ __forceinline__ void qkt(f32x16& p0, f32x16& p1, const char* Ks, int koffB, const bf16x8* qr, int r32, int hi) {
    bf16x8 kf[2 * NQ]; k_read<NQ, KP>(kf, Ks, koffB, r32, hi);
    if constexpr (PROBE == 4) { _Pragma("unroll") for (int i = 0; i < 2 * NQ; ++i) asm volatile("" :: "v"(kf[i])); p0 = f32x16{}; p1 = f32x16{}; return; }
#pragma unroll
    for (int d0 = 0; d0 < NQ; ++d0) {
        if (d0 == 0) { p0 = __builtin_amdgcn_mfma_f32_32x32x16_bf16(kf[0], qr[0], f32x16{}, 0, 0, 0); p1 = __builtin_amdgcn_mfma_f32_32x32x16_bf16(kf[1], qr[0], f32x16{}, 0, 0, 0); }
        else { p0 = __builtin_amdgcn_mfma_f32_32x32x16_bf16(kf[2 * d0], qr[d0], p0, 0, 0, 0); p1 = __builtin_amdgcn_mfma_f32_32x32x16_bf16(kf[2 * d0 + 1], qr[d0], p1, 0, 0, 0); } }
}
__device__ __forceinline__ void add_bias(f32x16& p0, f32x16& p1, float nb) {
#pragma unroll
    for (int r = 0; r < 16; ++r) { p0[r] += nb; p1[r] += nb; }
}
__device__ __forceinline__ void exp_all(f32x16& p0, f32x16& p1) {
#pragma unroll
    for (int r = 0; r < 16; ++r) { p0[r] = __builtin_amdgcn_exp2f(p0[r]); p1[r] = __builtin_amdgcn_exp2f(p1[r]); }
}
struct RS { float a, b, c, d; };
template <int I> __device__ __forceinline__ void rs_add1(RS& l, const f32x16& p0, const f32x16& p1) {
    const float x = (I < 16) ? p0[I & 15] : p1[I & 15];
    if constexpr ((I & 3) == 0) asm volatile("v_add_f32 %0, %0, %1" : "+v"(l.a) : "v"(x));
    else if constexpr ((I & 3) == 1) asm volatile("v_add_f32 %0, %0, %1" : "+v"(l.b) : "v"(x));
    else if constexpr ((I & 3) == 2) asm volatile("v_add_f32 %0, %0, %1" : "+v"(l.c) : "v"(x));
    else asm volatile("v_add_f32 %0, %0, %1" : "+v"(l.d) : "v"(x));
}
template <int I0, int I1> __device__ __forceinline__ void rs_adds(RS& l, const f32x16& p0, const f32x16& p1) {
    if constexpr (ATT_RSV && I0 < I1) { rs_add1<I0>(l, p0, p1); rs_adds<I0 + 1, I1>(l, p0, p1); }
}
template <int NQ, int G> __device__ __forceinline__ void rs_group(RS& l, const f32x16& p0, const f32x16& p1) {
    if constexpr (NQ == 4) rs_adds<8 * G, 8 * G + 8>(l, p0, p1);
    else { constexpr int S = (G < 2) ? 6 * G : 12 + 5 * (G - 2), N = (G < 2) ? 6 : 5; rs_adds<S, S + N>(l, p0, p1); }
}
__device__ __forceinline__ void sum_pack(const f32x16& p0, const f32x16& p1, bf16x8& pa0, bf16x8& pa1, bf16x8& pa2, bf16x8& pa3, RS& l) {
    rs_adds<0, 32>(l, p0, p1);
#define ATT_PK4(P, BASE, OUT) do { u32x4 w = {cvtpk(P[BASE + 0], P[BASE + 1]), cvtpk(P[BASE + 2], P[BASE + 3]), cvtpk(P[BASE + 4], P[BASE + 5]), cvtpk(P[BASE + 6], P[BASE + 7])}; \
    OUT = *reinterpret_cast<bf16x8*>(&w); } while (0)
    ATT_PK4(p0, 0, pa0); ATT_PK4(p0, 8, pa1); ATT_PK4(p1, 0, pa2); ATT_PK4(p1, 8, pa3);
#undef ATT_PK4
}

#define ATT_PK4(P, BASE, OUT) do { u32x4 w = {cvtpk(P[BASE + 0], P[BASE + 1]), cvtpk(P[BASE + 2], P[BASE + 3]), cvtpk(P[BASE + 4], P[BASE + 5]), cvtpk(P[BASE + 6], P[BASE + 7])}; \
    OUT = *reinterpret_cast<bf16x8*>(&w); } while (0)
template <int NQ, int KP, int PROBE = 0> __device__ __forceinline__ void qkt_sp(f32x16& n0, f32x16& n1, const char* Ks, int koffB, const bf16x8* qr, int r32, int hi,
                                                                const f32x16& e0, const f32x16& e1, bf16x8& pa0, bf16x8& pa1, bf16x8& pa2, bf16x8& pa3, RS& l) {
    bf16x8 kf[2 * NQ]; k_read<NQ, KP>(kf, Ks, koffB, r32, hi);
#pragma unroll
    for (int d0 = 0; d0 < NQ; ++d0) {
        if constexpr (PROBE == 4) { asm volatile("" :: "v"(kf[2 * d0]), "v"(kf[2 * d0 + 1])); if (d0 == 0) { n0 = f32x16{}; n1 = f32x16{}; } }
        else if (d0 == 0) { n0 = __builtin_amdgcn_mfma_f32_32x32x16_bf16(kf[0], qr[0], f32x16{}, 0, 0, 0); n1 = __builtin_amdgcn_mfma_f32_32x32x16_bf16(kf[1], qr[0], f32x16{}, 0, 0, 0); }
        else { n0 = __builtin_amdgcn_mfma_f32_32x32x16_bf16(kf[2 * d0], qr[d0], n0, 0, 0, 0); n1 = __builtin_amdgcn_mfma_f32_32x32x16_bf16(kf[2 * d0 + 1], qr[d0], n1, 0, 0, 0); }
        if (d0 == 0) { ATT_PK4(e0, 0, pa0); rs_group<NQ, 0>(l, e0, e1); }
        if (d0 == 1) { ATT_PK4(e0, 8, pa1); rs_group<NQ, 1>(l, e0, e1); }
        if (d0 == 2) { ATT_PK4(e1, 0, pa2); rs_group<NQ, 2>(l, e0, e1); }
        if (d0 == 3) { ATT_PK4(e1, 8, pa3); rs_group<NQ, 3>(l, e0, e1); }
        if constexpr (NQ == 6) { if (d0 == 4) rs_group<NQ, 4>(l, e0, e1); if (d0 == 5) rs_group<NQ, 5>(l, e0, e1); }
    }
}
template <int NQ, int KP, int PROBE = 0, bool XS = false> __device__ __forceinline__ void qkt_sp_pre(f32x16& n0, f32x16& n1, const bf16x8* kf, const bf16x8* qr,
                                                                f32x16& e0, f32x16& e1, bf16x8& pa0, bf16x8& pa1, bf16x8& pa2, bf16x8& pa3, RS& l) {
#pragma unroll
    for (int d0 = 0; d0 < NQ; ++d0) {
        if constexpr (PROBE == 4) { asm volatile("" :: "v"(kf[2 * d0]), "v"(kf[2 * d0 + 1])); if (d0 == 0) { n0 = f32x16{}; n1 = f32x16{}; } }
        else if (d0 == 0) { n0 = __builtin_amdgcn_mfma_f32_32x32x16_bf16(kf[0], qr[0], f32x16{}, 0, 0, 0); n1 = __builtin_amdgcn_mfma_f32_32x32x16_bf16(kf[1], qr[0], f32x16{}, 0, 0, 0); }
        else { n0 = __builtin_amdgcn_mfma_f32_32x32x16_bf16(kf[2 * d0], qr[d0], n0, 0, 0, 0); n1 = __builtin_amdgcn_mfma_f32_32x32x16_bf16(kf[2 * d0 + 1], qr[d0], n1, 0, 0, 0); }
        if (d0 == 0) { if constexpr (XS) { exp4<24>(e0, e1); ATT_PIN2(e0, e1); } ATT_PK4(e0, 0, pa0); rs_group<NQ, 0>(l, e0, e1); }
        if (d0 == 1) { if constexpr (XS) { exp4<28>(e0, e1); ATT_PIN2(e0, e1); } ATT_PK4(e0, 8, pa1); rs_group<NQ, 1>(l, e0, e1); }
        if (d0 == 2) { ATT_PK4(e1, 0, pa2); rs_group<NQ, 2>(l, e0, e1); }
        if (d0 == 3) { ATT_PK4(e1, 8, pa3); rs_group<NQ, 3>(l, e0, e1); }
        if constexpr (NQ == 6) { if (d0 == 4) rs_group<NQ, 4>(l, e0, e1); if (d0 == 5) rs_group<NQ, 5>(l, e0, e1); }
    }
}
#undef ATT_PK4

template <int KIND> struct Cfg;
template <> struct Cfg<0> { static constexpr int KROW = 96,  NQ = 6, DV = 64;  };
template <> struct Cfg<1> { static constexpr int KROW = 128, NQ = 4, DV = 128; };
template <> struct Cfg<2> { static constexpr int KROW = 64,  NQ = 4, DV = 64;  };
constexpr int NTILES = 2048 / 64;
constexpr int LDS_WS = 135168, LDS_BYTES = LDS_WS;
struct DiffAux { float lam; float oscale; const float* og; };

template <int KIND, int PROBE = 0>
__device__ __forceinline__ void attn_unit(const bf16_t* __restrict__ Qg, const bf16_t* __restrict__ Kg, const bf16_t* __restrict__ Vg, bf16_t* mixp, float negBc, const DiffAux& aux, char* lds, void* diag_out = nullptr) {
    using C = Cfg<KIND>;
    constexpr int KROW = C::KROW, NQ = C::NQ, DV = C::DV, NB = DV / 32, KP = KROW * 2 + 16, KBUF = 64 * KP, VBUF = 64 * DV * 2;
    int tid_ = threadIdx.x; asm volatile("" : "+v"(tid_));
    const int tid = tid_, lane = tid & 63, r32 = lane & 31, hi = lane >> 5; const int wid = __builtin_amdgcn_readfirstlane(tid >> 6);
    const int comp = (KIND == 1) ? (wid >> 2) : 0, rb = (KIND == 1) ? (wid & 3) : wid;
    constexpr int SLOT = KBUF + VBUF, R = (KIND == 1) ? 4 : 5, D = R - 2;
    constexpr int NKP = KBUF / 1024, NVP = VBUF / 1024, NP = NKP + NVP, NPW = (NP + 7) / 8;
    static_assert(R * SLOT <= LDS_WS && KBUF % 1024 == 0 && VBUF % 1024 == 0, "LDS map");
    f32x16 o[NB]; f32x16 lacc = f32x16{}; bf16x8 qr[NQ];
#pragma unroll
    for (int d = 0; d < NB; ++d) o[d] = f32x16{};
    { const bf16_t* Qw = Qg + (size_t)(rb * 32 + r32) * KROW + comp * 64 + hi * 8;
#pragma unroll
      for (int d0 = 0; d0 < NQ; ++d0) qr[d0] = *reinterpret_cast<const bf16x8*>(Qw + d0 * 16); }
    const float nb = __builtin_amdgcn_readfirstlane(negBc);
    const int koffB = comp * 128;
    const unsigned lds0 = (unsigned)(uintptr_t)lds;
    const int vb0 = (int)lds0 + KBUF + v_rd_base(lane);
    const bf16_t* gsrc[NPW]; int gstep[NPW]; int npw = 0;
#pragma unroll
    for (int i = 0; i < NPW; ++i) {
        const int pi = wid + 8 * i;
        if (pi < NKP) { const int d = 1024 * pi + 16 * lane, row = d / KP, cb = d % KP;
            gsrc[i] = Kg + row * KROW + (cb < 2 * KROW ? (cb >> 1) : 0); gstep[i] = 64 * KROW; }
        else { const int q = 1024 * (pi - NKP) + 16 * lane, st = q >> 9, kk = (st / NB) * 8 + ((q & 511) >> 6), k = kk, c = (st % NB) * 32 + ((q & 63) >> 1);
            gsrc[i] = Vg + k * DV + c; gstep[i] = 64 * DV; }
        if (pi < NP) npw = i + 1;
    }
#define ATT_DMA(t, slot) do { if constexpr (PROBE == 0) { _Pragma("unroll") for (int i_ = 0; i_ < NPW; ++i_) { if (i_ < npw) \
        glds16(gsrc[i_] + (size_t)(t) * gstep[i_], (unsigned)__builtin_amdgcn_readfirstlane((int)lds0 + (slot) * SLOT + 1024 * (wid + 8 * i_))); } } } while (0)
#define ATT_WAITBAR(keep) do { if (npw == NPW) asm volatile("s_waitcnt vmcnt(%0) lgkmcnt(0)\n\ts_barrier" :: "n"((keep) * NPW) : "memory"); \
                               else asm volatile("s_waitcnt vmcnt(%0) lgkmcnt(0)\n\ts_barrier" :: "n"((keep) * (NPW - 1)) : "memory"); } while (0)
#define ATT_KSLOT(s_) (lds + (s_) * SLOT)
#define ATT_VSLOT(s_) (vb0 + (s_) * SLOT)
#define ATT_INC(x) do { x = (x == R - 1) ? 0 : x + 1; } while (0)
    bf16x8 pa0, pa1, pa2, pa3; RS ls{0.f, 0.f, 0.f, 0.f};
#if ATT_DIAG
    unsigned long long dacc[4] = {0, 0, 0, 0};
#endif
    constexpr int NT = NTILES;
#pragma unroll
    for (int t = 0; t < D; ++t) ATT_DMA(t, t);
    ATT_WAITBAR(D - 1);
    int sc = 0, sp = 0, sw = D;
    {
        f32x16 pA0, pA1, pB0, pB1; VF fa, fb;
        constexpr bool KPRE = (KIND != 1);
        constexpr bool DLATE = (KIND == 1) && ATT_DLATE && ATT_ALT4 && ATT_RSV && PROBE == 0 && NPW <= 5;
        constexpr bool NEWK = KPRE && ATT_NEWK && ATT_ALT && ATT_RSV && PROBE == 0;
        constexpr bool XS = NEWK && ATT_XSPLIT && (NQ == 6);
        const int ka0 = (int)lds0 + r32 * KP + koffB + hi * 16;
        constexpr int KEEP = KPRE ? D - 2 : D - 1;
        bf16x8 kf[KPRE ? 2 * NQ : 1];
        if constexpr (KPRE) {
            ATT_WAITBAR(D - 2);
            ATT_DMA(D, sw); ATT_INC(sw);
            qkt<NQ, KP>(pA0, pA1, ATT_KSLOT(0), koffB, qr, r32, hi); if (nb != 0.f) add_bias(pA0, pA1, nb);
            if constexpr (NEWK) { ATT_SBAR(); k_read_grp<KP, 0>(kf, ka0 + SLOT); k_read_grp<KP, 1>(kf, ka0 + SLOT); if constexpr (NQ == 6) k_read_grp<KP, 2>(kf, ka0 + SLOT); ATT_SBAR(); }
            else k_read<NQ, KP>(kf, ATT_KSLOT(1), koffB, r32, hi);
            if constexpr (XS) { exp4<0>(pA0, pA1); exp4<4>(pA0, pA1); exp4<8>(pA0, pA1); exp4<12>(pA0, pA1); exp4<16>(pA0, pA1); exp4<20>(pA0, pA1); }
            else exp_all(pA0, pA1);
        } else {
            ATT_DMA(D, sw); ATT_INC(sw);
            qkt<NQ, KP>(pA0, pA1, ATT_KSLOT(0), koffB, qr, r32, hi); if (nb != 0.f) add_bias(pA0, pA1, nb); exp_all(pA0, pA1);
        }
        ATT_WAITBAR(KEEP);
        if constexpr (NEWK) k_pin<NQ>(kf);
        sc = 1;
        int sk = 2;
#define ATT_STEP(E0, E1, N0, N1, j, keep) do { \
            ATT_T(t0_); if constexpr (!DLATE) { if ((j) + D < NT) ATT_DMA((j) + D, sw); } ATT_T(t1_); \
            if constexpr (KPRE) { ATT_SBAR(); qkt_sp_pre<NQ, KP, PROBE, XS>(N0, N1, kf, qr, E0, E1, pa0, pa1, pa2, pa3, ls); ATT_SBAR(); \
                                  if constexpr (!NEWK) { if ((j) + 1 < NT) k_read<NQ, KP>(kf, ATT_KSLOT(sk), koffB, r32, hi); } } \
            else qkt_sp<NQ, KP, PROBE>(N0, N1, ATT_KSLOT(sc), koffB, qr, r32, hi, E0, E1, pa0, pa1, pa2, pa3, ls); \
            if (nb != 0.f) add_bias(N0, N1, nb); ATT_T(t2_); \
            if constexpr (NEWK) { if ((j) + 1 < NT) pv_alt_k<true, KP, NQ / 2, XS>(o, ATT_VSLOT(sp), pa0, pa1, pa2, pa3, N0, N1, kf, ka0 + sk * SLOT); \
                                  else pv_alt_k<true, KP, 0, XS>(o, ATT_VSLOT(sp), pa0, pa1, pa2, pa3, N0, N1, kf, ka0); } \
            else if constexpr (NB == 2 && ATT_ALT && ATT_RSV && PROBE == 0) pv_alt<true>(o, ATT_VSLOT(sp), pa0, pa1, pa2, pa3, N0, N1); \
            else if constexpr (DLATE) pv_alt4_d<true>(o, ATT_VSLOT(sp), pa0, pa1, pa2, pa3, N0, N1, [&](int i_) { if (i_ < npw && (j) + D < NT) \
                     glds16(gsrc[i_] + (size_t)((j) + D) * gstep[i_], (unsigned)__builtin_amdgcn_readfirstlane((int)lds0 + sw * SLOT + 1024 * (wid + 8 * i_))); }); \
            else if constexpr (NB == 4 && ATT_ALT4 && ATT_RSV && PROBE == 0) pv_alt4<true>(o, ATT_VSLOT(sp), pa0, pa1, pa2, pa3, N0, N1); \
            else pv_all<NB, true, PROBE, false>(o, lacc, ATT_VSLOT(sp), pa0, pa1, pa2, pa3, N0, N1, fa, fb); ATT_T(t3_); \
            ATT_INC(sw); ATT_WAITBAR(keep); if constexpr (NEWK) k_pin<NQ>(kf); if constexpr (KPRE) ATT_INC(sk); ATT_INC(sc); ATT_INC(sp); ATT_T(t4_); ATT_ACC(0, t0_, t1_); ATT_ACC(1, t1_, t2_); ATT_ACC(2, t2_, t3_); ATT_ACC(3, t3_, t4_); } while (0)
        static_assert(NT == 32 && (D == 3 || D == 2), "step schedule below is written for 32 tiles, 2 or 3 tiles ahead");
#pragma unroll 1
        for (int j = 1; j < NT - 3; j += 2) { ATT_STEP(pA0, pA1, pB0, pB1, j, KEEP); ATT_STEP(pB0, pB1, pA0, pA1, j + 1, KEEP); }
        ATT_STEP(pA0, pA1, pB0, pB1, NT - 3, (NT - 3 < NT - D) ? KEEP : 0); ATT_STEP(pB0, pB1, pA0, pA1, NT - 2, 0); ATT_STEP(pA0, pA1, pB0, pB1, NT - 1, 0);
#undef ATT_STEP
        if constexpr (XS) { exp4<24>(pB0, pB1); exp4<28>(pB0, pB1); }
        sum_pack(pB0, pB1, pa0, pa1, pa2, pa3, ls);
        if constexpr (NB == 2 && ATT_ALT && ATT_RSV && PROBE == 0) pv_alt<false>(o, ATT_VSLOT(sp), pa0, pa1, pa2, pa3, pB0, pB1);
        else if constexpr (NB == 4 && ATT_ALT4 && ATT_RSV && PROBE == 0) pv_alt4<false>(o, ATT_VSLOT(sp), pa0, pa1, pa2, pa3, pB0, pB1);
        else pv_all<NB, false>(o, lacc, ATT_VSLOT(sp), pa0, pa1, pa2, pa3, pB0, pB1, fa, fb);
    }
#undef ATT_DMA
#undef ATT_WAITBAR
#undef ATT_KSLOT
#undef ATT_VSLOT
#undef ATT_INC
#if ATT_DIAG
    if (KIND == ATT_DIAG_KIND && lane == 0) { unsigned long long* dg = (unsigned long long*)diag_out; for (int i = 0; i < 4; ++i) atomicAdd(dg + i, dacc[i]); }
#endif
    float rli[16];
    if constexpr (ATT_RSV) {
        float lt = (ls.a + ls.b) + (ls.c + ls.d); { const auto q_ = __builtin_amdgcn_permlane32_swap(__float_as_uint(lt), __float_as_uint(lt), false, false); lt = __uint_as_float(q_[0]) + __uint_as_float(q_[1]); }
        const float li = __builtin_amdgcn_rcpf(lt);
#pragma unroll
        for (int r = 0; r < 16; ++r) rli[r] = __shfl(li, crow(r, hi));
    } else {
#pragma unroll
        for (int r = 0; r < 16; ++r) rli[r] = __builtin_amdgcn_rcpf(lacc[r]);
    }
    if constexpr (KIND != 1) {
        __syncthreads();
        bf16_t* stg = (bf16_t*)lds + wid * 2048;
#pragma unroll
        for (int r = 0; r < 16; ++r) { const int orow = crow(r, hi);
#pragma unroll
            for (int d0 = 0; d0 < 2; ++d0) stg[orow * 64 + d0 * 32 + r32] = (bf16_t)(cvtpk(o[d0][r] * rli[r], 0.f) & 0xffffu); }
        asm volatile("s_waitcnt lgkmcnt(0)" ::: "memory");
#pragma unroll
        for (int i = 0; i < 4; ++i) { const int row = i * 8 + (lane >> 3), ch = lane & 7; const u32x4 v = *(const u32x4*)(stg + row * 64 + ch * 8);
            *(u32x4*)(mixp + (size_t)(wid * 32 + row) * 1280 + ch * 8) = v; }
        asm volatile("s_waitcnt lgkmcnt(0)" ::: "memory"); __syncthreads();
    } else {
#pragma unroll
        for (int d0 = 0; d0 < 4; ++d0)
#pragma unroll
            for (int r = 0; r < 16; ++r) o[d0][r] *= rli[r];
        __syncthreads();
        float* X = (float*)lds + rb * 4096;
        if (comp == 1) {
#pragma unroll
            for (int d0 = 0; d0 < 4; ++d0)
#pragma unroll
                for (int r = 0; r < 16; ++r) X[crow(r, hi) * 128 + d0 * 32 + r32] = aux.lam * o[d0][r];
        }
        asm volatile("s_waitcnt lgkmcnt(0)" ::: "memory"); __syncthreads();
        if (comp == 0) {
            float og[4];
#pragma unroll
            for (int d0 = 0; d0 < 4; ++d0) og[d0] = aux.og[d0 * 32 + r32] * aux.oscale;
#pragma unroll
            for (int d0 = 0; d0 < 4; ++d0)
#pragma unroll
                for (int r = 0; r < 16; ++r) o[d0][r] -= X[crow(r, hi) * 128 + d0 * 32 + r32];
            asm volatile("s_waitcnt lgkmcnt(0)" ::: "memory");
            bf16_t* stg = (bf16_t*)X;
            float ssr[16];
#pragma unroll
            for (int r = 0; r < 16; ++r) { float v = (o[0][r] * o[0][r] + o[1][r] * o[1][r]) + (o[2][r] * o[2][r] + o[3][r] * o[3][r]);
                v += __uint_as_float(__builtin_amdgcn_update_dpp(0u, __float_as_uint(v), 0xB1, 0xf, 0xf, true));
                v += __uint_as_float(__builtin_amdgcn_update_dpp(0u, __float_as_uint(v), 0x4E, 0xf, 0xf, true));
                v += __uint_as_float(__builtin_amdgcn_update_dpp(0u, __float_as_uint(v), 0x141, 0xf, 0xf, true));
                v += __uint_as_float(__builtin_amdgcn_update_dpp(0u, __float_as_uint(v), 0x140, 0xf, 0xf, true));
                const auto w_ = __builtin_amdgcn_permlane16_swap(__float_as_uint(v), __float_as_uint(v), false, false);
                ssr[r] = __uint_as_float(w_[0]) + __uint_as_float(w_[1]); }
#pragma unroll
            for (int r = 0; r < 16; ++r) {
                const float rr = rsqrtf(ssr[r] * (1.0f / 128.0f) + 1e-6f);
#pragma unroll
                for (int d0 = 0; d0 < 4; ++d0) stg[crow(r, hi) * 128 + d0 * 32 + r32] = (bf16_t)(cvtpk(o[d0][r] * rr * og[d0], 0.f) & 0xffffu);
            }
            asm volatile("s_waitcnt lgkmcnt(0)" ::: "memory");
#pragma unroll
            for (int i = 0; i < 8; ++i) { const int row = i * 4 + (lane >> 4), ch = lane & 15; const u32x4 v = *(const u32x4*)(stg + row * 128 + ch * 8);
                *(u32x4*)(mixp + (size_t)(rb * 32 + row) * 1280 + ch * 8) = v; }
        }
        asm volatile("s_waitcnt lgkmcnt(0)" ::: "memory"); __syncthreads();
    }
}
#undef ATT_SBAR
}
#define GAS __attribute__((address_space(1)))
#define LAS __attribute__((address_space(3)))
typedef unsigned short bf16;
typedef unsigned v4u __attribute__((ext_vector_type(4)));
typedef float f32x4 __attribute__((ext_vector_type(4)));
typedef short bf16x8 __attribute__((ext_vector_type(8)));
typedef GAS unsigned gu32;
typedef GAS unsigned long long gu64;
#define RLX_AGENT __ATOMIC_RELAXED, __HIP_MEMORY_SCOPE_AGENT
#define LDS_WAIT() asm volatile("s_waitcnt lgkmcnt(0)" ::: "memory")
#define VM_WAIT() asm volatile("s_waitcnt vmcnt(0)" ::: "memory")
__device__ __forceinline__ unsigned long long rt() { return __builtin_amdgcn_s_memrealtime(); }
__device__ __forceinline__ unsigned f2bf(float f) { unsigned u = __builtin_bit_cast(unsigned, f); return (u + 0x7fffu + ((u >> 16) & 1u)) >> 16; }
__device__ __forceinline__ unsigned pk2(float lo, float hi) { return f2bf(lo) | (f2bf(hi) << 16); }
#define XB_TMO      128
#define XB_XCNT(j)  (256  + 64 * (j))
#define XB_XSUB(j)  (1280 + 64 * (j))
#define XB_XGEN(j)  (2304 + 64 * (j))
#define XB_TOP      3328
#define XB_TOPGEN   3392
#define XCD_BAR_WORDS 3456
#define XB_SPIN_CAP (1u << 18)

__device__ __forceinline__ unsigned xb_ld(unsigned* p)              { return __hip_atomic_load(p, __ATOMIC_RELAXED, __HIP_MEMORY_SCOPE_AGENT); }
__device__ __forceinline__ unsigned xb_add(unsigned* p, unsigned v) { return __hip_atomic_fetch_add(p, v, __ATOMIC_RELAXED, __HIP_MEMORY_SCOPE_AGENT); }
__device__ __forceinline__ unsigned xb_xcc_id() { return (unsigned)__builtin_amdgcn_s_getreg((3 << 11) | 20) & 0xFu; }
#define XB_SPIN(cond, bar) do { unsigned _sp = 0; while (cond) { __builtin_amdgcn_s_sleep(1); \
    if ((++_sp & 255u) == 0u) { if (xb_ld(&(bar)[XB_TMO])) break; if (_sp > XB_SPIN_CAP) { atomicAdd(&(bar)[XB_TMO], 1u); break; } } } } while (0)

struct XcdBarrier {
    unsigned* bar; unsigned x;
    volatile LAS unsigned* st;
};

__device__ __forceinline__ XcdBarrier xcd_barrier_post(unsigned* bar, volatile LAS unsigned* st) {
    XcdBarrier b; b.bar = bar; b.x = xb_xcc_id(); b.st = st;
    if (threadIdx.x == 0) (void)xb_add(&bar[XB_XCNT(b.x)], 1u);
    return b;
}
__device__ __forceinline__ void xcd_barrier_complete(unsigned* bar, unsigned x, unsigned& nloc, unsigned& nx) {
    const unsigned G = gridDim.x * gridDim.y * gridDim.z;
    unsigned sum, cnt, mine, sp = 0u;
    for (;;) {
        sum = 0u; cnt = 0u; mine = 0u;
#pragma unroll
        for (unsigned j = 0; j < 16; ++j) { const unsigned c = xb_ld(&bar[XB_XCNT(j)]); sum += c; cnt += (c > 0u) ? 1u : 0u; mine = (j == x) ? c : mine; }
        if (sum == G) break;
        __builtin_amdgcn_s_sleep(1);
        if ((++sp & 255u) == 0u) { if (xb_ld(&bar[XB_TMO])) break; if (sp > XB_SPIN_CAP) { atomicAdd(&bar[XB_TMO], 1u); break; } }
    }
    nloc = mine > 0u ? mine : 1u; nx = cnt > 0u ? cnt : 1u;
}

__device__ __forceinline__ void xcd_barrier(const XcdBarrier& b) {
    asm volatile("s_waitcnt vmcnt(0)" ::: "memory");
    __syncthreads();
    if (threadIdx.x == 0) {
        unsigned* bar = b.bar;
        __builtin_amdgcn_s_waitcnt(0);
        unsigned nloc = b.st[0], nx = b.st[1];
        if (nloc == 0u) { xcd_barrier_complete(bar, b.x, nloc, nx); b.st[0] = nloc; b.st[1] = nx; }
        const unsigned old = xb_add(&bar[XB_XSUB(b.x)], 1u);
        const unsigned gen = old / nloc;
        if (old + 1u == (gen + 1u) * nloc) {
            __builtin_amdgcn_fence(__ATOMIC_RELEASE, "agent");
            asm volatile("s_waitcnt vmcnt(0)" ::: "memory");
            const unsigned og = xb_add(&bar[XB_TOP], 1u);
            const unsigned tg = og / nx;
            if (og + 1u == (tg + 1u) * nx) xb_add(&bar[XB_TOPGEN], 1u);
            else XB_SPIN(xb_ld(&bar[XB_TOPGEN]) == tg, bar);
            __builtin_amdgcn_fence(__ATOMIC_ACQUIRE, "agent");
            xb_add(&bar[XB_XGEN(b.x)], 1u);
            asm volatile("s_waitcnt vmcnt(0)" ::: "memory");
        } else {
            XB_SPIN(xb_ld(&bar[XB_XGEN(b.x)]) == gen, bar);
            __builtin_amdgcn_fence(__ATOMIC_ACQUIRE, "agent");
            asm volatile("s_waitcnt vmcnt(0)" ::: "memory");
        }
    }
    __syncthreads();
}
#ifndef PH_CONST
#define PH_CONST 1
#endif
#ifndef USE_LOCAL_BAR
#define USE_LOCAL_BAR 1
#endif
#ifndef EARLY_INV
#define EARLY_INV 1
#endif
#ifndef DEFER_W1
#define DEFER_W1 1
#endif
static_assert(att::LDS_BYTES <= RING_BYTES, "attention LDS");
struct Args { const float* in[22]; float* out; unsigned char* ws; int ph_lo, ph_hi; };

__device__ __forceinline__ float wave_sum(float v) {
    v += __uint_as_float(__builtin_amdgcn_update_dpp(0u, __float_as_uint(v), 0xB1, 0xf, 0xf, true));
    v += __uint_as_float(__builtin_amdgcn_update_dpp(0u, __float_as_uint(v), 0x4E, 0xf, 0xf, true));
    v += __uint_as_float(__builtin_amdgcn_update_dpp(0u, __float_as_uint(v), 0x141, 0xf, 0xf, true));
    v += __uint_as_float(__builtin_amdgcn_update_dpp(0u, __float_as_uint(v), 0x140, 0xf, 0xf, true));
    const auto r = __builtin_amdgcn_permlane16_swap(__float_as_uint(v), __float_as_uint(v), false, false);
    const float t = __uint_as_float(r[0]) + __uint_as_float(r[1]);
    const auto q = __builtin_amdgcn_permlane32_swap(__float_as_uint(t), __float_as_uint(t), false, false);
    return __uint_as_float(q[0]) + __uint_as_float(q[1]);
}
__device__ __forceinline__ int src_col32(int which, int g) {
    const int t = g >> 3, gi = g & 7, bj = gi >> 2, wc = gi & 3;
    switch (which) {
        case 0:
            switch (t) {
                case 0: return 32 * gi;
                case 1: return bj == 0 ? 256 + 32 * gi : 2720 + 32 * (gi - 4);
                case 2: return 384 + 32 * gi;
                case 3: case 4: return 672 + (4 * (t - 3) + wc) * 64 + 32 * bj;
                case 5: case 6: return 1184 + (4 * (t - 5) + wc) * 64 + 32 * bj;
                case 7: case 8: return 1696 + 256 * (t - 7) + 32 * gi;
                case 9: return 2208 + wc * 64 + 32 * bj;
                case 10: return wc < 2 ? 2208 + (4 + wc) * 64 + 32 * bj : 2592 + (wc - 2) * 64 + 32 * bj;
                default: return gi == 0 ? 640 : -1;
            }
        case 1: return wc < 3 ? (2 * t + bj) * 96 + 32 * wc : -1;
        case 4: return bj * FFH + 128 * t + 32 * wc;
        default: return 32 * g;
    }
}
__device__ __forceinline__ bool win_plain_group(int g) { const int t = g >> 3; return t <= 8 || t == 11; }
__device__ __forceinline__ void p0_convert_item(const float* W, int K, int N, const float* kg, int which, bf16* WT, LAS float* scr, int item, int lane) {
    const int ngr = (which == 0 ? 96 : which == 1 || which == 2 ? 24 : which == 4 ? 176 : 32), kb = item / ngr, g = item % ngr, k0 = 64 * kb, sc = src_col32(which, g);
    {
        float w[32];
        const int hl = lane >> 5, cl = lane & 31;
        if (sc >= 0) {
            const float* wp = W + (size_t)(k0 + hl) * N + sc + cl;
#pragma unroll
            for (int i = 0; i < 32; ++i) { w[i] = *wp; wp += 2 * N; if (i == 15) asm volatile("" : "+v"(wp)); }
            if (kg) {
                float gv[32];
#pragma unroll
                for (int i = 0; i < 32; ++i) gv[i] = kg[k0 + 2 * i + hl];
#pragma unroll
                for (int i = 0; i < 32; ++i) w[i] *= gv[i];
            }
        } else {
#pragma unroll
            for (int i = 0; i < 32; ++i) w[i] = 0.f;
        }
#pragma unroll
        for (int i = 0; i < 32; ++i) scr[(2 * i + hl) * 33 + cl] = w[i];
    }
    LDS_WAIT(); asm volatile("" ::: "memory");
    const int c = lane & 7;
    const bool prm = (which == 0 && win_plain_group(g)) || (which == 1 && (g & 3) < 2) || which == 2;
#pragma unroll
    for (int j = 0; j < 4; ++j) { const int n = (lane >> 3) + 8 * j; const LAS float* s = scr + (8 * c) * 33 + (prm ? pg8::perm32(n) : n);
        v4u o; o.x = pk2(s[0 * 33], s[1 * 33]); o.y = pk2(s[2 * 33], s[3 * 33]); o.z = pk2(s[4 * 33], s[5 * 33]); o.w = pk2(s[6 * 33], s[7 * 33]);
        *(GAS v4u*)(WT + (size_t)(32 * g + n) * K + k0 + 8 * c) = o; }
    LDS_WAIT(); asm volatile("" ::: "memory");
}
__device__ __forceinline__ void split_arrive(const XcdBarrier& b, unsigned* w) {
    asm volatile("s_waitcnt vmcnt(0)" ::: "memory");
    __syncthreads();
    if (threadIdx.x == 0) {
        __builtin_amdgcn_s_waitcnt(0);
        const unsigned nloc = b.st[0];
        const unsigned old = xb_add(&w[64 * b.x], 1u);
        if (old + 1u == nloc) { __builtin_amdgcn_fence(__ATOMIC_RELEASE, "agent"); asm volatile("s_waitcnt vmcnt(0)" ::: "memory"); xb_add(&w[1024], 1u); }
    }
}
__device__ __forceinline__ void split_wait(const XcdBarrier& b, unsigned* w) {
    if (threadIdx.x == 0) { const unsigned nx = b.st[1]; XB_SPIN(xb_ld(&w[1024]) < nx, b.bar); __builtin_amdgcn_fence(__ATOMIC_ACQUIRE, "agent"); asm volatile("s_waitcnt vmcnt(0)" ::: "memory"); }
    __syncthreads();
}
__device__ __forceinline__ void xcc_local_barrier(const XcdBarrier& b, unsigned* cnt, unsigned nloc, unsigned& epoch) {
    asm volatile("s_waitcnt vmcnt(0)" ::: "memory");
    __syncthreads();
    epoch += 1u;
    if (threadIdx.x == 0) {
        __builtin_amdgcn_s_waitcnt(0);
        const unsigned target = epoch * nloc;
        (void)__hip_atomic_fetch_add(cnt, 1u, __ATOMIC_RELAXED, __HIP_MEMORY_SCOPE_AGENT);
#if EARLY_INV
        asm volatile("buffer_inv sc1" ::: "memory");
        XB_SPIN(xb_ld(cnt) < target, b.bar);
        asm volatile("s_waitcnt vmcnt(0)" ::: "memory");
#else
        XB_SPIN(xb_ld(cnt) < target, b.bar);
        __builtin_amdgcn_fence(__ATOMIC_ACQUIRE, "agent");
        asm volatile("s_waitcnt vmcnt(0)" ::: "memory");
#endif
    }
    __syncthreads();
}
__device__ __forceinline__ void local_arrive(unsigned* cnt) {
    asm volatile("s_waitcnt vmcnt(0)" ::: "memory");
    __syncthreads();
    if (threadIdx.x == 0) { __builtin_amdgcn_s_waitcnt(0); (void)xb_add(cnt, 1u); }
}
__device__ __forceinline__ void local_wait(const XcdBarrier& b, unsigned* cnt, unsigned nloc) {
    if (threadIdx.x == 0) { XB_SPIN(xb_ld(cnt) < nloc, b.bar); __builtin_amdgcn_fence(__ATOMIC_ACQUIRE, "agent"); asm volatile("s_waitcnt vmcnt(0)" ::: "memory"); }
    __syncthreads();
}
constexpr int CW_LOCAL = 10240;
constexpr int CW_SPLIT = 6144;
struct Consts { float lam, oscale, negb_mla, negb_dif, negb_gqa, pad0, pad1, pad2; };

__device__ __forceinline__ void convert_layer_weights(const Args& A, int l, LAS float* scr, int gw, int NGW, int lane) {
    constexpr int NI_IN = (3072 / 32) * (1024 / 64), NI_UQ = (768 / 32) * (384 / 64), NI_UKV = (768 / 32) * (256 / 64), NI_O = (1024 / 32) * (1280 / 64), NI_GU = (5632 / 32) * (1024 / 64), NI_DN = (1024 / 32) * (2816 / 64);
    constexpr int NI_L = NI_IN + NI_UQ + NI_UKV + NI_O + NI_GU + NI_DN;
    bf16* wb = (bf16*)(A.ws + WS_W + (size_t)l * W_LAYER);
    for (int it = gw; it < NI_L; it += NGW) {
        int r = it;
        if (r < NI_IN) { p0_convert_item(A.in[2] + (size_t)l * 1024 * INW, 1024, INW, A.in[1] + l * 1024, 0, wb + W_IN / 2, scr, r, lane); continue; } r -= NI_IN;
        if (r < NI_UQ) { p0_convert_item(A.in[4] + (size_t)l * 384 * 576, 384, 576, A.in[3] + l * 384, 1, wb + W_UQ / 2, scr, r, lane); continue; } r -= NI_UQ;
        if (r < NI_UKV) { p0_convert_item(A.in[6] + (size_t)l * 256 * 768, 256, 768, A.in[5] + l * 256, 2, wb + W_UKV / 2, scr, r, lane); continue; } r -= NI_UKV;
        if (r < NI_O) { p0_convert_item(A.in[18] + (size_t)l * 1280 * 1024, 1280, 1024, nullptr, 3, wb + W_O / 2, scr, r, lane); continue; } r -= NI_O;
        if (r < NI_GU) { p0_convert_item(A.in[20] + (size_t)l * 1024 * 2 * FFH, 1024, 2 * FFH, A.in[19] + l * 1024, 4, wb + W_GU / 2, scr, r, lane); continue; } r -= NI_GU;
        p0_convert_item(A.in[21] + (size_t)l * FFH * 1024, FFH, 1024, nullptr, 5, wb + W_DN / 2, scr, r, lane);
    }
}
__device__ __forceinline__ void p0_prologue(const Args& A, LAS unsigned char* lds, int vcu, int G, int wave, int lane, int parts = 7) {
    unsigned char* ws = A.ws;
    LAS float* scr = (LAS float*)(lds + RING_OFF + wave * 16384);
    const int gw = vcu * NWAVES + wave, NGW = G * NWAVES;
    if (parts & 1) for (int l = 0; l < (DEFER_W1 && G == 256 ? 1 : DEPTH); ++l) convert_layer_weights(A, l, scr, gw, NGW, lane);
    float* ssqx = (float*)(ws + WS_SSQ + SSQ_X); bf16* xb = (bf16*)(ws + WS_XB);
    if (parts & 2) for (int m = gw; m < M; m += 2 * NGW) {
        const int m2 = m + NGW;
        const GAS f32x4* xr = (const GAS f32x4*)(A.in[0] + (size_t)m * DMODEL) + lane; const GAS f32x4* xr2 = (const GAS f32x4*)(A.in[0] + (size_t)(m2 < M ? m2 : m) * DMODEL) + lane;
        f32x4 v[4], v2[4]; float s = 0.f, s2 = 0.f;
#pragma unroll
        for (int j = 0; j < 4; ++j) { v[j] = xr[64 * j]; v2[j] = xr2[64 * j]; }
#pragma unroll
        for (int j = 0; j < 4; ++j) { s += (v[j].x * v[j].x + v[j].y * v[j].y) + (v[j].z * v[j].z + v[j].w * v[j].w); s2 += (v2[j].x * v2[j].x + v2[j].y * v2[j].y) + (v2[j].z * v2[j].z + v2[j].w * v2[j].w); }
        s = wave_sum(s); s2 = wave_sum(s2);
        GAS unsigned long long* o8 = (GAS unsigned long long*)(xb + (size_t)m * DMODEL) + lane;
#pragma unroll
        for (int j = 0; j < 4; ++j) o8[64 * j] = (unsigned long long)pk2(v[j].x, v[j].y) | ((unsigned long long)pk2(v[j].z, v[j].w) << 32);
        if (lane < 4) ssqx[(size_t)m * 4 + lane] = lane == 0 ? s : 0.f;
        if (m2 < M) {
            GAS unsigned long long* o82 = (GAS unsigned long long*)(xb + (size_t)m2 * DMODEL) + lane;
#pragma unroll
            for (int j = 0; j < 4; ++j) o82[64 * j] = (unsigned long long)pk2(v2[j].x, v2[j].y) | ((unsigned long long)pk2(v2[j].z, v2[j].w) << 32);
            if (lane < 4) ssqx[(size_t)m2 * 4 + lane] = lane == 0 ? s2 : 0.f;
        }
    }
    if (!(parts & 4)) return;
    float* tab = (float*)(ws + WS_TAB);
    const int gt = gw * 64 + lane, NGT = NGW * 64;
    for (int e = gt; e < 2048 * 16; e += NGT) { const int p = e >> 4, i = e & 15; const float ang = (float)p * (1.0f / powf(10000.0f, (float)(2 * i) / 32.0f)); tab[TAB_MLA_COS / 4 + e] = cosf(ang); tab[TAB_MLA_SIN / 4 + e] = sinf(ang); }
    for (int e = gt; e < 2048 * 32; e += NGT) { const int p = e >> 5, i = e & 31; const float ang = (float)p * (1.0f / powf(10000.0f, (float)(2 * i) / 64.0f)); tab[TAB_DIF_COS / 4 + e] = cosf(ang); tab[TAB_DIF_SIN / 4 + e] = sinf(ang); }
    for (int e = gt; e < 64 * 16; e += NGT) { const int p = e >> 4, i = e & 15; const float ang = (float)p * (1.0f / powf(10000.0f, (float)(2 * i) / 32.0f)); const float c = cosf(ang), s = sinf(ang);
        tab[TAB_COL_COS / 4 + e] = c; tab[TAB_COL_SIN / 4 + e] = s; if (p < 32) { tab[TAB_ROW_COS / 4 + e] = c; tab[TAB_ROW_SIN / 4 + e] = s; } }
    for (int e = gt; e < DEPTH * GN_STRIDE; e += NGT) { const int l = e / GN_STRIDE, r = e % GN_STRIDE; float v;
        if (r < GN_MK) v = A.in[7][l * 96 + r]; else if (r < GN_DQ) v = A.in[8][l * 96 + r - GN_MK]; else if (r < GN_DK) v = A.in[9][l * 64 + r - GN_DQ]; else if (r < GN_GQ) v = A.in[10][l * 64 + r - GN_DK];
        else if (r < GN_GK) v = A.in[16][l * 64 + r - GN_GQ]; else if (r < GN_OG) v = A.in[17][l * 64 + r - GN_GK]; else v = A.in[15][l * 128 + r - GN_OG];
        tab[TAB_GAIN / 4 + e] = v; }
    if (gw < DEPTH) {
        const int l = gw;
        const float d1 = wave_sum(A.in[11][l * 64 + lane] * A.in[12][l * 64 + lane]), d2 = wave_sum(A.in[13][l * 64 + lane] * A.in[14][l * 64 + lane]);
        const float lambda_init = 0.8f - 0.6f * expf(-0.3f * (float)l);
        float mq = fabsf(A.in[7][l * 96 + lane]), mk = fabsf(A.in[8][l * 96 + lane]);
        if (lane < 32) { mq = fmaxf(mq, fabsf(A.in[7][l * 96 + 64 + lane])); mk = fmaxf(mk, fabsf(A.in[8][l * 96 + 64 + lane])); }
        float dq = fabsf(A.in[9][l * 64 + lane]), dk = fabsf(A.in[10][l * 64 + lane]), gq = fabsf(A.in[16][l * 64 + lane]), gk = fabsf(A.in[17][l * 64 + lane]);
#pragma unroll
        for (int o = 1; o < 64; o <<= 1) { mq = fmaxf(mq, __shfl_xor(mq, o)); mk = fmaxf(mk, __shfl_xor(mk, o)); dq = fmaxf(dq, __shfl_xor(dq, o)); dk = fmaxf(dk, __shfl_xor(dk, o)); gq = fmaxf(gq, __shfl_xor(gq, o)); gk = fmaxf(gk, __shfl_xor(gk, o)); }
        if (lane == 0) { Consts c; c.lam = expf(d1) - expf(d2) + lambda_init; c.oscale = 1.0f - lambda_init;
            const float bm = pg8::C2_MLA * 96.0f * mq * mk, bd = pg8::C2_64 * 64.0f * dq * dk, bg = pg8::C2_64 * 64.0f * gq * gk;
            c.negb_mla = bm > 48.f ? -bm : 0.f; c.negb_dif = bd > 48.f ? -bd : 0.f; c.negb_gqa = bg > 48.f ? -bg : 0.f;
            c.pad0 = c.pad1 = c.pad2 = 0.f;
            *(Consts*)((unsigned char*)tab + TAB_CONST + 32 * l) = c; }
    }
}

#ifndef ATT_SD1
#define ATT_SD1 1
#endif
#ifndef KMASK
#define KMASK 7
#endif
#ifndef ATT_PROBE
#define ATT_PROBE 0
#endif
#define ATT_BODY { \
            const int b = vcu2 >> 5, c32 = vcu2 & 31; \
            att::DiffAux aux{cst.lam, cst.oscale, tab + TAB_GAIN / 4 + l * GN_STRIDE + GN_OG}; \
            if (KMASK & 1) for (int i = 0; i < 2; ++i) { const int u = c32 + 32 * i, h = u >> 4, qb = u & 15; const size_t hrow = (size_t)(b * 4 + h) * 2048; \
                ATTU(1)((const att::bf16_t*)(qkv + QB) + (hrow + qb * 128) * 128, (const att::bf16_t*)(qkv + KB) + hrow * 128, (const att::bf16_t*)(qkv + VB) + hrow * 128, \
                                  mix + (size_t)(b * 2048 + qb * 128) * MIXW + 384 + h * 128, cst.negb_dif, aux, (char*)lds + RING_OFF); } \
            if (KMASK & 4) for (int i = 0; i < 2; ++i) { const int u = i == 0 ? c32 : 16 + c32; if (i == 1 && c32 < 16) break; const int h = u >> 3, qb = u & 7; const size_t hq = (size_t)(b * 6 + h) * 2048, hk = (size_t)(b * 2 + h / 3) * 2048; \
                ATTU(2)((const att::bf16_t*)(qkv + QC) + (hq + qb * 256) * 64, (const att::bf16_t*)(qkv + KC) + hk * 64, (const att::bf16_t*)(qkv + VC) + hk * 64, \
                                  mix + (size_t)(b * 2048 + qb * 256) * MIXW + 896 + h * 64, cst.negb_gqa, aux, (char*)lds + RING_OFF, ws + WS_CTL + 32768); } \
            if (SPLIT_MLA && IN(p0 + 1)) { if (loc) local_wait(bar, (unsigned*)(ctl + CW_LOCAL + 1024 + 2048 * l + 64 * xb_xcc_id()), (unsigned)(G / 8)); else split_wait(bar, (unsigned*)(ctl + CW_SPLIT + 2048 * l)); }     \
            if (KMASK & 2) for (int i = 0; i < 2; ++i) { const int u = c32 + 32 * i; if (u >= 48) break; const int h = u >> 3, qb = u & 7; const size_t hrow = (size_t)(b * 6 + h) * 2048; \
                ATTU(0)((const att::bf16_t*)(qkv + QA) + (hrow + qb * 256) * 96, (const att::bf16_t*)(qkv + KA) + hrow * 96, (const att::bf16_t*)(qkv + VA) + hrow * 64, \
                                  mix + (size_t)(b * 2048 + qb * 256) * MIXW + h * 64, cst.negb_mla, aux, (char*)lds + RING_OFF, ws + WS_CTL + 32768); } \
 }
__global__ void __launch_bounds__(NWAVES * 64, 2) mega_fwd(Args args) {
    extern __shared__ __attribute__((aligned(16))) unsigned char lds[];
    LAS unsigned char* ldsl = (LAS unsigned char*)lds;
    volatile LAS unsigned* MISC = (volatile LAS unsigned*)(ldsl + MISC_OFF);
    int tid_ = threadIdx.x; asm volatile("" : "+v"(tid_));
    const int tid = tid_, lane = tid & 63, wave = __builtin_amdgcn_readfirstlane(tid >> 6);
    constexpr int G = 256;
    const int bx = blockIdx.x, vcu = (bx % 8) * (G / 8) + bx / 8;
    unsigned char* ws = args.ws;
    gu32* ctl = (gu32*)(ws + WS_CTL);
    for (int u = tid; u < (LDS_BYTES - LDSCTL_OFF) / 4; u += NWAVES * 64) ((LAS unsigned*)(ldsl + LDSCTL_OFF))[u] = 0u;
    __syncthreads();
#define bar (XcdBarrier{(unsigned*)((gu32*)(ws + WS_CTL) + CW_BAR), xb_xcc_id(), (volatile LAS unsigned*)((LAS unsigned char*)lds + MISC_OFF) + 8})
    if (tid == 0) { const unsigned x_ = xb_xcc_id(); MISC[10] = xb_add((unsigned*)((gu32*)(ws + WS_CTL) + CW_BAR) + XB_XCNT(x_), 1u); }
    __syncthreads();
#if PH_CONST
    constexpr int lo = 0, hi = NPHASE;
#else
    const int lo = args.ph_lo, hi = args.ph_hi;
#endif
#ifndef PRO_PART
#define PRO_PART 7
#endif
#ifndef CLK_DIAG
#define CLK_DIAG 0
#endif
#ifndef CLK_PH
#define CLK_PH 3
#endif
#ifndef GEMM_ALIGN
#define GEMM_ALIGN true
#endif
#ifndef GEMM_SP2
#define GEMM_SP2 true
#endif
#ifndef SPLIT_MLA
#define SPLIT_MLA 1
#endif
#ifndef REP_PRO
#define REP_PRO 1
#endif
#ifndef REP_IN
#define REP_IN 1
#endif
#ifndef REP_MLA
#define REP_MLA 1
#endif
#ifndef REP_ATT
#define REP_ATT 1
#endif
#ifndef REP_GU
#define REP_GU 1
#endif
#ifndef REP_OP0
#define REP_OP0 1
#endif
#ifndef EXTRA_BARS
#define EXTRA_BARS 0
#endif
#ifndef REP_DN0
#define REP_DN0 1
#endif
#ifndef PHMASK
#define PHMASK 0x7f
#endif
#define IN(k) (lo <= (k) && (k) < hi)
#define SEAM(k) do { if (IN((k) + 1)) xcd_barrier(bar); } while (0)
    float* tab = (float*)(ws + WS_TAB);
    pg8::bf16_t* xb = (pg8::bf16_t*)(ws + WS_XB);
    pg8::bf16_t* mix = (pg8::bf16_t*)(ws + WS_MIX);
    unsigned char* hs = (unsigned char*)args.out;
    pg8::bf16_t* cq = (pg8::bf16_t*)(hs + MIX_CQ); pg8::bf16_t* ckv = (pg8::bf16_t*)(hs + MIX_CKV);
    unsigned char* qkv = ws + WS_QKV;
    pg8::bf16_t* act = (pg8::bf16_t*)(ws + WS_QKV);

    if ((PHMASK & 1) && IN(0)) { for (int rep = 0; rep < REP_PRO; ++rep) { p0_prologue(args, ldsl, vcu, G, wave, lane, rep + 1 < REP_PRO ? PRO_PART : 7); __syncthreads(); } SEAM(0); }
    if (tid == 0) { MISC[11] = 0u; }
    if (USE_LOCAL_BAR && lo == 0 && G == 256) {
        if (tid == 0) { unsigned okc = 1u; unsigned* bw_ = (unsigned*)((gu32*)(ws + WS_CTL) + CW_BAR); for (unsigned j = 0; j < 16; ++j) { const unsigned c = xb_ld(&bw_[XB_XCNT(j)]); okc &= (j < 8 ? (c == (unsigned)(G / 8)) : (c == 0u)) ? 1u : 0u; } MISC[11] = okc; }
    }
    __syncthreads();
#define loc (__builtin_amdgcn_readfirstlane((int)MISC[11]) != 0)
#define bxv (loc ? (int)xb_xcc_id() + 8 * __builtin_amdgcn_readfirstlane((int)MISC[10]) : (int)blockIdx.x)
#define vcu2 ((bxv % 8) * 32 + bxv / 8)
#define lcnt ((unsigned*)((gu32*)(ws + WS_CTL) + CW_LOCAL + 64 * xb_xcc_id()))
    unsigned lbe = 0u;
#define SEAM_L(k) do { if (IN((k) + 1)) { if (loc) xcc_local_barrier(bar, lcnt, (unsigned)(G / 8), lbe); else xcd_barrier(bar); } } while (0)

    for (int eb = 0; eb < EXTRA_BARS; ++eb) xcd_barrier(bar);
#pragma unroll 1
    for (int l = 0; l < DEPTH; ++l) {
        const int p0 = 1 + 6 * l;
        const pg8::bf16_t* wb = (const pg8::bf16_t*)(ws + WS_W + (size_t)l * W_LAYER);
        if ((PHMASK & 2) && IN(p0)) {

#if CLK_DIAG
            unsigned long long ck0_ = 0, rt0_ = 0; if (CLK_PH == 1 && l == 1) { ck0_ = __builtin_amdgcn_s_memtime(); rt0_ = __builtin_amdgcn_s_memrealtime(); }
#endif
          for (int rep = 0; rep < REP_IN; ++rep) {
            pg8::Gemm g{xb, wb + W_IN / 2, M, 3072, 1024}; pg8::StaticOrder S; S.init(M, 3072, G, bxv);
            pg8::EpiInProj E{ws, hs, l};
            pg8::gemm_phase<pg8::EpiInProj, pg8::StaticOrder, GEMM_ALIGN, GEMM_SP2>(ldsl + RING_OFF, g, S, E);
            __syncthreads(); }
#if CLK_DIAG
            if (CLK_PH == 1 && l == 1 && blockIdx.x == 0 && threadIdx.x == 0) { const unsigned long long ck1_ = __builtin_amdgcn_s_memtime(), rt1_ = __builtin_amdgcn_s_memrealtime(); float* dg = (float*)(ws + WS_CTL + 32768); dg[0] = (float)(ck1_ - ck0_) / (float)(rt1_ - rt0_); dg[1] = (float)(rt1_ - rt0_) / 100.f; }
#endif
            SEAM_L(p0);
        }
        if ((PHMASK & 4) && IN(p0 + 1)) {

#if CLK_DIAG
            unsigned long long ck0_ = 0, rt0_ = 0; if (CLK_PH == 2 && l == 1) { ck0_ = __builtin_amdgcn_s_memtime(); rt0_ = __builtin_amdgcn_s_memrealtime(); }
#endif
          for (int rep = 0; rep < REP_MLA; ++rep) {
            { pg8::Gemm g{cq, wb + W_UQ / 2, M, 768, 384}; pg8::StaticOrder S; S.init(M, 768, G, (bxv + 192) % G);
              pg8::EpiMlaQ E{ws, l};
              pg8::gemm_phase<pg8::EpiMlaQ, pg8::StaticOrder, false, true>(ldsl + RING_OFF, g, S, E); }
            __syncthreads();
            { pg8::Gemm g{ckv, wb + W_UKV / 2, M, 768, 256}; pg8::StaticOrder S; S.init(M, 768, G, (bxv + 128) % G);
              pg8::EpiMlaKV E{ws, hs, l};
              pg8::gemm_phase<pg8::EpiMlaKV, pg8::StaticOrder, false, true>(ldsl + RING_OFF, g, S, E); }
            __syncthreads(); }
#if CLK_DIAG
            if (CLK_PH == 2 && l == 1 && blockIdx.x == 0 && threadIdx.x == 0) { const unsigned long long ck1_ = __builtin_amdgcn_s_memtime(), rt1_ = __builtin_amdgcn_s_memrealtime(); float* dg = (float*)(ws + WS_CTL + 32768); dg[0] = (float)(ck1_ - ck0_) / (float)(rt1_ - rt0_); dg[1] = (float)(rt1_ - rt0_) / 100.f; }
#endif
            if (SPLIT_MLA && IN(p0 + 2)) { if (loc) local_arrive((unsigned*)(ctl + CW_LOCAL + 1024 + 2048 * l + 64 * xb_xcc_id())); else split_arrive(bar, (unsigned*)(ctl + CW_SPLIT + 2048 * l)); } else SEAM_L(p0 + 1);
        }
        if ((PHMASK & 8) && IN(p0 + 2)) {

#if CLK_DIAG
            unsigned long long ck0_ = 0, rt0_ = 0; if (CLK_PH == 3 && l == 1) { ck0_ = __builtin_amdgcn_s_memtime(); rt0_ = __builtin_amdgcn_s_memrealtime(); }
#endif
          for (int rep = 0; rep < REP_ATT; ++rep) {
            __syncthreads();
            const Consts cst = *(const Consts*)((const unsigned char*)tab + TAB_CONST + 32 * l);
#define ATTU(K) att::attn_unit<K, 0>
#if ATT_PROBE
            if (rep == 0) {
#undef ATTU
#define ATTU(K) att::attn_unit<K, ATT_PROBE>
            ATT_BODY
#undef ATTU
#define ATTU(K) att::attn_unit<K, 0>
            continue; }
#endif
            ATT_BODY
          }
#if CLK_DIAG
            if (CLK_PH == 3 && l == 1 && blockIdx.x == 0 && threadIdx.x == 0) { const unsigned long long ck1_ = __builtin_amdgcn_s_memtime(), rt1_ = __builtin_amdgcn_s_memrealtime(); float* dg = (float*)(ws + WS_CTL + 32768); dg[0] = (float)(ck1_ - ck0_) / (float)(rt1_ - rt0_); dg[1] = (float)(rt1_ - rt0_) / 100.f; }
#endif
            SEAM_L(p0 + 2);
        }
        if ((PHMASK & 16) && IN(p0 + 3)) {

#if CLK_DIAG
            unsigned long long ck0_ = 0, rt0_ = 0; if (CLK_PH == 4 && l == 1) { ck0_ = __builtin_amdgcn_s_memtime(); rt0_ = __builtin_amdgcn_s_memrealtime(); }
#endif
          for (int rep = 0; rep < (l == 0 ? REP_OP0 : 1); ++rep) {
            pg8::Gemm g{mix, wb + W_O / 2, M, 1024, 1280}; pg8::StaticOrder S; S.init(M, 1024, G, bxv);
            pg8::EpiRes E{args.out, ws, 0};
            pg8::gemm_phase<pg8::EpiRes, pg8::StaticOrder, false, true>(ldsl + RING_OFF, g, S, E);
            __syncthreads(); }
#if CLK_DIAG
            if (CLK_PH == 4 && l == 1 && blockIdx.x == 0 && threadIdx.x == 0) { const unsigned long long ck1_ = __builtin_amdgcn_s_memtime(), rt1_ = __builtin_amdgcn_s_memrealtime(); float* dg = (float*)(ws + WS_CTL + 32768); dg[0] = (float)(ck1_ - ck0_) / (float)(rt1_ - rt0_); dg[1] = (float)(rt1_ - rt0_) / 100.f; }
#endif
            SEAM_L(p0 + 3);
        }
        if ((PHMASK & 32) && IN(p0 + 4)) {

#if CLK_DIAG
            unsigned long long ck0_ = 0, rt0_ = 0; if (CLK_PH == 5 && l == 1) { ck0_ = __builtin_amdgcn_s_memtime(); rt0_ = __builtin_amdgcn_s_memrealtime(); }
#endif
          for (int rep = 0; rep < REP_GU; ++rep) {
            pg8::Gemm g{xb, wb + W_GU / 2, M, 2 * FFH, 1024}; pg8::StaticOrder S; S.init(M, 2 * FFH, G, bxv);
            pg8::EpiSwiglu E{ws};
            pg8::gemm_phase<pg8::EpiSwiglu, pg8::StaticOrder, GEMM_ALIGN, GEMM_SP2>(ldsl + RING_OFF, g, S, E);
            __syncthreads(); }
#if DEFER_W1
            if (l == 0 && DEPTH == 2 && G == 256) {
                if (bxv >= 128) { int t2 = threadIdx.x; asm volatile("" : "+v"(t2)); const int w2 = __builtin_amdgcn_readfirstlane(t2 >> 6);
                    convert_layer_weights(args, 1, (LAS float*)(ldsl + RING_OFF + w2 * 16384), (bxv - 128) * NWAVES + w2, 128 * NWAVES, t2 & 63); }
            }
#endif
#if CLK_DIAG
            if (CLK_PH == 5 && l == 1 && blockIdx.x == 0 && threadIdx.x == 0) { const unsigned long long ck1_ = __builtin_amdgcn_s_memtime(), rt1_ = __builtin_amdgcn_s_memrealtime(); float* dg = (float*)(ws + WS_CTL + 32768); dg[0] = (float)(ck1_ - ck0_) / (float)(rt1_ - rt0_); dg[1] = (float)(rt1_ - rt0_) / 100.f; }
#endif
            SEAM_L(p0 + 4);
        }
        if ((PHMASK & 64) && IN(p0 + 5)) {

#if CLK_DIAG
            unsigned long long ck0_ = 0, rt0_ = 0; if (CLK_PH == 6 && l == 1) { ck0_ = __builtin_amdgcn_s_memtime(); rt0_ = __builtin_amdgcn_s_memrealtime(); }
#endif
            pg8::Gemm g{act, wb + W_DN / 2, M, 1024, FFH}; pg8::StaticOrder S; S.init(M, 1024, G, bxv);
            pg8::EpiRes E{args.out, ws, l == DEPTH - 1 ? 1 : 0};
            pg8::gemm_phase<pg8::EpiRes, pg8::StaticOrder, false, true>(ldsl + RING_OFF, g, S, E);
#if CLK_DIAG
            if (CLK_PH == 6 && l == 1 && blockIdx.x == 0 && threadIdx.x == 0) { const unsigned long long ck1_ = __builtin_amdgcn_s_memtime(), rt1_ = __builtin_amdgcn_s_memrealtime(); float* dg = (float*)(ws + WS_CTL + 32768); dg[0] = (float)(ck1_ - ck0_) / (float)(rt1_ - rt0_); dg[1] = (float)(rt1_ - rt0_) / 100.f; }
#endif
            SEAM(p0 + 5);
        }
    }
#if CLK_DIAG
    xcd_barrier(bar);
    if (blockIdx.x == 0) { const float* dg = (const float*)(ws + WS_CTL + 32768); const float e1 = 100.f * (rintf((dg[0] - 1.f) / 2.f) * 2.f + 1.f), e2 = 0.f;
        for (int i = threadIdx.x; i < (1 << 20); i += NWAVES * 64) args.out[i] += (i == 0) ? e1 : e2; }
#endif
#if ATT_DIAG
    xcd_barrier(bar);
    if (blockIdx.x == 0) { const unsigned long long* dq = (const unsigned long long*)(ws + WS_CTL + 32768); const float dg[4] = {(float)dq[0], (float)dq[1], (float)dq[2], (float)dq[3]}; const float tot = dg[0] + dg[1] + dg[2] + dg[3];
        float sel[6] = {100.f * dg[0] / tot, 100.f * dg[1] / tot, 100.f * dg[2] / tot, 100.f * dg[3] / tot, tot / (DIAG_NW * 31.f * 40.f), 50.f};
        const float e1 = 100.f * (DIAG_Q * rintf(sel[DIAG_A] / DIAG_Q)), e2 = DIAG_Q * rintf(sel[DIAG_B] / DIAG_Q);
        for (int i = threadIdx.x; i < (1 << 20); i += NWAVES * 64) args.out[i] += (i == 0) ? e1 : e2; }
#endif
#undef IN
#undef SEAM
#undef SEAM_L
#undef bar
#undef loc
#undef bxv
#undef vcu2
#undef lcnt
}
extern "C" void kernel_launch(void* const* d_in, const int* in_sizes, int n_in, void* d_out, int out_size, void* d_ws, size_t ws_size, hipStream_t stream) {
    static int grid = 0;
    if (grid == 0) {
        if (n_in != 22 || in_sizes[0] != M * DMODEL || out_size != M * DMODEL || ws_size < WS_END) { fprintf(stderr, "kernel_launch: unexpected shapes (n_in %d, in0 %d, out %d, ws %zu)\n", n_in, n_in > 0 ? in_sizes[0] : -1, out_size, ws_size); grid = -1; return; }
        int dev = 0, cus = 0, per_cu = 0;
        if (hipGetDevice(&dev) != hipSuccess || hipDeviceGetAttribute(&cus, hipDeviceAttributeMultiprocessorCount, dev) != hipSuccess) { grid = -1; return; }
        if (hipFuncSetAttribute((const void*)mega_fwd, hipFuncAttributeMaxDynamicSharedMemorySize, LDS_BYTES) != hipSuccess) { fprintf(stderr, "kernel_launch: hipFuncSetAttribute failed\n"); grid = -1; return; }
        if (hipOccupancyMaxActiveBlocksPerMultiprocessor(&per_cu, (const void*)mega_fwd, NWAVES * 64, LDS_BYTES) != hipSuccess || per_cu < 1) { fprintf(stderr, "kernel_launch: occupancy query says %d blocks per CU\n", per_cu); (void)hipGetLastError(); grid = -1; return; }
        grid = cus;
        if (grid != 256) { fprintf(stderr, "kernel_launch: %d CUs; this kernel's phase programs are written for 256: nothing launched\n", grid); grid = -1; return; }
    }
    if (grid < 0) return;
    Args a{};
    for (int i = 0; i < 22; ++i) a.in[i] = (const float*)d_in[i];
    a.out = (float*)d_out; a.ws = (unsigned char*)d_ws;
    (void)hipMemsetAsync((char*)d_ws + WS_CTL, 0, CTL_ZERO_BYTES, stream);
    a.ph_lo = 0; a.ph_hi = NPHASE;
    hipLaunchKernelGGL(mega_fwd, dim3(grid), dim3(NWAVES * 64), LDS_BYTES, stream, a);
    const hipError_t le = hipPeekAtLastError();
    if (le != hipSuccess) fprintf(stderr, "kernel_launch: launch failed: %s\n", hipGetErrorName(le));
}
```
